# Optimizing an MI355X kernel written in HIP

```python
import jax
import jax.numpy as jnp
from jax import lax
import numpy as np

D_MODEL = 2048
BATCH = 4
SEQ = 4096
DEPTH = 2

GRID_W = 64
CTX_LEN = 256
EPS = 1e-6
ROPE_BASE = 10000.0
ROT_DIM = 64
D_FF = 5504
N_MOD = 9
N_BRANCH = 4
BRANCH_W = D_MODEL // N_BRANCH

CHUNK = 128
GM_GROUPS = 4
GM_GC = BRANCH_W // GM_GROUPS

CONV_W = 31

MLA_HEADS = 4
MLA_Q_RANK = 512
MLA_KV_RANK = 256
MLA_NOPE = 128
MLA_ROPE = ROT_DIM
MLA_V = BRANCH_W // MLA_HEADS
MLA_QBLOCK = 128

SWA_HD = ROT_DIM
SWA_HEADS = BRANCH_W // SWA_HD
SWA_KV_HEADS = 2
SWA_GROUP = SWA_HEADS // SWA_KV_HEADS
WINDOW = 128
SWA_BLOCK = 128

N_A = 2 * BRANCH_W
N_B = 2 * BRANCH_W
N_C = MLA_Q_RANK + MLA_KV_RANK + MLA_ROPE
N_D = (SWA_HEADS + 2 * SWA_KV_HEADS) * SWA_HD
N_G = N_BRANCH * D_MODEL
N_IN = N_A + N_B + N_C + N_D + N_G
IN_SPLITS = (N_A, N_A + N_B, N_A + N_B + N_C, N_A + N_B + N_C + N_D)

kernel_name = 'hybrid_gated_mixer_dit_block'


def rmsnorm(x, g):
    xf = x.astype(jnp.float32)
    y = xf * lax.rsqrt(jnp.mean(xf * xf, axis=-1, keepdims=True) + EPS)
    return (y * g.astype(jnp.float32)).astype(x.dtype)


def layernorm(x, g, b):
    xf = x.astype(jnp.float32)
    mu = jnp.mean(xf, axis=-1, keepdims=True)
    var = jnp.mean(jnp.square(xf - mu), axis=-1, keepdims=True)
    y = (xf - mu) * lax.rsqrt(var + EPS) * g.astype(jnp.float32) + b.astype(jnp.float32)
    return y.astype(x.dtype)


def modulation(cond, w_mod, b_mod):
    m = jax.nn.silu(cond) @ w_mod + b_mod
    return m.reshape(cond.shape[:-1] + (N_MOD, D_MODEL))


def pick(m, k):
    return m[..., k, :][..., None, :]


def modulated_norm(x, g, m, j):
    return rmsnorm(x, g) * (1 + pick(m, 3 * j + 1)) + pick(m, 3 * j)


def ffn_sublayer(x, m, j, g_pre, g_post, w_gate, w_up, w_down):
    h = modulated_norm(x, g_pre, m, j)
    y = (jax.nn.silu(h @ w_gate) * (h @ w_up)) @ w_down
    return x + 0.5 * pick(m, 3 * j + 2) * rmsnorm(y, g_post)


def axial_rope_tables(rows, rot_dim):
    half = rot_dim // 2
    freqs = 1.0 / (ROPE_BASE ** (jnp.arange(0, half, 2, dtype=jnp.float32) / half))
    t_row = jnp.repeat(jnp.arange(rows, dtype=jnp.float32), GRID_W)
    t_col = jnp.tile(jnp.arange(GRID_W, dtype=jnp.float32), rows)

    def cos_sin(pos):
        ang = pos[:, None] * freqs[None, :]
        ang = jnp.concatenate([ang, ang], axis=-1)
        return jnp.cos(ang), jnp.sin(ang)

    cr, sr = cos_sin(t_row)
    cc, sc = cos_sin(t_col)
    return cr, sr, cc, sc


def _rotate(x, cos, sin):
    h = x.shape[-1] // 2
    rot = jnp.concatenate([-x[..., h:], x[..., :h]], axis=-1)
    return x * cos + rot * sin


def apply_axial_rope(x, tables):
    cr, sr, cc, sc = [t[None, :, None, :].astype(x.dtype) for t in tables]
    half = x.shape[-1] // 2
    return jnp.concatenate([_rotate(x[..., :half], cr, sr), _rotate(x[..., half:], cc, sc)], axis=-1)


def chunk_gmlp(z, ln_g, ln_b, ws, bs):
    bn, n, _ = z.shape
    z = jax.nn.gelu(z, approximate=False)
    u, v = jnp.split(z, 2, axis=-1)
    v = layernorm(v, ln_g, ln_b).reshape(bn, n // CHUNK, CHUNK, GM_GROUPS, GM_GC)
    sv = jnp.einsum('gpq,bnqgc->bnpgc', ws, v) + bs.T[None, None, :, :, None]
    return u * sv.reshape(bn, n, BRANCH_W)


def conformer_conv(z, dw, db, ln_g, ln_b):
    a, gt = jnp.split(z, 2, axis=-1)
    h = a * jax.nn.sigmoid(gt)
    h = lax.conv_general_dilated(
        h, dw[:, None, :], window_strides=(1,),
        padding=((CONV_W // 2, CONV_W // 2),),
        dimension_numbers=('NWC', 'WIO', 'NWC'),
        feature_group_count=h.shape[-1]) + db
    return jax.nn.silu(layernorm(h, ln_g, ln_b))


def mla_qkv(z, q_norm, kv_norm, w_uq, w_ukv):
    bn, n, _ = z.shape
    cq, ckv, k_rope = jnp.split(z, [MLA_Q_RANK, MLA_Q_RANK + MLA_KV_RANK], axis=-1)
    q = (rmsnorm(cq, q_norm) @ w_uq).reshape(bn, n, MLA_HEADS, MLA_NOPE + MLA_ROPE)
    kv = (rmsnorm(ckv, kv_norm) @ w_ukv).reshape(bn, n, MLA_HEADS, MLA_NOPE + MLA_V)
    return q, kv[..., :MLA_NOPE], k_rope[:, :, None, :], kv[..., MLA_NOPE:]


def mla_keys(k_nope, k_rope):
    return jnp.concatenate([k_nope, jnp.broadcast_to(k_rope, k_nope.shape[:-1] + (MLA_ROPE,))], axis=-1)


def block_attention(q, k, v):
    bn, n, h, dk = q.shape
    nb = n // MLA_QBLOCK
    scale = dk ** -0.5
    qb = jnp.moveaxis(q.reshape(bn, nb, MLA_QBLOCK, h, dk), 1, 0)

    def one_block(qblk):
        s = jnp.einsum('bqhd,bkhd->bhqk', qblk, k, preferred_element_type=jnp.float32) * scale
        p = jax.nn.softmax(s, axis=-1).astype(v.dtype)
        return jnp.einsum('bhqk,bkhd->bqhd', p, v)

    o = lax.map(one_block, qb)
    return jnp.moveaxis(o, 0, 1).reshape(bn, n, h * v.shape[-1])


def swa_qkv(z):
    bn, n, _ = z.shape
    q, k, v = jnp.split(z, [SWA_HEADS * SWA_HD, (SWA_HEADS + SWA_KV_HEADS) * SWA_HD], axis=-1)
    return (q.reshape(bn, n, SWA_HEADS, SWA_HD),
            k.reshape(bn, n, SWA_KV_HEADS, SWA_HD),
            v.reshape(bn, n, SWA_KV_HEADS, SWA_HD))


def window_attention(q, k, v, k_ctx, v_ctx, sink):
    bn, n, kvh, grp, hd = q.shape
    nb = n // SWA_BLOCK
    n_ctx = k_ctx.shape[1]
    scale = hd ** -0.5
    qb = q.reshape(bn, nb, SWA_BLOCK, kvh, grp, hd)

    def band(t):
        tb = jnp.pad(t.reshape(bn, nb, SWA_BLOCK, kvh, hd), ((0, 0), (1, 1), (0, 0), (0, 0), (0, 0)))
        return jnp.concatenate([tb[:, :-2], tb[:, 1:-1], tb[:, 2:]], axis=2)

    kb, vb = band(k), band(v)
    blk = jnp.arange(nb)[:, None] * SWA_BLOCK
    q_pos = blk + jnp.arange(SWA_BLOCK)[None, :]
    k_pos = blk - SWA_BLOCK + jnp.arange(3 * SWA_BLOCK)[None, :]
    dist = k_pos[:, None, :] - q_pos[:, :, None]
    valid = (jnp.abs(dist) <= WINDOW) & (k_pos[:, None, :] >= 0) & (k_pos[:, None, :] < n)
    s_loc = jnp.einsum('bnqkgd,bnjkd->bnkgqj', qb, kb, preferred_element_type=jnp.float32) * scale
    s_loc = jnp.where(valid[None, :, None, None], s_loc, -jnp.inf)
    s_ctx = jnp.einsum('bnqkgd,bjkd->bnkgqj', qb, k_ctx, preferred_element_type=jnp.float32) * scale
    s_sink = jnp.broadcast_to(sink.astype(jnp.float32).reshape(1, 1, kvh, grp, 1, 1), s_ctx.shape[:-1] + (1,))
    p = jax.nn.softmax(jnp.concatenate([s_sink, s_ctx, s_loc], axis=-1), axis=-1).astype(v.dtype)
    o = (jnp.einsum('bnkgqj,bjkd->bnqkgd', p[..., 1:1 + n_ctx], v_ctx)
         + jnp.einsum('bnkgqj,bnjkd->bnqkgd', p[..., 1 + n_ctx:], vb))
    return o.reshape(bn, n, kvh * grp * hd)


def sink_attention_dense(q, k, v, sink):
    bn, n, kvh, grp, hd = q.shape
    s = jnp.einsum('bqkgd,bjkd->bkgqj', q, k, preferred_element_type=jnp.float32) * (hd ** -0.5)
    s_sink = jnp.broadcast_to(sink.astype(jnp.float32).reshape(1, kvh, grp, 1, 1), s.shape[:-1] + (1,))
    p = jax.nn.softmax(jnp.concatenate([s_sink, s], axis=-1), axis=-1)[..., 1:].astype(v.dtype)
    return jnp.einsum('bkgqj,bjkd->bqkgd', p, v).reshape(bn, n, kvh * grp * hd)


def gated_merge(branches, zg, w_branch, w_out):
    acc = None
    for b, y in enumerate(branches):
        term = jax.nn.sigmoid(zg[..., b * D_MODEL:(b + 1) * D_MODEL]) * (y @ w_branch[b])
        acc = term if acc is None else acc + term
    return acc @ w_out


def token_mix(h_lat, h_ctx, rope, need_ctx, w_in, b_in, gm_ln_g, gm_ln_b, gm_ws, gm_bs,
              cv_dw, cv_db, cv_ln_g, cv_ln_b, mla_q_norm, mla_kv_norm, mla_w_uq, mla_w_ukv,
              swa_sink, w_branch, w_out):
    za_l, zb_l, zc_l, zd_l, zg_l = jnp.split(h_lat @ w_in + b_in, IN_SPLITS, axis=-1)
    if need_ctx:
        za_c, zb_c, zc_c, zd_c, zg_c = jnp.split(h_ctx @ w_in + b_in, IN_SPLITS, axis=-1)
    else:
        lo, hi = IN_SPLITS[1], IN_SPLITS[3]
        zc_c, zd_c = jnp.split(h_ctx @ w_in[:, lo:hi] + b_in[lo:hi], [N_C], axis=-1)

    q_l, kn_l, kr_l, v_l = mla_qkv(zc_l, mla_q_norm, mla_kv_norm, mla_w_uq, mla_w_ukv)
    q_l = jnp.concatenate([q_l[..., :MLA_NOPE], apply_axial_rope(q_l[..., MLA_NOPE:], rope)], axis=-1)
    k_l = mla_keys(kn_l, apply_axial_rope(kr_l, rope))
    q_c, kn_c, kr_c, v_c = mla_qkv(zc_c, mla_q_norm, mla_kv_norm, mla_w_uq, mla_w_ukv)
    k_c = mla_keys(kn_c, kr_c)
    yc_l = block_attention(q_l, jnp.concatenate([k_c, k_l], axis=1), jnp.concatenate([v_c, v_l], axis=1))

    qd_l, kd_l, vd_l = swa_qkv(zd_l)
    qd_l = apply_axial_rope(qd_l, rope)
    kd_l = apply_axial_rope(kd_l, rope)
    qd_c, kd_c, vd_c = swa_qkv(zd_c)
    bn, n = qd_l.shape[:2]
    yd_l = window_attention(qd_l.reshape(bn, n, SWA_KV_HEADS, SWA_GROUP, SWA_HD), kd_l, vd_l, kd_c, vd_c, swa_sink)

    ya_l = chunk_gmlp(za_l, gm_ln_g, gm_ln_b, gm_ws, gm_bs)
    yb_l = conformer_conv(zb_l, cv_dw, cv_db, cv_ln_g, cv_ln_b)
    y_lat = gated_merge((ya_l, yb_l, yc_l, yd_l), zg_l, w_branch, w_out)
    if not need_ctx:
        return y_lat, None

    nc = qd_c.shape[1]
    ya_c = chunk_gmlp(za_c, gm_ln_g, gm_ln_b, gm_ws, gm_bs)
    yb_c = conformer_conv(zb_c, cv_dw, cv_db, cv_ln_g, cv_ln_b)
    yc_c = block_attention(q_c, k_c, v_c)
    yd_c = sink_attention_dense(qd_c.reshape(bn, nc, SWA_KV_HEADS, SWA_GROUP, SWA_HD), kd_c, vd_c, swa_sink)
    y_ctx = gated_merge((ya_c, yb_c, yc_c, yd_c), zg_c, w_branch, w_out)
    return y_lat, y_ctx


def setup_inputs(seed: int = 0) -> dict:
    key = jax.random.key(seed)
    keys = iter(jax.random.split(key, 40))

    def nrm(shape, s):
        return s * jax.random.normal(next(keys), shape, jnp.float32)

    def gain(shape):
        return 1.0 + nrm(shape, 0.02)

    L = DEPTH
    return {
        'x': nrm((BATCH, SEQ, D_MODEL), 1.0),
        'c': nrm((BATCH, D_MODEL), 1.0),
        'ctx': nrm((BATCH, CTX_LEN, D_MODEL), 1.0),
        'c_ctx': nrm((D_MODEL,), 1.0),
        'w_mod': nrm((L, D_MODEL, N_MOD * D_MODEL), 0.5 * D_MODEL ** -0.5),
        'b_mod': nrm((L, N_MOD * D_MODEL), 0.02),
        'norm_pre': gain((L, 3, D_MODEL)),
        'norm_post': gain((L, 3, D_MODEL)),
        'w_ff_gate': nrm((L, 2, D_MODEL, D_FF), D_MODEL ** -0.5),
        'w_ff_up': nrm((L, 2, D_MODEL, D_FF), D_MODEL ** -0.5),
        'w_ff_down': nrm((L, 2, D_FF, D_MODEL), D_FF ** -0.5),
        'w_in': nrm((L, D_MODEL, N_IN), D_MODEL ** -0.5),
        'b_in': nrm((L, N_IN), 0.02),
        'gm_ln_g': gain((L, BRANCH_W)),
        'gm_ln_b': nrm((L, BRANCH_W), 0.02),
        'gm_ws': nrm((L, GM_GROUPS, CHUNK, CHUNK), CHUNK ** -0.5),
        'gm_bs': gain((L, GM_GROUPS, CHUNK)),
        'cv_dw': nrm((L, CONV_W, BRANCH_W), CONV_W ** -0.5),
        'cv_db': nrm((L, BRANCH_W), 0.02),
        'cv_ln_g': gain((L, BRANCH_W)),
        'cv_ln_b': nrm((L, BRANCH_W), 0.02),
        'mla_q_norm': gain((L, MLA_Q_RANK)),
        'mla_kv_norm': gain((L, MLA_KV_RANK)),
        'mla_w_uq': nrm((L, MLA_Q_RANK, MLA_HEADS * (MLA_NOPE + MLA_ROPE)), MLA_Q_RANK ** -0.5),
        'mla_w_ukv': nrm((L, MLA_KV_RANK, MLA_HEADS * (MLA_NOPE + MLA_V)), MLA_KV_RANK ** -0.5),
        'swa_sink': nrm((L, SWA_HEADS), 0.5),
        'w_branch': nrm((L, N_BRANCH, BRANCH_W, D_MODEL), BRANCH_W ** -0.5),
        'w_out': nrm((L, D_MODEL, D_MODEL), D_MODEL ** -0.5),
    }


def reference(x, c, ctx, c_ctx, w_mod, b_mod, norm_pre, norm_post, w_ff_gate, w_ff_up, w_ff_down,
              w_in, b_in, gm_ln_g, gm_ln_b, gm_ws, gm_bs, cv_dw, cv_db, cv_ln_g, cv_ln_b,
              mla_q_norm, mla_kv_norm, mla_w_uq, mla_w_ukv, swa_sink, w_branch, w_out):
    n_lat = x.shape[1]
    ROWS = n_lat // GRID_W
    rope = axial_rope_tables(ROWS, ROT_DIM)
    for l in range(DEPTH):
        last = l == DEPTH - 1
        m_lat = modulation(c, w_mod[l], b_mod[l])
        m_ctx = modulation(c_ctx, w_mod[l], b_mod[l])

        x = ffn_sublayer(x, m_lat, 0, norm_pre[l, 0], norm_post[l, 0], w_ff_gate[l, 0], w_ff_up[l, 0], w_ff_down[l, 0])
        ctx = ffn_sublayer(ctx, m_ctx, 0, norm_pre[l, 0], norm_post[l, 0], w_ff_gate[l, 0], w_ff_up[l, 0], w_ff_down[l, 0])

        h_lat = modulated_norm(x, norm_pre[l, 1], m_lat, 1)
        h_ctx = modulated_norm(ctx, norm_pre[l, 1], m_ctx, 1)
        y_lat, y_ctx = token_mix(h_lat, h_ctx, rope, not last, w_in[l], b_in[l], gm_ln_g[l], gm_ln_b[l],
                                 gm_ws[l], gm_bs[l], cv_dw[l], cv_db[l], cv_ln_g[l], cv_ln_b[l],
                                 mla_q_norm[l], mla_kv_norm[l], mla_w_uq[l], mla_w_ukv[l],
                                 swa_sink[l], w_branch[l], w_out[l])
        x = x + pick(m_lat, 5) * rmsnorm(y_lat, norm_post[l, 1])

        x = ffn_sublayer(x, m_lat, 2, norm_pre[l, 2], norm_post[l, 2], w_ff_gate[l, 1], w_ff_up[l, 1], w_ff_down[l, 1])
        if not last:
            ctx = ctx + pick(m_ctx, 5) * rmsnorm(y_ctx, norm_post[l, 1])
            ctx = ffn_sublayer(ctx, m_ctx, 2, norm_pre[l, 2], norm_post[l, 2], w_ff_gate[l, 1], w_ff_up[l, 1], w_ff_down[l, 1])
    return x
```

```cpp
#include <hip/hip_runtime.h>
#include <cstdio>
#include <cstdint>

#define LAS __attribute__((address_space(3)))
#define GAS __attribute__((address_space(1)))
typedef unsigned short bf16_t;
typedef short bf16x8 __attribute__((ext_vector_type(8)));
typedef float f32x4 __attribute__((ext_vector_type(4)));
typedef float f32x2 __attribute__((ext_vector_type(2)));
typedef unsigned u32x4 __attribute__((ext_vector_type(4)));
typedef unsigned u32x2 __attribute__((ext_vector_type(2)));

#ifndef PROBE_MASK
#define PROBE_MASK 0
#endif
#ifndef MK_CHECK_LAYER
#define MK_CHECK_LAYER 1
#endif
#ifndef MERGE_N
#define MERGE_N 4
#define MERGE_MAP 0x3210
#endif
#ifndef PROBE_LOCMASK
#define PROBE_LOCMASK 15
#endif
#ifndef LOCMASK
#define LOCMASK 15
#endif
#ifndef PHMASK
#define PHMASK 0xffff
#endif
#define EN(j) (((PHMASK) >> (j)) & 1)
#ifndef MK_MULTI
#define MK_MULTI 0
#endif

constexpr int D = 2048, NB = 4, SEQ = 4096, DEPTH = 2, CTXL = 256, DFF = 5504;
constexpr int ML = NB * SEQ, MC = NB * CTXL, MT = ML + MC;
constexpr int NMOD = 9 * D, NIN = 11840, NZ = 11776, NZW = 12032, NGU = 2 * DFF;
constexpr int ZC_CQ = 2048, ZC_CKV = 2560, ZC_KR = 2816, ZC_QD = 2880, ZC_KD = 3392, ZC_G = 3584;
constexpr float EPS = 1e-6f;
constexpr float LOG2E = 1.4426950408889634f;

__device__ __forceinline__ unsigned f2bf(float f) { unsigned u = __builtin_bit_cast(unsigned, f); return (u + 0x7fffu + ((u >> 16) & 1u)) >> 16; }
__device__ __forceinline__ unsigned pk2(float lo, float hi) { return f2bf(lo) | (f2bf(hi) << 16); }
__device__ __forceinline__ float bflo(unsigned w) { return __builtin_bit_cast(float, w << 16); }
__device__ __forceinline__ float bfhi(unsigned w) { return __builtin_bit_cast(float, w & 0xffff0000u); }
__device__ __forceinline__ float bf2f(bf16_t h) { return __builtin_bit_cast(float, ((unsigned)h) << 16); }
__device__ __forceinline__ unsigned cvt_pk_bf16(float lo, float hi) { unsigned r; asm volatile("v_cvt_pk_bf16_f32 %0, %1, %2" : "=v"(r) : "v"(lo), "v"(hi)); return r; }
__device__ __forceinline__ float fast_exp2(float x) { return __builtin_amdgcn_exp2f(x); }
__device__ __forceinline__ float fast_rcp(float x) { return __builtin_amdgcn_rcpf(x); }
__device__ __forceinline__ float sigmoidf_(float x) { return fast_rcp(1.0f + fast_exp2(-x * LOG2E)); }
__device__ __forceinline__ int fresh_tid() { int t = threadIdx.x; asm volatile("" : "+v"(t)); return t; }
__device__ __forceinline__ float wave_sum(float v) {
#pragma unroll
    for (int o = 1; o < 64; o <<= 1) v += __shfl_xor(v, o);
    return v;
}
__device__ __forceinline__ float gelu1(float v) {
    const float av = __builtin_fabsf(v), t = fast_rcp(av * 0.2316418882f + 1.0f);
    float q = t * 0.5307027145f + (-0.7265760135f); q = q * t + 0.7107068705f; q = q * t + (-0.142248368f); q = q * t + 0.127414796f; q = q * t;
    const float e = fast_exp2((v * v) * (-0.72134752044f));
    const float m = v * (q * e);
    return v < 0.f ? m : v - m;
}

namespace pg8 {
constexpr int BM = 256, BK = 64, HALF = 128, HTB = HALF * BK * 2, STAGE_BYTES = 8 * HTB, NXCD = 8, WGM = 8;
__host__ __device__ __forceinline__ int lds_byte(int r, int c) { const int st = (r >> 4) * 2 + (c >> 5), rr = r & 15, cc = c & 31, ob = rr * 64 + cc * 2; return st * 1024 + (ob ^ (((ob >> 9) & 1) << 5)); }
__host__ __device__ __forceinline__ void stage_rc(int b, int& R, int& C) { const int st = b / 1024, sb = b % 1024, swz = sb ^ (((sb >> 9) & 1) << 5); R = (st >> 1) * 16 + swz / 64; C = (st & 1) * 32 + (swz % 64) / 2; }
__host__ __device__ __forceinline__ int perm32(int rho) { const int n = rho >> 4, i = rho & 15; return 8 * (i >> 2) + 4 * n + (i & 3); }

struct Unit { int pm, pn, sub; };
struct RectOrder {
    int nM, nN, nwg, G, c; const char* A; const char* B; unsigned tA, tB;
    __device__ __forceinline__ void init(int nM_, int nN_, int G_, int c_, int rot, const void* A_, unsigned tA_, const void* B_, unsigned tB_) { nM = nM_; nN = nN_; nwg = nM * nN; G = G_; c = (c_ + G_ - (rot % G_)) % G_; A = (const char*)A_; B = (const char*)B_; tA = tA_; tB = tB_; }
    __device__ __forceinline__ void tile_of(int wgid, Unit& u) const {
        { const int q = nwg / NXCD, r = nwg % NXCD, xcd = wgid % NXCD, off = wgid / NXCD; wgid = (xcd < r ? xcd * (q + 1) : r * (q + 1) + (xcd - r) * q) + off; }
        const int nig = WGM * nN, gid = wgid / nig, fm = gid * WGM, gsz = (nM - fm) < WGM ? (nM - fm) : WGM;
        u.pm = fm + ((wgid % nig) % gsz); u.pn = (wgid % nig) / gsz;
    }
    __device__ __forceinline__ bool next(int i, Unit& u) const { const long L = (long)i * G + c; if (L >= nwg) return false; tile_of((int)L, u); u.sub = 0; return true; }
    __device__ __forceinline__ const char* aptr(const Unit& u) const { return A + (size_t)u.pm * tA; }
    __device__ __forceinline__ const char* bptr(const Unit& u) const { return B + (size_t)u.pn * tB; }
};
struct SplitOrder {
    int pm, pn, part; bool have; const char* A; const char* B;
    __device__ __forceinline__ bool next(int i, Unit& u) const { if (i > 0 || !have) return false; u.pm = pm; u.pn = pn; u.sub = part; return true; }
    __device__ __forceinline__ const char* aptr(const Unit&) const { return A; }
    __device__ __forceinline__ const char* bptr(const Unit&) const { return B; }
};
struct ChainOrder : RectOrder {
    int nsub, map; size_t sA, sB;
    __device__ __forceinline__ bool next(int i, Unit& u) const { const int su = i / nsub; const long L = (long)su * G + c; if (L >= nwg) return false; tile_of((int)L, u); u.sub = i - su * nsub; return true; }
    __device__ __forceinline__ const char* aptr(const Unit& u) const { return A + (size_t)u.pm * tA + (size_t)((map >> (4 * u.sub)) & 15) * sA; }
    __device__ __forceinline__ const char* bptr(const Unit& u) const { return B + (size_t)u.pn * tB + (size_t)((map >> (4 * u.sub)) & 15) * sB; }
};

template <class Epi, class Sched, bool ALIGN_EPI, bool HALFN = false>
__device__ __forceinline__ void gemm_phase(LAS unsigned char* lds, const int K, const int lda, const int ldb, const Sched& S, const Epi& E) {
    const int tid = fresh_tid(), wid = __builtin_amdgcn_readfirstlane(tid >> 6), lane = tid & 63, wr = wid >> 2, wc = wid & 3, fr = lane & 15, fq = lane >> 4;
    const int nt = K / BK;
    unsigned voffA[2], voffB[2];
#pragma unroll
    for (int i = 0; i < 2; ++i) { int R, C; stage_rc(tid * 16 + i * 8192, R, C); const int Rb = Epi::PERM ? ((R & ~31) + perm32(R & 31)) : R;
        voffA[i] = (unsigned)(R * lda + C) * 2u; voffB[i] = (unsigned)(Rb * ldb + C) * 2u; }
    const size_t kstep = (size_t)(BK * 2);
    const size_t hstepA = (size_t)HALF * lda * 2, hstepB = (size_t)HALF * ldb * 2;
    const unsigned ldsw = (unsigned)wid * 1024u;
    const int aoff = lds_byte(wr * 64 + fr, fq * 8), boff = lds_byte(wc * 32 + fr, fq * 8);
#define PG8_SA(b, h) (((b) * 2 + (h)) * HTB)
#define PG8_SB(b, h) ((4 + (b) * 2 + (h)) * HTB)
#define PG8_STAGE(bufoff, gbase, voff) do { _Pragma("unroll") for (int _i = 0; _i < 2; ++_i) \
        __builtin_amdgcn_global_load_lds((const unsigned*)((const char*)(gbase) + (voff)[_i]), (LAS unsigned*)(lds + (bufoff) + ldsw + _i * 8192), 16, 0, 0); } while (0)
#define PG8_LDA(dst, b, h) do { _Pragma("unroll") for (int m = 0; m < 4; ++m) _Pragma("unroll") for (int k = 0; k < 2; ++k) dst[m][k] = *(const LAS bf16x8*)(lds + PG8_SA(b, h) + aoff + m * 2048 + k * 1024); } while (0)
#define PG8_LDB(dst, b, h) do { _Pragma("unroll") for (int n = 0; n < 2; ++n) _Pragma("unroll") for (int k = 0; k < 2; ++k) dst[n][k] = *(const LAS bf16x8*)(lds + PG8_SB(b, h) + boff + n * 2048 + k * 1024); } while (0)
#define PG8_MMA(ai, bj, At, Bt) do { __builtin_amdgcn_s_setprio(1); _Pragma("unroll") for (int m = 0; m < 4; ++m) _Pragma("unroll") for (int n = 0; n < 2; ++n) _Pragma("unroll") for (int k = 0; k < 2; ++k) \
        acc[ai][bj][m][n] = __builtin_amdgcn_mfma_f32_16x16x32_bf16(Bt[n][k], At[m][k], acc[ai][bj][m][n], 0, 0, 0); __builtin_amdgcn_s_setprio(0); } while (0)
#define PG8_WAIT_V(n) asm volatile("s_waitcnt vmcnt(" #n ")" ::: "memory")
#define PG8_WAIT_L(n) asm volatile("s_waitcnt lgkmcnt(" #n ")" ::: "memory")
#define PG8_WAIT_VH do { if constexpr (HALFN) PG8_WAIT_V(6); else PG8_WAIT_V(8); } while (0)
#define PG8_BAR __builtin_amdgcn_s_barrier()
#define PG8_SCHED __builtin_amdgcn_sched_barrier(0)
    Unit cur, nxt; int ui = 0;
    if (!S.next(0, cur)) return;
    f32x4 acc[2][2][4][2];
#pragma unroll
    for (int a = 0; a < 2; ++a)
#pragma unroll
        for (int b = 0; b < 2; ++b)
#pragma unroll
            for (int m = 0; m < 4; ++m)
#pragma unroll
                for (int n = 0; n < 2; ++n) acc[a][b][m][n] = (f32x4){0.f, 0.f, 0.f, 0.f};
    bf16x8 At[4][2], B0[2][2], B1[2][2];
    const char* cA = S.aptr(cur); const char* cB = S.bptr(cur);
    PG8_STAGE(PG8_SB(0, 0), cB, voffB); if constexpr (!HALFN) PG8_STAGE(PG8_SB(0, 1), cB + hstepB, voffB); PG8_STAGE(PG8_SA(0, 0), cA, voffA); PG8_STAGE(PG8_SA(0, 1), cA + hstepA, voffA);
    if (wr == 1) PG8_BAR;
    PG8_WAIT_V(2); PG8_BAR;
    PG8_STAGE(PG8_SB(1, 0), cB + kstep, voffB); PG8_STAGE(PG8_SA(1, 0), cA + kstep, voffA); if constexpr (!HALFN) PG8_STAGE(PG8_SB(1, 1), cB + hstepB + kstep, voffB);
    if constexpr (HALFN) PG8_WAIT_V(4); else PG8_WAIT_V(6);
    PG8_BAR;
    for (;;) {
        const bool has_next = S.next(ui + 1, nxt);
        const char* nA = has_next ? S.aptr(nxt) : cA; const char* nB = has_next ? S.bptr(nxt) : cB;
#pragma unroll 1
        for (int t = 0; t < nt; t += 2) {
            const bool last = (t == nt - 2);
            const char* a1 = cA + (size_t)(t + 1) * kstep;
            const char* a2 = last ? nA : cA + (size_t)(t + 2) * kstep; const char* b2 = last ? nB : cB + (size_t)(t + 2) * kstep;
            const char* a3 = a2 + kstep; const char* b3 = b2 + kstep;
            PG8_LDB(B0, 0, 0); if constexpr (!HALFN) PG8_LDB(B1, 0, 1); PG8_SCHED; PG8_LDA(At, 0, 0); PG8_STAGE(PG8_SA(1, 1), a1 + hstepA, voffA);
            PG8_WAIT_VH; PG8_WAIT_L(0); PG8_BAR; PG8_MMA(0, 0, At, B0); if constexpr (!HALFN) PG8_MMA(0, 1, At, B1); PG8_BAR; PG8_SCHED;
            PG8_LDA(At, 0, 1); PG8_STAGE(PG8_SB(0, 0), b2, voffB); if constexpr (!HALFN) PG8_STAGE(PG8_SB(0, 1), b2 + hstepB, voffB); PG8_STAGE(PG8_SA(0, 0), a2, voffA);
            PG8_WAIT_VH; PG8_WAIT_L(0); PG8_BAR; PG8_MMA(1, 0, At, B0); if constexpr (!HALFN) PG8_MMA(1, 1, At, B1); PG8_BAR; PG8_SCHED;
            PG8_LDB(B0, 1, 0); if constexpr (!HALFN) PG8_LDB(B1, 1, 1); PG8_SCHED; PG8_LDA(At, 1, 0); PG8_STAGE(PG8_SA(0, 1), a2 + hstepA, voffA);
            PG8_WAIT_VH; PG8_WAIT_L(0); PG8_BAR; PG8_MMA(0, 0, At, B0); if constexpr (!HALFN) PG8_MMA(0, 1, At, B1); PG8_BAR; PG8_SCHED;
            PG8_LDA(At, 1, 1); PG8_STAGE(PG8_SB(1, 0), b3, voffB); if constexpr (!HALFN) PG8_STAGE(PG8_SB(1, 1), b3 + hstepB, voffB); PG8_STAGE(PG8_SA(1, 0), a3, voffA);
            PG8_WAIT_VH; PG8_WAIT_L(0); PG8_BAR; PG8_MMA(1, 0, At, B0); if constexpr (!HALFN) PG8_MMA(1, 1, At, B1); PG8_BAR; PG8_SCHED;
        }
        if constexpr (ALIGN_EPI) { if (wr == 0) PG8_BAR; }
        const bool keep = E(acc, cur, wr, wc, fr, fq);
        if (!has_next) break;
        if (!keep) {
#pragma unroll
        for (int a = 0; a < 2; ++a)
#pragma unroll
            for (int b = 0; b < 2; ++b)
#pragma unroll
                for (int m = 0; m < 4; ++m)
#pragma unroll
                    for (int n = 0; n < 2; ++n) acc[a][b][m][n] = (f32x4){0.f, 0.f, 0.f, 0.f};
        }
        cur = nxt; cA = nA; cB = nB; ++ui;
        if constexpr (ALIGN_EPI) { if (wr == 1) PG8_BAR; }
    }
    PG8_WAIT_V(0);
    if constexpr (!ALIGN_EPI) { if (wr == 0) PG8_BAR; }
    PG8_BAR;
#undef PG8_SA
#undef PG8_SB
#undef PG8_STAGE
#undef PG8_LDA
#undef PG8_LDB
#undef PG8_MMA
#undef PG8_WAIT_V
#undef PG8_WAIT_L
#undef PG8_WAIT_VH
#undef PG8_BAR
#undef PG8_SCHED
}
}

constexpr size_t MiB = 1u << 20;
constexpr size_t WS_CTL = 0, CTL_ZERO_BYTES = 1 * MiB;
constexpr size_t WS_MOD = 1 * MiB;
constexpr size_t WS_TAB = 2 * MiB;
constexpr size_t WS_SSP = 2 * MiB + 65536;
constexpr size_t WS_XC = 3 * MiB;
constexpr size_t WS_H = 11 * MiB;
constexpr size_t WS_Y = 79 * MiB;
constexpr size_t WS_HB = 147 * MiB;
constexpr size_t WS_YBR = 164 * MiB;
constexpr size_t WS_QM = 232 * MiB;
constexpr size_t WS_KN = 258 * MiB;
constexpr size_t WS_VTM = 275 * MiB;
constexpr size_t WS_Z = 292 * MiB;
constexpr size_t WS_W = 692 * MiB;
constexpr size_t WL_GU = 0, WL_D = 86 * MiB, WL_IN = 129 * MiB, WL_UQ = 176 * MiB, WL_KV = 177 * MiB, WL_BR = 178 * MiB, WL_OUT = 186 * MiB, WL_GMW = 194 * MiB, WL_BZ = 194 * MiB + 262144, WL_SIZE = 195 * MiB;
constexpr size_t WS_VTD = WS_W + DEPTH * WL_SIZE;
constexpr size_t WS_PART = WS_VTD + 9 * MiB;
constexpr size_t WS_END = WS_PART + 64 * MiB;
static_assert(WS_SSP + (size_t)MT * 12 * 4 <= WS_XC && WS_XC + (size_t)MC * D * 4 <= WS_H && WS_H + (size_t)MT * D * 2 <= WS_Y && WS_Y + (size_t)MT * D * 2 <= WS_HB, "ws map 1");
static_assert(WS_HB + (size_t)MT * 512 * 2 <= WS_YBR && WS_YBR + (size_t)4 * MT * 512 * 2 <= WS_QM && WS_QM + (size_t)MT * 768 * 2 <= WS_KN && WS_KN + (size_t)MT * 512 * 2 <= WS_VTM && WS_VTM + (size_t)512 * MT * 2 <= WS_Z && WS_Z + (size_t)MT * NZ * 2 <= WS_W, "ws map 2");
static_assert((size_t)2 * NGU * D * 2 <= WL_D && WL_D + (size_t)2 * D * DFF * 2 <= WL_IN && WL_IN + (size_t)NZW * D * 2 <= WL_UQ && WL_UQ + 768 * 512 * 2 <= WL_KV && WL_KV + 1024 * 256 * 2 <= WL_BR && WL_BR + (size_t)4 * D * 512 * 2 <= WL_OUT && WL_OUT + (size_t)D * D * 2 <= WL_GMW && WL_GMW + 4 * 128 * 128 * 2 <= WL_BZ && WL_BZ + NZW * 4 <= WL_SIZE, "weight map");
static_assert((size_t)DEPTH * 5 * NMOD * 4 <= 1 * MiB, "mod");
constexpr int CW_BAR = 4096;

constexpr int RING_BYTES = 131072, MISC_OFF = RING_BYTES + 320, LTAB_OFF = RING_BYTES + 2048  , LDS_BYTES = 147456;

#define XB_TMO      128
#define XB_XCNT(j)  (256  + 64 * (j))
#define XB_XSUB(j)  (1280 + 64 * (j))
#define XB_XGEN(j)  (2304 + 64 * (j))
#define XB_TOP      3328
#define XB_TOPGEN   3392
#define XCD_BAR_WORDS 3456
#define XB_SPIN_CAP (1u << 20)
__device__ __forceinline__ unsigned xb_ld(unsigned* p)              { return __hip_atomic_load(p, __ATOMIC_RELAXED, __HIP_MEMORY_SCOPE_AGENT); }
__device__ __forceinline__ unsigned xb_add(unsigned* p, unsigned v) { return __hip_atomic_fetch_add(p, v, __ATOMIC_RELAXED, __HIP_MEMORY_SCOPE_AGENT); }
__device__ __forceinline__ unsigned xb_xcc_id() { return (unsigned)__builtin_amdgcn_s_getreg((3 << 11) | 20) & 0xFu; }
#define XB_SPIN(cond, bar) do { unsigned _sp = 0; while (cond) { __builtin_amdgcn_s_sleep(1); \
    if ((++_sp & 255u) == 0u) { if (xb_ld(&(bar)[XB_TMO])) break; if (_sp > XB_SPIN_CAP) { atomicAdd(&(bar)[XB_TMO], 1u); break; } } } } while (0)
struct XcdBarrier { unsigned* bar; unsigned x; volatile LAS unsigned* st; };
__device__ __forceinline__ XcdBarrier xcd_barrier_post(unsigned* bar, volatile LAS unsigned* st) {
    XcdBarrier b; b.bar = bar; b.x = xb_xcc_id(); b.st = st;
    if (threadIdx.x == 0) (void)xb_add(&bar[XB_XCNT(b.x)], 1u);
    return b;
}
__device__ __forceinline__ void xcd_barrier_complete(unsigned* bar, unsigned x, unsigned& nloc, unsigned& nx) {
    const unsigned G = gridDim.x * gridDim.y * gridDim.z;
    unsigned sum, cnt, mine, sp = 0u;
    for (;;) {
        sum = 0u; cnt = 0u; mine = 0u;
#pragma unroll
        for (unsigned j = 0; j < 16; ++j) { const unsigned c = xb_ld(&bar[XB_XCNT(j)]); sum += c; cnt += (c > 0u) ? 1u : 0u; mine = (j == x) ? c : mine; }
        if (sum == G) break;
        __builtin_amdgcn_s_sleep(1);
        if ((++sp & 255u) == 0u) { if (xb_ld(&bar[XB_TMO])) break; if (sp > XB_SPIN_CAP) { atomicAdd(&bar[XB_TMO], 1u); break; } }
    }
    nloc = mine > 0u ? mine : 1u; nx = cnt > 0u ? cnt : 1u;
}
__device__ __forceinline__ void xcd_barrier(const XcdBarrier& b) {
    asm volatile("s_waitcnt vmcnt(0)" ::: "memory");
    __syncthreads();
    if (threadIdx.x == 0) {
        unsigned* bar = b.bar;
        __builtin_amdgcn_s_waitcnt(0);
        unsigned nloc = b.st[0], nx = b.st[1];
        if (nloc == 0u) { xcd_barrier_complete(bar, b.x, nloc, nx); b.st[0] = nloc; b.st[1] = nx; }
        const unsigned old = xb_add(&bar[XB_XSUB(b.x)], 1u);
        const unsigned gen = old / nloc;
        if (old + 1u == (gen + 1u) * nloc) {
            __builtin_amdgcn_fence(__ATOMIC_RELEASE, "agent");
            asm volatile("s_waitcnt vmcnt(0)" ::: "memory");
            const unsigned og = xb_add(&bar[XB_TOP], 1u);
            const unsigned tg = og / nx;
            if (og + 1u == (tg + 1u) * nx) xb_add(&bar[XB_TOPGEN], 1u);
            else XB_SPIN(xb_ld(&bar[XB_TOPGEN]) == tg, bar);
            __builtin_amdgcn_fence(__ATOMIC_ACQUIRE, "agent");
            xb_add(&bar[XB_XGEN(b.x)], 1u);
            asm volatile("s_waitcnt vmcnt(0)" ::: "memory");
        } else {
            XB_SPIN(xb_ld(&bar[XB_XGEN(b.x)]) == gen, bar);
            __builtin_amdgcn_fence(__ATOMIC_ACQUIRE, "agent");
            asm volatile("s_waitcnt vmcnt(0)" ::: "memory");
        }
    }
    __syncthreads();
}

constexpr int RING_BYTES_C = 131072;
struct Params { const float* in[28]; float* out; unsigned char* ws; int ph_lo, ph_hi; };
enum { I_X = 0, I_C, I_CTX, I_CCTX, I_WMOD, I_BMOD, I_NPRE, I_NPOST, I_WG, I_WU, I_WD, I_WIN, I_BIN, I_GMLNG, I_GMLNB, I_GMWS, I_GMBS, I_CVDW, I_CVDB, I_CVLNG, I_CVLNB, I_QNORM, I_KVNORM, I_WUQ, I_WUKV, I_SINK, I_WBR, I_WOUT };

constexpr int PTAB_OFF = RING_BYTES_C + 1024;
struct Ctx { volatile LAS unsigned* tab;
    __device__ __forceinline__ unsigned long long get(int i) const { const unsigned lo = __builtin_amdgcn_readfirstlane(tab[2 * i]), hi = __builtin_amdgcn_readfirstlane(tab[2 * i + 1]); return ((unsigned long long)hi << 32) | lo; }
    __device__ __forceinline__ const float* in(int i) const { return (const float*)(const GAS float*)get(i); }
    __device__ __forceinline__ float* out() const { return (float*)(GAS float*)get(28); }
    __device__ __forceinline__ unsigned char* ws() const { return (unsigned char*)(GAS unsigned char*)get(29); }
};
#define WSP(T, off) ((T*)(ws + (off)))
#define WLP(T, l, off) ((T*)(ws + WS_W + (size_t)(l) * WL_SIZE + (off)))

namespace pg8 {
struct EpiSwiglu { static constexpr bool PERM = true; bf16_t* O;
    __device__ __forceinline__ bool operator()(f32x4 (&acc)[2][2][4][2], const Unit& u, int wr, int wc, int fr, int fq) const {
        const int row0 = u.pm * BM + wr * 64 + fr, col0 = u.pn * HALF + wc * 32 + 8 * fq;
#pragma unroll
        for (int ai = 0; ai < 2; ++ai)
#pragma unroll
            for (int m = 0; m < 4; ++m) { bf16_t* rowp = O + (size_t)(row0 + ai * HALF + m * 16) * DFF + col0; float v[8];
#pragma unroll
                for (int n = 0; n < 2; ++n)
#pragma unroll
                    for (int i = 0; i < 4; ++i) { const float g = acc[ai][0][m][n][i], up = acc[ai][1][m][n][i]; v[4 * n + i] = g * sigmoidf_(g) * up; }
                u32x4 w; w.x = cvt_pk_bf16(v[0], v[1]); w.y = cvt_pk_bf16(v[2], v[3]); w.z = cvt_pk_bf16(v[4], v[5]); w.w = cvt_pk_bf16(v[6], v[7]);
                *(u32x4*)rowp = w; }
        return false;
    }
};
template <bool RS> struct EpiPlain { static constexpr bool PERM = true; bf16_t* O; int ldc; const float* ssp;
    __device__ __forceinline__ bool operator()(f32x4 (&acc)[2][2][4][2], const Unit& u, int wr, int wc, int fr, int fq) const {
        const int row0 = u.pm * BM + wr * 64 + fr, col0 = u.pn * BM + wc * 32 + 8 * fq;
        f32x4 pr[2][4];
        if (RS) {
#pragma unroll
            for (int ai = 0; ai < 2; ++ai)
#pragma unroll
                for (int m = 0; m < 4; ++m) pr[ai][m] = *(const f32x4*)(ssp + (size_t)(row0 + ai * HALF + m * 16) * 12 + 8);
            __builtin_amdgcn_sched_barrier(0);
        }
#pragma unroll
        for (int ai = 0; ai < 2; ++ai)
#pragma unroll
            for (int m = 0; m < 4; ++m) { const int row = row0 + ai * HALF + m * 16; bf16_t* rowp = O + (size_t)row * ldc + col0; float sc = 1.f;
                if (RS) { const f32x4 p = pr[ai][m]; sc = __builtin_amdgcn_rsqf(((p[0] + p[1]) + (p[2] + p[3])) * (1.f / 256.f) + EPS); }
#pragma unroll
                for (int bj = 0; bj < 2; ++bj) { const f32x4 v0 = acc[ai][bj][m][0] * sc, v1 = acc[ai][bj][m][1] * sc;
                    u32x4 w; w.x = cvt_pk_bf16(v0[0], v0[1]); w.y = cvt_pk_bf16(v0[2], v0[3]); w.z = cvt_pk_bf16(v1[0], v1[1]); w.w = cvt_pk_bf16(v1[2], v1[3]);
                    *(u32x4*)(rowp + bj * HALF) = w; } }
        return false;
    }
};
struct EpiPartial { static constexpr bool PERM = false; float* P; int row_base; size_t pstride;
    __device__ __forceinline__ bool operator()(f32x4 (&acc)[2][2][4][2], const Unit& u, int wr, int wc, int fr, int fq) const {
        const int row0 = u.pm * BM - row_base + wr * 64 + fr, col0 = u.pn * BM + wc * 32 + 4 * fq; float* base = P + (size_t)u.sub * pstride;
#pragma unroll
        for (int ai = 0; ai < 2; ++ai)
#pragma unroll
            for (int m = 0; m < 4; ++m) { float* rowp = base + (size_t)(row0 + ai * HALF + m * 16) * D + col0;
#pragma unroll
                for (int bj = 0; bj < 2; ++bj)
#pragma unroll
                    for (int n = 0; n < 2; ++n) *(f32x4*)(rowp + bj * HALF + n * 16) = acc[ai][bj][m][n]; }
        return false;
    }
};
__device__ __forceinline__ void rope4(f32x4& v0, f32x4& v1, const LAS float* tab) {
    const f32x4 t0 = *(const LAS f32x4*)tab, t1 = *(const LAS f32x4*)(tab + 4);
    const float c[4] = {t0[0], t0[2], t1[0], t1[2]}, s[4] = {t0[1], t0[3], t1[1], t1[3]};
#pragma unroll
    for (int i = 0; i < 4; ++i) { const float a = v0[i], b = v1[i]; v0[i] = a * c[i] - b * s[i]; v1[i] = b * c[i] + a * s[i]; }
}
struct EpiQ { static constexpr bool PERM = true; bf16_t* O; const float* ssp; const LAS float* tab;
    __device__ __forceinline__ bool operator()(f32x4 (&acc)[2][2][4][2], const Unit& u, int wr, int wc, int fr, int fq) const {
        const int row0 = u.pm * BM + wr * 64 + fr, col0 = u.pn * BM + wc * 32 + 8 * fq;
        const float qs = 0.07216878364870322f * LOG2E;
#pragma unroll
        for (int ai = 0; ai < 2; ++ai) {
        f32x4 pr0[4], pr1[4];
#pragma unroll
        for (int m = 0; m < 4; ++m) { const size_t ro = (size_t)(row0 + ai * HALF + m * 16) * 12; pr0[m] = *(const f32x4*)(ssp + ro); pr1[m] = *(const f32x4*)(ssp + ro + 4); }
        __builtin_amdgcn_sched_barrier(0);
#pragma unroll
            for (int m = 0; m < 4; ++m) { const int row = row0 + ai * HALF + m * 16; bf16_t* rowp = O + (size_t)row * 768 + col0;
                const f32x4 p0 = pr0[m], p1 = pr1[m];
                const float sc = __builtin_amdgcn_rsqf((((p0[0] + p0[1]) + (p0[2] + p0[3])) + ((p1[0] + p1[1]) + (p1[2] + p1[3]))) * (1.f / 512.f) + EPS) * qs;
                const int t = row & (SEQ - 1); const bool lat = row < ML;
#pragma unroll
                for (int bj = 0; bj < 2; ++bj) { const int grp = (u.pn * 8 + bj * 4 + wc) % 6;
                    f32x4 v0 = acc[ai][bj][m][0] * sc, v1 = acc[ai][bj][m][1] * sc;
                    if (grp >= 4 && lat) { const int pos = (grp == 4) ? (t >> 6) : (t & 63); rope4(v0, v1, tab + (pos * 16 + 4 * fq) * 2); }
                    u32x4 w; w.x = cvt_pk_bf16(v0[0], v0[1]); w.y = cvt_pk_bf16(v0[2], v0[3]); w.z = cvt_pk_bf16(v1[0], v1[1]); w.w = cvt_pk_bf16(v1[2], v1[3]);
                    *(u32x4*)(rowp + bj * HALF) = w; } }
        __builtin_amdgcn_sched_barrier(0); }
        return false;
    }
};
struct EpiZ { static constexpr bool PERM = true; bf16_t* Z; bf16_t* HB; float* ssp; const float* bias; const LAS float* tab; int pn_off, row_base;
    __device__ __forceinline__ bool operator()(f32x4 (&acc)[2][2][4][2], const Unit& u, int wr, int wc, int fr, int fq) const {
        const int pn = u.pn + pn_off;
        const int row0 = row_base + u.pm * BM + wr * 64 + fr, col0 = pn * BM + wc * 32 + 8 * fq;
        f32x4 bv[2][2];
#pragma unroll
        for (int bj = 0; bj < 2; ++bj)
#pragma unroll
            for (int n = 0; n < 2; ++n) bv[bj][n] = *(const f32x4*)(bias + col0 + bj * HALF + 4 * n);
        if (pn >= 4 && pn < 8) {
#pragma unroll
            for (int ai = 0; ai < 2; ++ai)
#pragma unroll
                for (int m = 0; m < 4; ++m) { bf16_t* rowp = HB + (size_t)(row0 + ai * HALF + m * 16) * 512 + (pn - 4) * HALF + wc * 32 + 8 * fq; float h[8];
#pragma unroll
                    for (int n = 0; n < 2; ++n) { const f32x4 a = acc[ai][0][m][n] + bv[0][n], gt = acc[ai][1][m][n] + bv[1][n];
#pragma unroll
                        for (int i = 0; i < 4; ++i) h[4 * n + i] = a[i] * sigmoidf_(gt[i]); }
                    u32x4 w; w.x = cvt_pk_bf16(h[0], h[1]); w.y = cvt_pk_bf16(h[2], h[3]); w.z = cvt_pk_bf16(h[4], h[5]); w.w = cvt_pk_bf16(h[6], h[7]); *(u32x4*)rowp = w; }
        } else {
#pragma unroll
        for (int ai = 0; ai < 2; ++ai)
#pragma unroll
            for (int m = 0; m < 4; ++m) { const int row = row0 + ai * HALF + m * 16; bf16_t* rowp = Z + (size_t)row * NZ + col0; float ss = 0.f;
                const int t = row & (SEQ - 1); const bool lat = row < ML;
#pragma unroll
                for (int bj = 0; bj < 2; ++bj) { f32x4 v0 = acc[ai][bj][m][0] + bv[bj][0], v1 = acc[ai][bj][m][1] + bv[bj][1];
                    if (pn < 4) {
#pragma unroll
                        for (int i = 0; i < 4; ++i) { v0[i] = gelu1(v0[i]); v1[i] = gelu1(v1[i]); }
                    } else if (pn < 11) {
#pragma unroll
                        for (int i = 0; i < 4; ++i) ss += v0[i] * v0[i] + v1[i] * v1[i];
                    } else if (pn < 14) { const int grp = pn * 8 + bj * 4 + wc;
                        if (grp >= 88 && grp < 110 && lat) { const int pos = (grp & 1) ? (t & 63) : (t >> 6); rope4(v0, v1, tab + (pos * 16 + 4 * fq) * 2); }
                        if (grp >= 90 && grp < 106) { v0 = v0 * (0.125f * LOG2E); v1 = v1 * (0.125f * LOG2E); }
                    } else {
#pragma unroll
                        for (int i = 0; i < 4; ++i) { v0[i] = sigmoidf_(v0[i]); v1[i] = sigmoidf_(v1[i]); }
                    }
                    u32x4 w; w.x = cvt_pk_bf16(v0[0], v0[1]); w.y = cvt_pk_bf16(v0[2], v0[3]); w.z = cvt_pk_bf16(v1[0], v1[1]); w.w = cvt_pk_bf16(v1[2], v1[3]);
                    *(u32x4*)(rowp + bj * HALF) = w; }
                if (pn >= 8 && pn < 11) { ss += __shfl_xor(ss, 16); ss += __shfl_xor(ss, 32); ssp[(size_t)row * 12 + (pn - 8) * 4 + wc] = ss; } }
        }
        asm volatile("" :: "v"(bv[0][0]), "v"(bv[0][1]), "v"(bv[1][0]), "v"(bv[1][1]));
        return false;
    }
};
template <bool COLSCALE> struct EpiVt { static constexpr bool PERM = true; bf16_t* O; int ldc; const float* rbias; const float* ssp;
    __device__ __forceinline__ bool operator()(f32x4 (&acc)[2][2][4][2], const Unit& u, int wr, int wc, int fr, int fq) const {
        const int row0 = u.pm * BM + wr * 64 + fr, col0 = u.pn * BM + wc * 32 + 8 * fq;
        float sc[2][8];
        if (COLSCALE) {
#pragma unroll
            for (int bj = 0; bj < 2; ++bj) { f32x4 pc[8];
#pragma unroll
                for (int e = 0; e < 8; ++e) pc[e] = *(const f32x4*)(ssp + (size_t)(col0 + bj * HALF + e) * 12 + 8);
                __builtin_amdgcn_sched_barrier(0);
#pragma unroll
                for (int e = 0; e < 8; ++e) { const f32x4 p = pc[e]; sc[bj][e] = __builtin_amdgcn_rsqf(((p[0] + p[1]) + (p[2] + p[3])) * (1.f / 256.f) + EPS); }
                __builtin_amdgcn_sched_barrier(0); }
        } else {
#pragma unroll
            for (int bj = 0; bj < 2; ++bj)
#pragma unroll
                for (int e = 0; e < 8; ++e) sc[bj][e] = 1.f;
        }
        float rbv[2][4];
#pragma unroll
        for (int ai = 0; ai < 2; ++ai)
#pragma unroll
            for (int m = 0; m < 4; ++m) rbv[ai][m] = COLSCALE ? 0.f : rbias[row0 + ai * HALF + m * 16];
        __builtin_amdgcn_sched_barrier(0);
#pragma unroll
        for (int ai = 0; ai < 2; ++ai)
#pragma unroll
            for (int m = 0; m < 4; ++m) { const int row = row0 + ai * HALF + m * 16; bf16_t* rowp = O + (size_t)row * ldc + col0; const float rb = rbv[ai][m];
#pragma unroll
                for (int bj = 0; bj < 2; ++bj) { const f32x4 a0 = acc[ai][bj][m][0] + rb, a1 = acc[ai][bj][m][1] + rb;
                    u32x4 w; w.x = cvt_pk_bf16(a0[0] * sc[bj][0], a0[1] * sc[bj][1]); w.y = cvt_pk_bf16(a0[2] * sc[bj][2], a0[3] * sc[bj][3]); w.z = cvt_pk_bf16(a1[0] * sc[bj][4], a1[1] * sc[bj][5]); w.w = cvt_pk_bf16(a1[2] * sc[bj][6], a1[3] * sc[bj][7]);
                    *(u32x4*)(rowp + bj * HALF) = w; } }
        return false;
    }
};
struct EpiM1 { static constexpr bool PERM = true; const bf16_t* Z; bf16_t* T; int nlast, map;
    __device__ __forceinline__ void loadb(const bf16_t* sp, const bf16_t* sp2, int b, u32x4 (&s)[2][2], u32x4 (&s2)[2][2]) const {
#pragma unroll
        for (int mm = 0; mm < 2; ++mm)
#pragma unroll
            for (int bj = 0; bj < 2; ++bj) { const size_t ro = (size_t)((b >> 1) * HALF + (2 * (b & 1) + mm) * 16) * NZ + bj * HALF; s[mm][bj] = *(const u32x4*)(sp + ro); s2[mm][bj] = *(const u32x4*)(sp2 + ro); }
    }
    __device__ __forceinline__ bool operator()(f32x4 (&acc)[2][2][4][2], const Unit& u, int wr, int wc, int fr, int fq) const {
        const int row0 = u.pm * BM + wr * 64 + fr, col0 = u.pn * BM + wc * 32 + 8 * fq; const int sub = u.sub;
        const int br = (map >> (4 * sub)) & 15, br2 = (map >> (4 * sub + 4)) & 15; const bool mid = sub < nlast;
        const bf16_t* sp = Z + (size_t)row0 * NZ + ZC_G + br * D + col0; const bf16_t* sp2 = Z + (size_t)row0 * NZ + ZC_G + (mid ? br2 : br) * D + col0;
        u32x4 sA[2][2], s2A[2][2], sB[2][2], s2B[2][2];
        loadb(sp, sp2, 0, sA, s2A);
#pragma unroll
        for (int b = 0; b < 4; ++b) {
            if (b + 1 < 4) { if (b & 1) loadb(sp, sp2, b + 1, sA, s2A); else loadb(sp, sp2, b + 1, sB, s2B); }
            __builtin_amdgcn_sched_barrier(0);
            const int ai = b >> 1, mp = b & 1;
#pragma unroll
            for (int mm = 0; mm < 2; ++mm)
#pragma unroll
                for (int bj = 0; bj < 2; ++bj) { const int m = 2 * mp + mm; const u32x4 a = (b & 1) ? sB[mm][bj] : sA[mm][bj], c = (b & 1) ? s2B[mm][bj] : s2A[mm][bj];
                    float g[8] = {bflo(a.x), bfhi(a.x), bflo(a.y), bfhi(a.y), bflo(a.z), bfhi(a.z), bflo(a.w), bfhi(a.w)};
                    if (mid) { const float g2[8] = {bflo(c.x), bfhi(c.x), bflo(c.y), bfhi(c.y), bflo(c.z), bfhi(c.z), bflo(c.w), bfhi(c.w)};
#pragma unroll
                        for (int i = 0; i < 8; ++i) g[i] = g[i] * fast_rcp(__builtin_fmaxf(g2[i], 1e-30f));
#pragma unroll
                        for (int i = 0; i < 4; ++i) { acc[ai][bj][m][0][i] *= g[i]; acc[ai][bj][m][1][i] *= g[4 + i]; }
                    } else { f32x4 v0, v1; asm volatile("" :: "v"(c));
#pragma unroll
                        for (int i = 0; i < 4; ++i) { v0[i] = acc[ai][bj][m][0][i] * g[i]; v1[i] = acc[ai][bj][m][1][i] * g[4 + i]; }
                        u32x4 w; w.x = cvt_pk_bf16(v0[0], v0[1]); w.y = cvt_pk_bf16(v0[2], v0[3]); w.z = cvt_pk_bf16(v1[0], v1[1]); w.w = cvt_pk_bf16(v1[2], v1[3]);
                        *(u32x4*)(T + (size_t)(row0 + ai * HALF + m * 16) * D + col0 + bj * HALF) = w; } }
            __builtin_amdgcn_sched_barrier(0);
        }
        return mid;
    }
};
struct EpiM1H { static constexpr bool PERM = true; const bf16_t* Z; bf16_t* T; int nlast, map;
    __device__ __forceinline__ bool operator()(f32x4 (&acc)[2][2][4][2], const Unit& u, int wr, int wc, int fr, int fq) const {
        const int row0 = u.pm * BM + wr * 64 + fr, col0 = u.pn * HALF + wc * 32 + 8 * fq; const int sub = u.sub; const int br = (map >> (4 * sub)) & 15;
        const bf16_t* sp = Z + (size_t)row0 * NZ + ZC_G + br * D + col0;
        u32x4 s[2][4];
#pragma unroll
        for (int ai = 0; ai < 2; ++ai)
#pragma unroll
            for (int m = 0; m < 4; ++m) s[ai][m] = *(const u32x4*)(sp + (size_t)(ai * HALF + m * 16) * NZ);
        __builtin_amdgcn_sched_barrier(0);
#pragma unroll
        for (int ai = 0; ai < 2; ++ai)
#pragma unroll
            for (int m = 0; m < 4; ++m) { const u32x4 a = s[ai][m];
                const f32x4 g0 = (f32x4){bflo(a.x), bfhi(a.x), bflo(a.y), bfhi(a.y)}, g1 = (f32x4){bflo(a.z), bfhi(a.z), bflo(a.w), bfhi(a.w)};
                acc[ai][1][m][0] += g0 * acc[ai][0][m][0]; acc[ai][1][m][1] += g1 * acc[ai][0][m][1];
                acc[ai][0][m][0] = (f32x4){0.f, 0.f, 0.f, 0.f}; acc[ai][0][m][1] = (f32x4){0.f, 0.f, 0.f, 0.f};
                if (sub == nlast) { const f32x4 v0 = acc[ai][1][m][0], v1 = acc[ai][1][m][1];
                    u32x4 w; w.x = cvt_pk_bf16(v0[0], v0[1]); w.y = cvt_pk_bf16(v0[2], v0[3]); w.z = cvt_pk_bf16(v1[0], v1[1]); w.w = cvt_pk_bf16(v1[2], v1[3]);
                    *(u32x4*)(T + (size_t)(row0 + ai * HALF + m * 16) * D + col0) = w;
                    acc[ai][1][m][0] = (f32x4){0.f, 0.f, 0.f, 0.f}; acc[ai][1][m][1] = (f32x4){0.f, 0.f, 0.f, 0.f}; } }
        return true;
    }
};
}

#define LDS_WAIT() asm volatile("s_waitcnt lgkmcnt(0)" ::: "memory")
__device__ __forceinline__ void cvt_item(const float* W, int ldw, int srccol0, bf16_t* dst, int K, int k0, const float* kscale, LAS float* scr, int lane, bool perm) {
    const int sc8 = perm ? (((lane & 7) >> 1) + 4 * (lane & 1)) : (lane & 7);
    f32x4 v[8];
    float ksv[8];
#pragma unroll
    for (int i = 0; i < 8; ++i) ksv[i] = 1.f;
    if (kscale) {
#pragma unroll
        for (int i = 0; i < 8; ++i) ksv[i] = kscale[k0 + 8 * i + (lane >> 3)];
    }
    const int scc = srccol0 >= 0 ? srccol0 : 0; const float zf = srccol0 >= 0 ? 1.f : 0.f;
#pragma unroll
    for (int i = 0; i < 8; ++i) { const int kk = 8 * i + (lane >> 3);
        v[i] = __builtin_nontemporal_load((const f32x4*)(W + (size_t)(k0 + kk) * ldw + scc + sc8 * 4)); }
#pragma unroll
    for (int i = 0; i < 8; ++i) { const int kk = 8 * i + (lane >> 3); f32x4 x = v[i] * (zf * ksv[i]);
        LAS float* d = scr + kk * 33 + (lane & 7) * 4; d[0] = x[0]; d[1] = x[1]; d[2] = x[2]; d[3] = x[3]; }
    LDS_WAIT(); asm volatile("" ::: "memory");
    const int c = lane & 7;
#pragma unroll
    for (int j = 0; j < 4; ++j) { const int n = (lane >> 3) + 8 * j; const LAS float* s = scr + (8 * c) * 33 + n;
        u32x4 o; o.x = pk2(s[0 * 33], s[1 * 33]); o.y = pk2(s[2 * 33], s[3 * 33]); o.z = pk2(s[4 * 33], s[5 * 33]); o.w = pk2(s[6 * 33], s[7 * 33]);
        __builtin_nontemporal_store(o, (u32x4*)(dst + (size_t)n * K + k0 + 8 * c)); }
    LDS_WAIT(); asm volatile("" ::: "memory");
}
__device__ __forceinline__ int zsrc_col(int n) {
    if (n < 1024) return n;
    if (n < 2048) { const int t = (n - 1024) >> 8, j = (n - 1024) & 255; return j < 128 ? 1024 + 128 * t + j : 1536 + 128 * t + (j - 128); }
    if (n < 3520) return n;
    if (n < 3584) return -1;
    if (n < NZ) return n + 64;
    if (n < NZ + 128) return 3520 + (n - NZ);
    return -1;
}
constexpr int CV_GU = 2 * (NGU / 32) * (D / 64), CV_D = 2 * (D / 32) * (DFF / 64), CV_IN = (NZW / 32) * (D / 64), CV_UQ = (768 / 32) * (512 / 64), CV_KV = (1024 / 32) * (256 / 64),
              CV_BR = 4 * (D / 32) * (512 / 64), CV_OUT = (D / 32) * (D / 64), CV_LAYER = CV_GU + CV_D + CV_IN + CV_UQ + CV_KV + CV_BR + CV_OUT;
constexpr int CV_E0 = CV_GU / 2, CV_E1 = CV_E0 + CV_D / 2, CV_E2 = CV_E1 + CV_IN, CV_E3 = CV_E2 + CV_UQ, CV_E4 = CV_E3 + CV_KV, CV_E5 = CV_E4 + CV_BR, CV_E6 = CV_E5 + CV_OUT, CV_E7 = CV_E6 + CV_GU / 2, CV_E8 = CV_E7 + CV_D / 2;
static_assert(CV_E8 == CV_LAYER, "conversion item count");
constexpr int CW_QHEAD = 2048, CW_DONE = 2112;
__device__ __forceinline__ void cvt_item_idx(const Ctx& C, unsigned char* ws, int it, LAS float* scr, int lane) {
    const int l = it / CV_LAYER; int r = it - l * CV_LAYER;
    const float* W; int ldw, sc0, K, k0; bf16_t* dst; const float* ks = nullptr; bool perm = false;
    if (r < CV_E0 || (r >= CV_E6 && r < CV_E7)) { const int f = r >= CV_E6; if (f) r -= CV_E6; const int kb = r / (NGU / 32), nb = r - kb * (NGU / 32); const int n = nb * 32, tile = n >> 8, j = n & 255;
        W = (j < 128 ? C.in(I_WG) : C.in(I_WU)) + (size_t)(l * 2 + f) * D * DFF; ldw = DFF; sc0 = 128 * tile + (j & 127); dst = WLP(bf16_t, l, WL_GU) + ((size_t)f * NGU + n) * D; K = D; k0 = kb * 64; }
    else if (r < CV_E1 || r >= CV_E7) { const int f = r >= CV_E7; r -= f ? CV_E7 : CV_E0; const int kb = r / (D / 32), nb = r - kb * (D / 32);
        W = C.in(I_WD) + (size_t)(l * 2 + f) * DFF * D; ldw = D; sc0 = nb * 32; dst = WLP(bf16_t, l, WL_D) + ((size_t)f * D + nb * 32) * DFF; K = DFF; k0 = kb * 64; }
    else if (r < CV_E2) { r -= CV_E1; const int kb = r / (NZW / 32), nb = r - kb * (NZW / 32);
        W = C.in(I_WIN) + (size_t)l * D * NIN; ldw = NIN; sc0 = zsrc_col(nb * 32); perm = (nb >= ZC_KR / 32 && nb < 3520 / 32); dst = WLP(bf16_t, l, WL_IN) + (size_t)nb * 32 * D; K = D; k0 = kb * 64; }
    else if (r < CV_E3) { r -= CV_E2; const int kb = r / 24, nb = r - kb * 24;
        W = C.in(I_WUQ) + (size_t)l * 512 * 768; ldw = 768; sc0 = nb * 32; perm = (nb % 6) >= 4; dst = WLP(bf16_t, l, WL_UQ) + (size_t)nb * 32 * 512; K = 512; k0 = kb * 64; ks = C.in(I_QNORM) + l * 512; }
    else if (r < CV_E4) { r -= CV_E3; const int kb = r / 32, nb = r - kb * 32;
        W = C.in(I_WUKV) + (size_t)l * 256 * 1024; ldw = 1024; sc0 = (((nb * 32) & 511) >> 7) * 256 + ((nb * 32) >> 9) * 128 + ((nb * 32) & 127); dst = WLP(bf16_t, l, WL_KV) + (size_t)nb * 32 * 256; K = 256; k0 = kb * 64; ks = C.in(I_KVNORM) + l * 256; }
    else if (r < CV_E5) { r -= CV_E4; const int b = r / (CV_BR / 4); r -= b * (CV_BR / 4); const int kb = r / 64, nb = r - kb * 64;
        W = C.in(I_WBR) + (size_t)(l * 4 + b) * 512 * D; ldw = D; sc0 = nb * 32; dst = WLP(bf16_t, l, WL_BR) + ((size_t)b * D + nb * 32) * 512; K = 512; k0 = kb * 64; }
    else { r -= CV_E5; const int kb = r / 64, nb = r - kb * 64;
        W = C.in(I_WOUT) + (size_t)l * D * D; ldw = D; sc0 = nb * 32; dst = WLP(bf16_t, l, WL_OUT) + (size_t)nb * 32 * D; K = D; k0 = kb * 64; }
    cvt_item(W, ldw, sc0, dst, K, k0, ks, scr, lane, perm);
}
__device__ __forceinline__ void cvt_pull(const Ctx& C, LAS unsigned char* lds, int mand_end, int done_word  , int G) {
    const int tid = fresh_tid(), lane = tid & 63, wid = tid >> 6;
    volatile LAS unsigned* sh = (volatile LAS unsigned*)(lds + 8 * 8448);
    if (done_word && tid == 0) (void)__hip_atomic_fetch_add((unsigned*)(C.ws() + WS_CTL) + done_word, 1u, __ATOMIC_RELAXED, __HIP_MEMORY_SCOPE_AGENT);
    for (;;) {
        __syncthreads();
        if (tid == 0) { unsigned* const ctl = (unsigned*)(C.ws() + WS_CTL); const unsigned h = __hip_atomic_load(ctl + CW_QHEAD, __ATOMIC_RELAXED, __HIP_MEMORY_SCOPE_AGENT); bool go = false;
            if (h < (unsigned)(DEPTH * CV_LAYER)) { if (h < (unsigned)mand_end) go = true; else if (done_word && __hip_atomic_load(ctl + done_word, __ATOMIC_RELAXED, __HIP_MEMORY_SCOPE_AGENT) < (unsigned)G) go = true; }
            sh[0] = go ? __hip_atomic_fetch_add(ctl + CW_QHEAD, 16u, __ATOMIC_RELAXED, __HIP_MEMORY_SCOPE_AGENT) : 0xffffffffu; }
        __syncthreads();
        const unsigned base = sh[0];
        if (base == 0xffffffffu) break;
#pragma unroll 1
        for (int i = 0; i < 2; ++i) { const int it = (int)base + wid * 2 + i; if (it < DEPTH * CV_LAYER) cvt_item_idx(C, C.ws(), it, (LAS float*)(lds + wid * 8448), lane); }
    }
}
__device__ __forceinline__ void prologue_phase(const Ctx& C, LAS unsigned char* lds, int G, int bid) {
    unsigned char* const ws = C.ws();
    const int tid = fresh_tid(), lane = tid & 63, wid = tid >> 6;
    if (bid == 0) { float* tab = WSP(float, WS_TAB);
        for (int i = tid; i < 64 * 16; i += 512) { const int pos = i >> 4, f = i & 15; const float ang = (float)pos * exp2f(-(float)f * (13.287712379549449f / 16.f)); float s, c; sincosf(ang, &s, &c); tab[2 * i] = c; tab[2 * i + 1] = s; } }
    {
        LAS float* SC = (LAS float*)lds; LAS float* PART = (LAS float*)(lds + 40960);
        { const float* const cp = C.in(I_C); const float* const cc = C.in(I_CCTX); float xs[20];
#pragma unroll
          for (int j = 0; j < 20; ++j) { const int i = tid + 512 * j; xs[j] = j < 16 ? cp[i] : cc[i - 4 * D]; }
#pragma unroll
          for (int j = 0; j < 20; ++j) { const float x = xs[j]; SC[tid + 512 * j] = x / (1.f + expf(-x)); } }
        __syncthreads();
        const int kg = tid >> 3, ct = tid & 7;
        for (int it = bid; it < DEPTH * (NMOD / 32); it += G) { const int l = it / (NMOD / 32), ng = it - l * (NMOD / 32);
            const float* wp = C.in(I_WMOD) + ((size_t)l * D + kg * 32) * NMOD + ng * 32 + ct * 4;
            f32x4 a[5];
#pragma unroll
            for (int s = 0; s < 5; ++s) a[s] = (f32x4){0.f, 0.f, 0.f, 0.f};
#pragma unroll 4
            for (int kk = 0; kk < 32; ++kk) { const f32x4 w = __builtin_nontemporal_load((const f32x4*)(wp + (size_t)kk * NMOD));
#pragma unroll
                for (int s = 0; s < 5; ++s) a[s] += w * SC[s * D + kg * 32 + kk]; }
#pragma unroll
            for (int s = 0; s < 5; ++s) *(LAS f32x4*)(PART + (kg * 5 + s) * 32 + ct * 4) = a[s];
            __syncthreads();
            if (tid < 160) { const int s = tid >> 5, cc = tid & 31; float v = C.in(I_BMOD)[(size_t)l * NMOD + ng * 32 + cc];
                for (int k2 = 0; k2 < 64; ++k2) v += PART[(k2 * 5 + s) * 32 + cc];
                WSP(float, WS_MOD)[((size_t)l * 5 + s) * NMOD + ng * 32 + cc] = v; }
            __syncthreads();
        }
    }
    { const int gt = bid * 512 + tid, GT = G * 512;
        for (int i = gt; i < DEPTH * 65536; i += GT) { const int l = i >> 16; WLP(bf16_t, l, WL_GMW)[i & 65535] = (bf16_t)f2bf(C.in(I_GMWS)[i]); }
        for (int i = gt; i < DEPTH * NZW; i += GT) { const int l = i / NZW, n = i - l * NZW; int nn = n; if (n >= ZC_KR && n < 3520) { const int pp = n & 31; nn = (n & ~31) + 4 * (pp >> 3) + (pp & 3) + 16 * ((pp >> 2) & 1); }
            const int sc = zsrc_col(nn); WLP(float, l, WL_BZ)[n] = sc >= 0 ? C.in(I_BIN)[(size_t)l * NIN + sc] : 0.f; } }
    __syncthreads();
    cvt_pull(C, lds, CV_E0, 0, G);
}

struct NormArgs { const float* xin_lat; const float* xin_ctx; float* xout_lat; float* xout_ctx; const bf16_t* Y; const float* part; bf16_t* H; };
#define NCOL(r, j) (4 * lane + 256 * (((j) + (r)) & 7))
__device__ __forceinline__ void norm_row_load(const NormArgs& A, int r, int lane, f32x4 (&x)[8], u32x2 (&yr)[8]) {
    const float* xi = r < ML ? A.xin_lat + (size_t)r * D : A.xin_ctx + (size_t)(r - ML) * D;
#pragma unroll
    for (int j = 0; j < 8; ++j) x[j] = __builtin_nontemporal_load((const f32x4*)(xi + NCOL(r, j)));
    if (A.Y && !(A.part && r >= ML)) {
#pragma unroll
        for (int j = 0; j < 8; ++j) yr[j] = __builtin_nontemporal_load((const u32x2*)(A.Y + (size_t)r * D + NCOL(r, j)));
    }
}
__device__ __forceinline__ void norm_row_compute(const NormArgs& A, const LAS float* V, int r, int lane, f32x4 (&x)[8], u32x2 (&yr)[8]) {
    const float* xi = r < ML ? A.xin_lat + (size_t)r * D : A.xin_ctx + (size_t)(r - ML) * D;
    float* xo = r < ML ? A.xout_lat + (size_t)r * D : A.xout_ctx + (size_t)(r - ML) * D;
    if (A.Y) {
        if (A.part && r >= ML) {
#pragma unroll
            for (int j = 0; j < 8; ++j) { const float* pp = A.part + (size_t)(r - ML) * D + NCOL(r, j); f32x4 pq[8];
#pragma unroll
                for (int q = 0; q < 8; ++q) pq[q] = __builtin_nontemporal_load((const f32x4*)(pp + (size_t)q * MC * D));
                __builtin_amdgcn_sched_barrier(0);
                const f32x4 a = ((pq[0] + pq[1]) + (pq[2] + pq[3])) + ((pq[4] + pq[5]) + (pq[6] + pq[7]));
                yr[j].x = cvt_pk_bf16(a[0], a[1]); yr[j].y = cvt_pk_bf16(a[2], a[3]); }
        }
        float ss = 0.f;
#pragma unroll
        for (int j = 0; j < 8; ++j) { const float y0 = bflo(yr[j].x), y1 = bfhi(yr[j].x), y2 = bflo(yr[j].y), y3 = bfhi(yr[j].y); ss += (y0 * y0 + y1 * y1) + (y2 * y2 + y3 * y3); }
        const float rs = __builtin_amdgcn_rsqf(wave_sum(ss) * (1.f / D) + EPS);
#pragma unroll
        for (int j = 0; j < 8; ++j) { const f32x4 y = (f32x4){bflo(yr[j].x), bfhi(yr[j].x), bflo(yr[j].y), bfhi(yr[j].y)}; x[j] += *(const LAS f32x4*)(V + NCOL(r, j)) * (y * rs); }
    }
    if (A.Y || xi != xo) {
#pragma unroll
        for (int j = 0; j < 8; ++j) __builtin_nontemporal_store(x[j], (f32x4*)(xo + NCOL(r, j)));
    }
    if (A.H) {
        float ss = 0.f;
#pragma unroll
        for (int j = 0; j < 8; ++j) ss += (x[j][0] * x[j][0] + x[j][1] * x[j][1]) + (x[j][2] * x[j][2] + x[j][3] * x[j][3]);
        const float rs = __builtin_amdgcn_rsqf(wave_sum(ss) * (1.f / D) + EPS);
#pragma unroll
        for (int j = 0; j < 8; ++j) { const f32x4 h = (x[j] * rs) * *(const LAS f32x4*)(V + D + NCOL(r, j)) + *(const LAS f32x4*)(V + 2 * D + NCOL(r, j)); u32x2 w; w.x = cvt_pk_bf16(h[0], h[1]); w.y = cvt_pk_bf16(h[2], h[3]);
            *(u32x2*)(A.H + (size_t)r * D + NCOL(r, j)) = w; }
    }
}
__device__ __forceinline__ void norm_phase(LAS unsigned char* lds, int G, int bid, int rows, const float* xin_lat, const float* xin_ctx, float* xout_lat, float* xout_ctx,
                                           const bf16_t* Y, const float* part  , const float* modg  , int kgate, float coef, const float* gpost,
                                           bf16_t* H, const float* modh  , int kshift, const float* gpre) {
    const int tid = fresh_tid(), lane = tid & 63, wid = tid >> 6;
    const NormArgs A{xin_lat, xin_ctx, xout_lat, xout_ctx, Y, part, H};
    LAS float* V = (LAS float*)lds;
    const int stride = G * 8; int s_have = -1;
    for (int r0 = bid * 8; r0 < rows; r0 += 2 * stride) {
        const int r = r0 + wid, r2 = r + stride; const bool two = r0 + stride < rows;
        const int s = r0 < ML ? (r0 >> 12) : 4;
        if (s != s_have) { __syncthreads();
            { const int c = 4 * tid; f32x4 gg = (f32x4){0.f, 0.f, 0.f, 0.f}, a = gg, b = gg;
              if (Y) gg = *(const f32x4*)(modg + (size_t)s * NMOD + kgate * D + c) * *(const f32x4*)(gpost + c) * coef;
              if (H) { a = *(const f32x4*)(gpre + c) * (*(const f32x4*)(modh + (size_t)s * NMOD + (kshift + 1) * D + c) + 1.f); b = *(const f32x4*)(modh + (size_t)s * NMOD + kshift * D + c); }
              *(LAS f32x4*)(V + c) = gg; *(LAS f32x4*)(V + D + c) = a; *(LAS f32x4*)(V + 2 * D + c) = b; }
            __syncthreads(); s_have = s; }
        f32x4 xa[8], xb[8]; u32x2 ya[8], yb[8];
#pragma unroll
        for (int j = 0; j < 8; ++j) { ya[j] = (u32x2){0u, 0u}; yb[j] = (u32x2){0u, 0u}; xb[j] = (f32x4){0.f, 0.f, 0.f, 0.f}; }
        norm_row_load(A, r, lane, xa, ya);
        if (two) norm_row_load(A, r2, lane, xb, yb);
        norm_row_compute(A, V, r, lane, xa, ya);
        if (two) norm_row_compute(A, V, r2, lane, xb, yb);
    }
    __syncthreads();
}
#undef NCOL

__device__ __forceinline__ f32x4 mfma16(bf16x8 a, bf16x8 b, f32x4 c) { return __builtin_amdgcn_mfma_f32_16x16x32_bf16(a, b, c, 0, 0, 0); }
__device__ __forceinline__ void gmlp_chunk(const Ctx& C, int l, LAS unsigned char* lds, int R0, int g_lo) {
    unsigned char* const ws = C.ws();
    const bf16_t* Z = WSP(const bf16_t, WS_Z); bf16_t* YA = WSP(bf16_t, WS_YBR);
    const float* lng = C.in(I_GMLNG) + l * 512; const float* lnb = C.in(I_GMLNB) + l * 512; const float* bs = C.in(I_GMBS) + l * 512; const bf16_t* WS = WLP(const bf16_t, l, WL_GMW);
    LAS float* stats = (LAS float*)lds; LAS bf16_t* vnT = (LAS bf16_t*)(lds + 1024);
    const int tid = fresh_tid(), lane = tid & 63, wid = tid >> 6, i16 = lane & 15, g4 = lane >> 4;
    for (int rr = 0; rr < 16; ++rr) { const int q = 16 * wid + rr; const u32x4 w = *(const u32x4*)(Z + (size_t)(R0 + q) * NZ + 512 + 8 * lane);
        const float v[8] = {bflo(w.x), bfhi(w.x), bflo(w.y), bfhi(w.y), bflo(w.z), bfhi(w.z), bflo(w.w), bfhi(w.w)};
        float s = 0.f;
#pragma unroll
        for (int e = 0; e < 8; ++e) s += v[e];
        const float mean = wave_sum(s) * (1.f / 512.f); float q2 = 0.f;
#pragma unroll
        for (int e = 0; e < 8; ++e) { const float d = v[e] - mean; q2 += d * d; }
        const float rstd = __builtin_amdgcn_rsqf(wave_sum(q2) * (1.f / 512.f) + EPS);
        if (lane == 0) { stats[2 * q] = mean; stats[2 * q + 1] = rstd; } }
    __syncthreads();
    for (int g = g_lo; g < g_lo + 2; ++g) {
        u32x4 wj[4];
#pragma unroll
        for (int j = 0; j < 4; ++j) { const int id = tid + 512 * j, q = id >> 4, cc = id & 15; wj[j] = *(const u32x4*)(Z + (size_t)(R0 + q) * NZ + 512 + g * 128 + 8 * cc); }
        __builtin_amdgcn_sched_barrier(0);
#pragma unroll
        for (int j = 0; j < 4; ++j) { const int id = tid + 512 * j, q = id >> 4, cc = id & 15; const u32x4 w = wj[j];
            const float v[8] = {bflo(w.x), bfhi(w.x), bflo(w.y), bfhi(w.y), bflo(w.z), bfhi(w.z), bflo(w.w), bfhi(w.w)};
            const float mean = stats[2 * q], rstd = stats[2 * q + 1];
            const f32x4 g0 = *(const f32x4*)(lng + g * 128 + 8 * cc), g1 = *(const f32x4*)(lng + g * 128 + 8 * cc + 4), b0 = *(const f32x4*)(lnb + g * 128 + 8 * cc), b1 = *(const f32x4*)(lnb + g * 128 + 8 * cc + 4);
            const float gg[8] = {g0[0], g0[1], g0[2], g0[3], g1[0], g1[1], g1[2], g1[3]}, bb[8] = {b0[0], b0[1], b0[2], b0[3], b1[0], b1[1], b1[2], b1[3]};
#pragma unroll
            for (int e = 0; e < 8; ++e) vnT[(8 * cc + e) * 136 + q] = (bf16_t)f2bf((v[e] - mean) * rstd * gg[e] + bb[e]); }
        __syncthreads();
        bf16x8 bw[4];
#pragma unroll
        for (int ks = 0; ks < 4; ++ks) bw[ks] = *(const bf16x8*)(WS + (size_t)(g * 128 + 16 * wid + i16) * 128 + 32 * ks + 8 * g4);
        f32x4 acc[8];
#pragma unroll
        for (int ct = 0; ct < 8; ++ct) { acc[ct] = (f32x4){0.f, 0.f, 0.f, 0.f};
#pragma unroll
            for (int ks = 0; ks < 4; ++ks) { const bf16x8 a = *(const LAS bf16x8*)(vnT + (16 * ct + i16) * 136 + 32 * ks + 8 * g4); acc[ct] = mfma16(a, bw[ks], acc[ct]); } }
        const int prow = R0 + 16 * wid + i16; const float bsv = bs[g * 128 + 16 * wid + i16];
        u32x2 uwv[8];
#pragma unroll
        for (int ct = 0; ct < 8; ++ct) uwv[ct] = *(const u32x2*)(Z + (size_t)prow * NZ + g * 128 + 16 * ct + 4 * g4);
        __builtin_amdgcn_sched_barrier(0);
#pragma unroll
        for (int ct = 0; ct < 8; ++ct) { const int c4 = g * 128 + 16 * ct + 4 * g4; const u32x2 uw = uwv[ct];
            u32x2 o; o.x = cvt_pk_bf16(bflo(uw.x) * (acc[ct][0] + bsv), bfhi(uw.x) * (acc[ct][1] + bsv)); o.y = cvt_pk_bf16(bflo(uw.y) * (acc[ct][2] + bsv), bfhi(uw.y) * (acc[ct][3] + bsv));
            *(u32x2*)(YA + (size_t)prow * 512 + c4) = o; }
        __syncthreads();
    }
}
__device__ __forceinline__ void conv_block(const Ctx& C, int l, LAS unsigned char* lds, int SR0, int SL, int p0) {
    unsigned char* const ws = C.ws();
    const bf16_t* HB = WSP(const bf16_t, WS_HB); bf16_t* YB = WSP(bf16_t, WS_YBR) + (size_t)MT * 512;
    const float* lng = C.in(I_CVLNG) + l * 512; const float* lnb = C.in(I_CVLNB) + l * 512;
    LAS float* tile = (LAS float*)lds;
    const int tid = fresh_tid(), lane = tid & 63, wid = tid >> 6;
    float dw[31]; const float db = C.in(I_CVDB)[l * 512 + tid]; const float* const dwp = C.in(I_CVDW) + (size_t)l * 31 * 512 + tid;
#pragma unroll
    for (int j = 0; j < 31; ++j) dw[j] = dwp[j * 512];
    __builtin_amdgcn_sched_barrier(0);
    float hv[62]; unsigned raw[62];
#pragma unroll
    for (int j = 0; j < 62; ++j) { const int p = p0 - 15 + j; const int pc = p < 0 ? 0 : (p >= SL ? SL - 1 : p);
        raw[j] = HB[(size_t)(SR0 + pc) * 512 + tid]; }
    __builtin_amdgcn_sched_barrier(0);
#pragma unroll
    for (int j = 0; j < 62; ++j) { const int p = p0 - 15 + j; hv[j] = (p >= 0 && p < SL) ? __builtin_bit_cast(float, raw[j] << 16) : 0.f; }
#pragma unroll
    for (int o = 0; o < 32; ++o) { float s = db;
#pragma unroll
        for (int j = 0; j < 31; ++j) s += dw[j] * hv[o + j];
        tile[o * 512 + tid] = s; }
    __syncthreads();
    const f32x4 lga = *(const f32x4*)(lng + 4 * lane), lgb = *(const f32x4*)(lng + 256 + 4 * lane), lba = *(const f32x4*)(lnb + 4 * lane), lbb = *(const f32x4*)(lnb + 256 + 4 * lane);
#pragma unroll
    for (int rr = 0; rr < 4; ++rr) { const int o = 4 * wid + rr; f32x4 a = *(const LAS f32x4*)(tile + o * 512 + 4 * lane), b = *(const LAS f32x4*)(tile + o * 512 + 256 + 4 * lane);
        const float mean = wave_sum((a[0] + a[1]) + (a[2] + a[3]) + (b[0] + b[1]) + (b[2] + b[3])) * (1.f / 512.f);
        a = a - mean; b = b - mean;
        const float rstd = __builtin_amdgcn_rsqf(wave_sum((a[0] * a[0] + a[1] * a[1]) + (a[2] * a[2] + a[3] * a[3]) + (b[0] * b[0] + b[1] * b[1]) + (b[2] * b[2] + b[3] * b[3])) * (1.f / 512.f) + EPS);
        const f32x4 ya = a * rstd * lga + lba, yb = b * rstd * lgb + lbb;
        u32x2 wa, wb; wa.x = cvt_pk_bf16(ya[0] * sigmoidf_(ya[0]), ya[1] * sigmoidf_(ya[1])); wa.y = cvt_pk_bf16(ya[2] * sigmoidf_(ya[2]), ya[3] * sigmoidf_(ya[3]));
        wb.x = cvt_pk_bf16(yb[0] * sigmoidf_(yb[0]), yb[1] * sigmoidf_(yb[1])); wb.y = cvt_pk_bf16(yb[2] * sigmoidf_(yb[2]), yb[3] * sigmoidf_(yb[3]));
        bf16_t* op = YB + (size_t)(SR0 + p0 + o) * 512; *(u32x2*)(op + 4 * lane) = wa; *(u32x2*)(op + 256 + 4 * lane) = wb; }
    __syncthreads();
}

struct AttnSrc { const bf16_t* k1; int k1ld; const bf16_t* k2; int k2ld; const bf16_t* vt; };
template <int DK1, int DK2, int DV> struct AttnGeo {
    static constexpr int DK = DK1 + DK2, KS = DK / 32, DT = DV / 16, KROW = DK + 8, VROW = 72, KC = DK / 8, NKC = 64 * KC / 512, NVC = DV * 8 / 512, KBYTES = 64 * KROW * 2, BUF = KBYTES + DV * VROW * 2;
    static_assert((64 * KC) % 512 == 0 && (DV * 8) % 512 == 0, "staging geometry");
};
template <int DK1, int DK2, int DV>
__device__ __forceinline__ void attn_load(const AttnSrc& S, int row0, int tid, u32x4 (&kr)[AttnGeo<DK1, DK2, DV>::NKC], u32x4 (&vr)[AttnGeo<DK1, DK2, DV>::NVC]) {
    typedef AttnGeo<DK1, DK2, DV> Gm;
#pragma unroll
    for (int i = 0; i < Gm::NKC; ++i) { const int c = tid + 512 * i, key = c / Gm::KC, part = c - key * Gm::KC;
        const bf16_t* src = (part < DK1 / 8) ? S.k1 + (size_t)(row0 + key) * S.k1ld + part * 8 : S.k2 + (size_t)(row0 + key) * S.k2ld + (part - DK1 / 8) * 8; kr[i] = *(const u32x4*)src; }
#pragma unroll
    for (int i = 0; i < Gm::NVC; ++i) { const int c = tid + 512 * i, d = c >> 3, c8 = c & 7; vr[i] = *(const u32x4*)(S.vt + (size_t)d * MT + row0 + 8 * c8); }
}
template <int DK1, int DK2, int DV>
__device__ __forceinline__ void attn_store(LAS unsigned char* buf, int tid, const u32x4 (&kr)[AttnGeo<DK1, DK2, DV>::NKC], const u32x4 (&vr)[AttnGeo<DK1, DK2, DV>::NVC]) {
    typedef AttnGeo<DK1, DK2, DV> Gm; LAS bf16_t* Ks = (LAS bf16_t*)buf; LAS bf16_t* Vt = (LAS bf16_t*)(buf + Gm::KBYTES);
#pragma unroll
    for (int i = 0; i < Gm::NKC; ++i) { const int c = tid + 512 * i, key = c / Gm::KC, part = c - key * Gm::KC;
        const int rho = (key & 32) + 16 * ((key >> 2) & 1) + 4 * ((key >> 3) & 3) + (key & 3);
        *(LAS u32x4*)(Ks + rho * Gm::KROW + part * 8) = kr[i]; }
#pragma unroll
    for (int i = 0; i < Gm::NVC; ++i) { const int c = tid + 512 * i, d = c >> 3, c8 = c & 7; *(LAS u32x4*)(Vt + d * Gm::VROW + 8 * c8) = vr[i]; }
}
template <int DT, bool MASK>
__device__ __forceinline__ void attn_softmax(f32x4 (&st)[2], float& m, float& l, f32x4 (&ot)[DT], bf16x8& pf, int kp0  , bool masked) {
    if (MASK && masked) {
#pragma unroll
        for (int t2 = 0; t2 < 2; ++t2)
#pragma unroll
            for (int r = 0; r < 4; ++r) if ((unsigned)(kp0 + 4 * t2 + r) > 256u) st[t2][r] = -1e30f;
    }
    float mx = __builtin_fmaxf(__builtin_fmaxf(__builtin_fmaxf(st[0][0], st[0][1]), __builtin_fmaxf(st[0][2], st[0][3])), __builtin_fmaxf(__builtin_fmaxf(st[1][0], st[1][1]), __builtin_fmaxf(st[1][2], st[1][3])));
    { auto r16 = __builtin_amdgcn_permlane16_swap(__builtin_bit_cast(unsigned, mx), __builtin_bit_cast(unsigned, mx), false, false);
      mx = __builtin_fmaxf(__builtin_bit_cast(float, r16[0]), __builtin_bit_cast(float, r16[1]));
      auto r32 = __builtin_amdgcn_permlane32_swap(__builtin_bit_cast(unsigned, mx), __builtin_bit_cast(unsigned, mx), false, false);
      mx = __builtin_fmaxf(__builtin_bit_cast(float, r32[0]), __builtin_bit_cast(float, r32[1])); }
    const float mn = __builtin_fmaxf(m, mx);
    if (__any(mn > m)) { const float alpha = fast_exp2(m - mn); l *= alpha;
#pragma unroll
        for (int dt = 0; dt < DT; ++dt) ot[dt] = ot[dt] * alpha; }
    m = mn;
    float ps = 0.f;
#pragma unroll
    for (int t2 = 0; t2 < 2; ++t2)
#pragma unroll
        for (int r = 0; r < 4; ++r) { st[t2][r] = fast_exp2(st[t2][r] - mn); ps += st[t2][r]; }
    union { u32x4 u; bf16x8 b; } q; q.u.x = cvt_pk_bf16(st[0][0], st[0][1]); q.u.y = cvt_pk_bf16(st[0][2], st[0][3]); q.u.z = cvt_pk_bf16(st[1][0], st[1][1]); q.u.w = cvt_pk_bf16(st[1][2], st[1][3]);
    pf = q.b;
    l += ps;
}
template <int DK1, int DK2, int DV, bool MASK>
__device__ __forceinline__ void attn_unit(LAS unsigned char* lds, const AttnSrc& S, const bf16_t* q0p, const bf16_t* q1p, bf16_t* o0p, bf16_t* o1p,
                                          int ctx_row0, int nctx, int loc_row0, int loc_pos0, int nloc, int qpos0, int qpos1, float m0, float l0) {
    typedef AttnGeo<DK1, DK2, DV> Gm; constexpr int KS = Gm::KS, DT = Gm::DT, KROW = Gm::KROW, VROW = Gm::VROW;
    const int tid = fresh_tid(), lane = tid & 63, i16 = lane & 15, g4 = lane >> 4;
    bf16x8 qf0[KS], qf1[KS];
#pragma unroll
    for (int ks = 0; ks < KS; ++ks) { qf0[ks] = *(const bf16x8*)(q0p + 32 * ks + 8 * g4); qf1[ks] = *(const bf16x8*)(q1p + 32 * ks + 8 * g4); }
    f32x4 ot0[DT], ot1[DT];
#pragma unroll
    for (int dt = 0; dt < DT; ++dt) { ot0[dt] = (f32x4){0.f, 0.f, 0.f, 0.f}; ot1[dt] = (f32x4){0.f, 0.f, 0.f, 0.f}; }
    float ma = m0, mb = m0, la = (g4 == 0) ? l0 : 0.f, lb = la;
    const int NT = nctx + nloc;
    u32x4 kr[Gm::NKC], vr[Gm::NVC];
#define TROW(t) ((t) < nctx ? ctx_row0 + 64 * (t) : loc_row0 + 64 * ((t) - nctx))
    attn_load<DK1, DK2, DV>(S, TROW(0), tid, kr, vr);
    __syncthreads();
    attn_store<DK1, DK2, DV>(lds, tid, kr, vr);
    __syncthreads();
    if (NT > 1) attn_load<DK1, DK2, DV>(S, TROW(1), tid, kr, vr);
    for (int tt = 0; tt < NT; ++tt) {
        LAS unsigned char* buf = lds + (tt & 1) * Gm::BUF; const LAS bf16_t* Ks = (const LAS bf16_t*)buf; const LAS bf16_t* Vt = (const LAS bf16_t*)(buf + Gm::KBYTES);
        const bool masked = MASK && tt >= nctx; const int kpb = loc_pos0 + 64 * (tt - nctx) + 8 * g4 + 128;
#pragma unroll
        for (int hh = 0; hh < 2; ++hh) {
            f32x4 sa[2], sb[2];
#pragma unroll
            for (int t2 = 0; t2 < 2; ++t2) { sa[t2] = (f32x4){0.f, 0.f, 0.f, 0.f}; sb[t2] = (f32x4){0.f, 0.f, 0.f, 0.f};
                bf16x8 kf[KS];
#pragma unroll
                for (int ks = 0; ks < KS; ++ks) kf[ks] = *(const LAS bf16x8*)(Ks + (32 * hh + 16 * t2 + i16) * KROW + 32 * ks + 8 * g4);
                __builtin_amdgcn_sched_barrier(0);
#pragma unroll
                for (int ks = 0; ks < KS; ++ks) { sa[t2] = mfma16(kf[ks], qf0[ks], sa[t2]); sb[t2] = mfma16(kf[ks], qf1[ks], sb[t2]); }
                __builtin_amdgcn_sched_barrier(0); }
            bf16x8 pa, pb;
            attn_softmax<DT, MASK>(sa, ma, la, ot0, pa, kpb + 32 * hh - qpos0, masked);
            attn_softmax<DT, MASK>(sb, mb, lb, ot1, pb, kpb + 32 * hh - qpos1, masked);
            __builtin_amdgcn_sched_barrier(0);
#pragma unroll
            for (int d4 = 0; d4 < DT; d4 += 4) { bf16x8 vf[4];
#pragma unroll
                for (int dd = 0; dd < 4; ++dd) vf[dd] = *(const LAS bf16x8*)(Vt + (16 * (d4 + dd) + i16) * VROW + 32 * hh + 8 * g4);
                __builtin_amdgcn_sched_barrier(0);
#pragma unroll
                for (int dd = 0; dd < 4; ++dd) { ot0[d4 + dd] = mfma16(vf[dd], pa, ot0[d4 + dd]); ot1[d4 + dd] = mfma16(vf[dd], pb, ot1[d4 + dd]); }
                __builtin_amdgcn_sched_barrier(0); }
        }
        if (tt + 1 < NT) attn_store<DK1, DK2, DV>(lds + ((tt + 1) & 1) * Gm::BUF, tid, kr, vr);
        __syncthreads();
        if (tt + 2 < NT) attn_load<DK1, DK2, DV>(S, TROW(tt + 2), tid, kr, vr);
    }
#undef TROW
    float lt = la + __shfl_xor(la, 16); lt += __shfl_xor(lt, 32); const float ia = 1.f / lt;
    lt = lb + __shfl_xor(lb, 16); lt += __shfl_xor(lt, 32); const float ib = 1.f / lt;
#pragma unroll
    for (int dt = 0; dt < DT; ++dt) { u32x2 w; w.x = cvt_pk_bf16(ot0[dt][0] * ia, ot0[dt][1] * ia); w.y = cvt_pk_bf16(ot0[dt][2] * ia, ot0[dt][3] * ia); *(u32x2*)(o0p + 16 * dt + 4 * g4) = w;
        w.x = cvt_pk_bf16(ot1[dt][0] * ib, ot1[dt][1] * ib); w.y = cvt_pk_bf16(ot1[dt][2] * ib, ot1[dt][3] * ib); *(u32x2*)(o1p + 16 * dt + 4 * g4) = w; }
}

constexpr int NPHASE = 2 + 12 * DEPTH;
__global__ void __launch_bounds__(512, 2) mk_fwd(Params P) {
    extern __shared__ __attribute__((aligned(16))) unsigned char lds_raw[];
    LAS unsigned char* lds = (LAS unsigned char*)lds_raw;
    const int tid = fresh_tid();
    volatile LAS unsigned* MISC = (volatile LAS unsigned*)(lds + MISC_OFF);
    for (int u = tid; u < (LDS_BYTES - RING_BYTES) / 4; u += 512) ((LAS unsigned*)(lds + RING_BYTES))[u] = 0u;
    __syncthreads();
    Ctx C; C.tab = (volatile LAS unsigned*)(lds + PTAB_OFF);
    if (tid == 0) {
#pragma unroll
        for (int i = 0; i < 28; ++i) { const unsigned long long v = (unsigned long long)P.in[i]; C.tab[2 * i] = (unsigned)v; C.tab[2 * i + 1] = (unsigned)(v >> 32); }
        { const unsigned long long v = (unsigned long long)P.out; C.tab[56] = (unsigned)v; C.tab[57] = (unsigned)(v >> 32); }
        { const unsigned long long v = (unsigned long long)P.ws; C.tab[58] = (unsigned)v; C.tab[59] = (unsigned)(v >> 32); }
        C.tab[60] = (unsigned)P.ph_lo; C.tab[61] = (unsigned)P.ph_hi;
    }
    __syncthreads();
    if (!MK_MULTI) (void)xcd_barrier_post((unsigned*)(C.ws() + WS_CTL) + CW_BAR, MISC + 8);
#define LO ((int)__builtin_amdgcn_readfirstlane(C.tab[60]))
#define HI ((int)__builtin_amdgcn_readfirstlane(C.tab[61]))
#define IN(k) (LO <= (k) && (k) < HI)
#define MKBAR XcdBarrier bar; bar.bar = (unsigned*)(C.ws() + WS_CTL) + CW_BAR; bar.x = xb_xcc_id(); bar.st = (volatile LAS unsigned*)(lds + MISC_OFF) + 8
#define SEAM(k) do { if (!MK_MULTI && IN(k) && IN((k) + 1)) { MKBAR; xcd_barrier(bar); } } while (0)
#define GRID const int G = gridDim.x, bid = blockIdx.x

    if (IN(0) && EN(12)) for (int _rep = 0; _rep < (((PROBE_MASK >> 12) & 1) ? 2 : 1); ++_rep) { if (_rep) { MKBAR; xcd_barrier(bar); } GRID; prologue_phase(C, lds, G, bid); }
    SEAM(0);

    for (int l = 0; l < DEPTH; ++l) {
        const int pb = 1 + 12 * l; const bool last = (l == DEPTH - 1);
        if (IN(pb + 0) && EN(0)) for (int _rep = 0; _rep < (((PROBE_MASK >> 0) & 1) ? 2 : 1); ++_rep) { if (_rep) { MKBAR; xcd_barrier(bar); } GRID; unsigned char* const ws = C.ws(); float* const out = C.out(); float* const XC = WSP(float, WS_XC);
            const float* modl = WSP(const float, WS_MOD) + (size_t)l * 5 * NMOD; const float* npre = C.in(I_NPRE) + (size_t)l * 3 * D; const float* npost = C.in(I_NPOST) + (size_t)l * 3 * D;
            if (PROBE_MASK & 0x2000) { if (l == 0) { norm_phase(lds, G, bid, MT, C.in(I_X), C.in(I_CTX), (float*)(ws + WS_Z), (float*)(ws + WS_Z) + (size_t)ML * D, nullptr, nullptr, modl, 0, 0.f, nullptr, (bf16_t*)(ws + WS_Z + 160 * MiB), modl, 0, npre); } { MKBAR; xcd_barrier(bar); } }
            if (PROBE_MASK & 0x2000) { if (l != 0) { norm_phase(lds, G, bid, MT, out, XC, (float*)(ws + WS_Z), (float*)(ws + WS_Z) + (size_t)ML * D, WSP(const bf16_t, WS_Y), G >= 256 ? WSP(const float, WS_PART) : nullptr, modl - (size_t)5 * NMOD, 8, 0.5f, npost - D, (bf16_t*)(ws + WS_Z + 160 * MiB), modl, 0, npre); } { MKBAR; xcd_barrier(bar); } }
            if (l == 0) norm_phase(lds, G, bid, MT, C.in(I_X), C.in(I_CTX), (float*)C.in(I_X), (float*)C.in(I_CTX)  , nullptr, nullptr, modl, 0, 0.f, nullptr, WSP(bf16_t, WS_H), modl, 0, npre);
            else norm_phase(lds, G, bid, MT, out, XC, out, XC, WSP(const bf16_t, WS_Y), G >= 256 ? WSP(const float, WS_PART) : nullptr, modl - (size_t)5 * NMOD, 8, 0.5f, npost - D, WSP(bf16_t, WS_H), modl, 0, npre);
        }
        SEAM(pb + 0);
        if (IN(pb + 1) && EN(1)) for (int _rep = 0; _rep < (((PROBE_MASK >> 1) & 1) ? 2 : 1); ++_rep) { if (_rep) { MKBAR; xcd_barrier(bar); } GRID; unsigned char* const ws = C.ws();
            pg8::RectOrder S; S.init(MT / 256, NGU / 256, G, bid, 0, WSP(bf16_t, WS_H), 256 * D * 2, WLP(bf16_t, l, WL_GU), 256 * D * 2);
            pg8::EpiSwiglu E{WSP(bf16_t, WS_Z)}; pg8::gemm_phase<pg8::EpiSwiglu, pg8::RectOrder, true>(lds, D, D, D, S, E); }
        if (IN(pb + 1) && EN(1)) { GRID; cvt_pull(C, lds, l * CV_LAYER + CV_E2, CW_DONE + 64 * (pb + 1), G); }
        SEAM(pb + 1);
        if (IN(pb + 2) && EN(2)) for (int _rep = 0; _rep < (((PROBE_MASK >> 2) & 1) ? 2 : 1); ++_rep) { if (_rep) { MKBAR; xcd_barrier(bar); } GRID; unsigned char* const ws = C.ws();
            const bool split = (G >= 256);
            { pg8::RectOrder S; S.init((split ? ML : MT) / 256, D / 256, G, bid, 0, WSP(bf16_t, WS_Z), 256 * DFF * 2, WLP(bf16_t, l, WL_D), 256 * DFF * 2);
              pg8::EpiPlain<false> E{WSP(bf16_t, WS_Y), D, nullptr}; pg8::gemm_phase<pg8::EpiPlain<false>, pg8::RectOrder, true>(lds, DFF, DFF, DFF, S, E); }
            if (split) { const int tile = bid >> 3, part = bid & 7, ks = part < 5 ? 10 * part : 50 + 12 * (part - 5), kn = part < 5 ? 10 : 12;
              pg8::SplitOrder S; S.pm = ML / 256 + (tile >> 3); S.pn = tile & 7; S.part = part; S.have = bid < 256;
              S.A = (const char*)(WSP(bf16_t, WS_Z) + (size_t)S.pm * 256 * DFF + ks * 64); S.B = (const char*)(WLP(bf16_t, l, WL_D) + (size_t)S.pn * 256 * DFF + ks * 64);
              pg8::EpiPartial E{WSP(float, WS_PART), ML, (size_t)MC * D}; pg8::gemm_phase<pg8::EpiPartial, pg8::SplitOrder, true>(lds, kn * 64, DFF, DFF, S, E); } }
        SEAM(pb + 2);
        if (IN(pb + 3) && EN(3)) for (int _rep = 0; _rep < (((PROBE_MASK >> 3) & 1) ? 2 : 1); ++_rep) { if (_rep) { MKBAR; xcd_barrier(bar); } GRID; unsigned char* const ws = C.ws(); float* const out = C.out(); float* const XC = WSP(float, WS_XC);
            if (PROBE_MASK & 0x2000) { if (true) { norm_phase(lds, G, bid, MT, out, XC, (float*)(ws + WS_Z), (float*)(ws + WS_Z) + (size_t)ML * D, WSP(const bf16_t, WS_Y), G >= 256 ? WSP(const float, WS_PART) : nullptr, WSP(const float, WS_MOD) + (size_t)l * 5 * NMOD, 2, 0.5f, C.in(I_NPOST) + (size_t)l * 3 * D, (bf16_t*)(ws + WS_Z + 160 * MiB), WSP(const float, WS_MOD) + (size_t)l * 5 * NMOD, 3, C.in(I_NPRE) + ((size_t)l * 3 + 1) * D); } { MKBAR; xcd_barrier(bar); } }
            norm_phase(lds, G, bid, MT, l == 0 ? C.in(I_X) : out, l == 0 ? C.in(I_CTX) : XC, out, XC, WSP(const bf16_t, WS_Y), G >= 256 ? WSP(const float, WS_PART) : nullptr, WSP(const float, WS_MOD) + (size_t)l * 5 * NMOD, 2, 0.5f, C.in(I_NPOST) + (size_t)l * 3 * D, WSP(bf16_t, WS_H), WSP(const float, WS_MOD) + (size_t)l * 5 * NMOD, 3, C.in(I_NPRE) + ((size_t)l * 3 + 1) * D); }
        SEAM(pb + 3);
        if (IN(pb + 4) && EN(4)) for (int _rep = 0; _rep < (((PROBE_MASK >> 4) & 1) ? 2 : 1); ++_rep) { if (_rep) { MKBAR; xcd_barrier(bar); } GRID; unsigned char* const ws = C.ws();
            bf16_t* const Z = WSP(bf16_t, WS_Z); bf16_t* const H = WSP(bf16_t, WS_H);
            LAS float* const LTAB = (LAS float*)(lds + LTAB_OFF);
            { const int t_ = fresh_tid(); for (int i = t_; i < 2048; i += 512) LTAB[i] = WSP(const float, WS_TAB)[i]; __syncthreads(); }
            pg8::EpiZ E{Z, WSP(bf16_t, WS_HB), WSP(float, WS_SSP), WLP(const float, l, WL_BZ), LTAB, 0, 0};
            { pg8::RectOrder S; S.init(ML / 256, NZ / 256, G, bid, 0, H, 256 * D * 2, WLP(bf16_t, l, WL_IN), 256 * D * 2);
              pg8::gemm_phase<pg8::EpiZ, pg8::RectOrder, true>(lds, D, D, D, S, E); }
            int used = (ML / 256) * (NZ / 256);
            {
                const int ct0 = last ? 10 : 0, nct = last ? 4 : 14;
                pg8::EpiZ E2{Z, WSP(bf16_t, WS_HB), WSP(float, WS_SSP), WLP(const float, l, WL_BZ), LTAB, ct0, ML};
                pg8::RectOrder S; S.init(MC / 256, nct, G, bid, used, H + (size_t)ML * D, 256 * D * 2, WLP(bf16_t, l, WL_IN) + (size_t)ct0 * 256 * D, 256 * D * 2);
                pg8::gemm_phase<pg8::EpiZ, pg8::RectOrder, true>(lds, D, D, D, S, E2); used += (MC / 256) * nct; }
            {
                pg8::EpiVt<false> E3{WSP(bf16_t, WS_VTD), MT, WLP(const float, l, WL_BZ) + NZ, nullptr};
                pg8::RectOrder S; S.init(1, MT / 256, G, bid, used, WLP(bf16_t, l, WL_IN) + (size_t)NZ * D, 0, H, 256 * D * 2);
                pg8::gemm_phase<pg8::EpiVt<false>, pg8::RectOrder, true>(lds, D, D, D, S, E3); }
        }
        if (IN(pb + 4) && EN(4)) { GRID; cvt_pull(C, lds, l * CV_LAYER + CV_E7, CW_DONE + 64 * (pb + 4), G); }
        SEAM(pb + 4);
        if (IN(pb + 5) && EN(5)) for (int _rep = 0; _rep < (((PROBE_MASK >> 5) & 1) ? 2 : 1); ++_rep) { if (_rep) { MKBAR; xcd_barrier(bar); } GRID;
            const int lm_ = _rep ? PROBE_LOCMASK : LOCMASK;
            const int nch = 2 * ((last ? ML : MT) / 128), ncb = (last ? ML : MT) / 32;
            for (int it = bid; it < nch + ncb; it += G) {
                if (it < nch) { if (lm_ & 1) gmlp_chunk(C, l, lds, (it >> 1) * 128, 2 * (it & 1)); }
                else { const int cb = it - nch; int SR0, SL, p0; if (cb < ML / 32) { SR0 = (cb >> 7) * SEQ; SL = SEQ; p0 = (cb & 127) * 32; } else { const int c2 = cb - ML / 32; SR0 = ML + (c2 >> 3) * CTXL; SL = CTXL; p0 = (c2 & 7) * 32; }
                    if (lm_ & 2) conv_block(C, l, lds, SR0, SL, p0); }
            }
            __syncthreads();
            const int pan_q = (last ? ML : MT) / 256;
            if (!last) { unsigned char* const ws = C.ws();
              LAS float* const LTAB = (LAS float*)(lds + LTAB_OFF);
              pg8::EpiZ E2{WSP(bf16_t, WS_Z), WSP(bf16_t, WS_HB), WSP(float, WS_SSP), WLP(const float, l, WL_BZ), LTAB, 14, ML};
              pg8::RectOrder S; S.init(MC / 256, NZ / 256 - 14, G, bid, G / 2, WSP(bf16_t, WS_H) + (size_t)ML * D, 256 * D * 2, WLP(bf16_t, l, WL_IN) + (size_t)14 * 256 * D, 256 * D * 2);
              pg8::gemm_phase<pg8::EpiZ, pg8::RectOrder, true>(lds, D, D, D, S, E2); }
            if (lm_ & 4) { unsigned char* const ws = C.ws();
              pg8::RectOrder S; S.init(pan_q, 3, G, bid, 0, WSP(bf16_t, WS_Z) + ZC_CQ, 256 * NZ * 2, WLP(bf16_t, l, WL_UQ), 256 * 512 * 2);
              LAS float* const LTAB = (LAS float*)(lds + LTAB_OFF); { const int t_ = fresh_tid(); for (int i = t_; i < 2048; i += 512) LTAB[i] = WSP(const float, WS_TAB)[i]; __syncthreads(); }
              pg8::EpiQ E{WSP(bf16_t, WS_QM), WSP(const float, WS_SSP), LTAB}; pg8::gemm_phase<pg8::EpiQ, pg8::RectOrder, true>(lds, 512, NZ, 512, S, E); }
            if (lm_ & 8) { unsigned char* const ws = C.ws();
              { pg8::RectOrder S; S.init(MT / 256, 2, G, bid, last ? pan_q * 3 : 0, WSP(bf16_t, WS_Z) + ZC_CKV, 256 * NZ * 2, WLP(bf16_t, l, WL_KV), 256 * 256 * 2);
                pg8::EpiPlain<true> E{WSP(bf16_t, WS_KN), 512, WSP(const float, WS_SSP)}; pg8::gemm_phase<pg8::EpiPlain<true>, pg8::RectOrder, true>(lds, 256, NZ, 256, S, E); }
              { pg8::RectOrder S; S.init(2, MT / 256, G, bid, last ? pan_q * 3 + (MT / 256) * 2 : 0, WLP(bf16_t, l, WL_KV) + 512 * 256, 256 * 256 * 2, WSP(bf16_t, WS_Z) + ZC_CKV, 256 * NZ * 2);
                pg8::EpiVt<true> E{WSP(bf16_t, WS_VTM), MT, nullptr, WSP(const float, WS_SSP)}; pg8::gemm_phase<pg8::EpiVt<true>, pg8::RectOrder, true>(lds, 256, 256, NZ, S, E); } }
        }
        SEAM(pb + 5);
        if (IN(pb + 6) && EN(6)) for (int _rep = 0; _rep < (((PROBE_MASK >> 6) & 1) ? 2 : 1); ++_rep) { if (_rep) { MKBAR; xcd_barrier(bar); } GRID; unsigned char* const ws = C.ws();
            bf16_t* const YC = WSP(bf16_t, WS_YBR) + (size_t)2 * MT * 512; bf16_t* const YD = WSP(bf16_t, WS_YBR) + (size_t)3 * MT * 512;
            const bf16_t* const QM = WSP(const bf16_t, WS_QM); const bf16_t* const KN = WSP(const bf16_t, WS_KN); const bf16_t* const Z = WSP(const bf16_t, WS_Z);
            const bf16_t* const VTM = WSP(const bf16_t, WS_VTM); const bf16_t* const VTD = WSP(const bf16_t, WS_VTD);
            const float* const sink = C.in(I_SINK) + l * 8;
            const int tid2 = fresh_tid(), wid = __builtin_amdgcn_readfirstlane(tid2 >> 6), i16 = tid2 & 15;
            for (int u = bid; u < 256; u += G) { const int bh = (u & 7) + 8 * ((u >> 7) & 1), qb = (u >> 3) & 15, b = bh >> 2, h = bh & 3;
                const int row = b * SEQ + 256 * qb + 32 * wid + i16;
                AttnSrc S{KN + h * 128, 512, Z + ZC_KR, NZ, VTM + (size_t)h * 128 * MT};
                attn_unit<128, 64, 128, false>(lds, S, QM + (size_t)row * 768 + h * 192, QM + (size_t)(row + 16) * 768 + h * 192, YC + (size_t)row * 512 + h * 128, YC + (size_t)(row + 16) * 512 + h * 128,
                                               ML + b * CTXL, 4, b * SEQ, 0, 64, 0, 0, -1e30f, 0.f); }
            for (int u = bid; u < 512; u += G) { const int b = u >> 7, kvh = (u >> 6) & 1, qb = u & 63, q0 = 64 * qb, head = 4 * kvh + (wid >> 1);
                const int q = q0 + 32 * (wid & 1) + i16, row = b * SEQ + q;
                int tlo = (128 - q0) / 64; if (tlo < 0) tlo = 0; int thi = (SEQ + 128 - q0) / 64; if (thi > 5) thi = 5;
                const int lp0 = q0 - 128 + 64 * tlo;
                AttnSrc S{Z + ZC_KD + 64 * kvh, NZ, Z, NZ, VTD + (size_t)kvh * 64 * MT};
                attn_unit<64, 0, 64, true>(lds, S, Z + (size_t)row * NZ + ZC_QD + 64 * head, Z + (size_t)(row + 16) * NZ + ZC_QD + 64 * head, YD + (size_t)row * 512 + 64 * head, YD + (size_t)(row + 16) * 512 + 64 * head,
                                           ML + b * CTXL, 4, b * SEQ + lp0, lp0, thi - tlo, q, q + 16, sink[head] * LOG2E, 1.f); }
            if (!last) {
                for (int u = bid; u < 16; u += G) { const int b = u >> 2, h = u & 3; const int row = ML + b * CTXL + 32 * wid + i16;
                    AttnSrc S{KN + h * 128, 512, Z + ZC_KR, NZ, VTM + (size_t)h * 128 * MT};
                    attn_unit<128, 64, 128, false>(lds, S, QM + (size_t)row * 768 + h * 192, QM + (size_t)(row + 16) * 768 + h * 192, YC + (size_t)row * 512 + h * 128, YC + (size_t)(row + 16) * 512 + h * 128,
                                                   ML + b * CTXL, 4, 0, 0, 0, 0, 0, -1e30f, 0.f); }
                for (int u = bid - 16; u >= 0 && u < 32; u += G) { const int b = u >> 3, kvh = (u >> 2) & 1, qb = u & 3, head = 4 * kvh + (wid >> 1);
                    const int q = 64 * qb + 32 * (wid & 1) + i16, row = ML + b * CTXL + q;
                    AttnSrc S{Z + ZC_KD + 64 * kvh, NZ, Z, NZ, VTD + (size_t)kvh * 64 * MT};
                    attn_unit<64, 0, 64, false>(lds, S, Z + (size_t)row * NZ + ZC_QD + 64 * head, Z + (size_t)(row + 16) * NZ + ZC_QD + 64 * head, YD + (size_t)row * 512 + 64 * head, YD + (size_t)(row + 16) * 512 + 64 * head,
                                                ML + b * CTXL, 4, 0, 0, 0, 0, 0, sink[head] * LOG2E, 1.f); }
            }
            __syncthreads();
        }
        SEAM(pb + 6);
        if (IN(pb + 7) && EN(7)) for (int _rep = 0; _rep < (((PROBE_MASK >> 7) & 1) ? 2 : 1); ++_rep) { if (_rep) { MKBAR; xcd_barrier(bar); } GRID; unsigned char* const ws = C.ws();
            pg8::ChainOrder S; S.init((last ? ML : MT) / 256, D / 128, G, bid, 0, WSP(bf16_t, WS_YBR), 256 * 512 * 2, WLP(bf16_t, l, WL_BR), 128 * 512 * 2); S.nsub = MERGE_N; S.map = MERGE_MAP; S.sA = (size_t)MT * 512 * 2; S.sB = (size_t)D * 512 * 2;
            pg8::EpiM1H E{WSP(const bf16_t, WS_Z), WSP(bf16_t, WS_H), S.nsub - 1, S.map}; pg8::gemm_phase<pg8::EpiM1H, pg8::ChainOrder, true, true>(lds, 512, 512, 512, S, E); }
        SEAM(pb + 7);
        if (IN(pb + 8) && EN(8)) for (int _rep = 0; _rep < (((PROBE_MASK >> 8) & 1) ? 2 : 1); ++_rep) { if (_rep) { MKBAR; xcd_barrier(bar); } GRID; unsigned char* const ws = C.ws();
            const bool split = (G >= 256) && !last;
            { pg8::RectOrder S; S.init((last || split ? ML : MT) / 256, D / 256, G, bid, 0, WSP(bf16_t, WS_H), 256 * D * 2, WLP(bf16_t, l, WL_OUT), 256 * D * 2);
              pg8::EpiPlain<false> E{WSP(bf16_t, WS_Y), D, nullptr}; pg8::gemm_phase<pg8::EpiPlain<false>, pg8::RectOrder, true>(lds, D, D, D, S, E); }
            if (split) { const int tile = bid >> 3, part = bid & 7;
              pg8::SplitOrder S; S.pm = ML / 256 + (tile >> 3); S.pn = tile & 7; S.part = part; S.have = bid < 256;
              S.A = (const char*)(WSP(bf16_t, WS_H) + (size_t)S.pm * 256 * D + part * 256); S.B = (const char*)(WLP(bf16_t, l, WL_OUT) + (size_t)S.pn * 256 * D + part * 256);
              pg8::EpiPartial E{WSP(float, WS_PART), ML, (size_t)MC * D}; pg8::gemm_phase<pg8::EpiPartial, pg8::SplitOrder, true>(lds, 256, D, D, S, E); } }
        SEAM(pb + 8);
        if (IN(pb + 9) && EN(9)) for (int _rep = 0; _rep < (((PROBE_MASK >> 9) & 1) ? 2 : 1); ++_rep) { if (_rep) { MKBAR; xcd_barrier(bar); } GRID; unsigned char* const ws = C.ws(); float* const out = C.out(); float* const XC = WSP(float, WS_XC);
            if (PROBE_MASK & 0x2000) { if (true) { norm_phase(lds, G, bid, last ? ML : MT, out, XC, (float*)(ws + WS_Z), (float*)(ws + WS_Z) + (size_t)ML * D, WSP(const bf16_t, WS_Y), (G >= 256 && !last) ? WSP(const float, WS_PART) : nullptr, WSP(const float, WS_MOD) + (size_t)l * 5 * NMOD, 5, 1.0f, C.in(I_NPOST) + ((size_t)l * 3 + 1) * D, (bf16_t*)(ws + WS_Z + 160 * MiB), WSP(const float, WS_MOD) + (size_t)l * 5 * NMOD, 6, C.in(I_NPRE) + ((size_t)l * 3 + 2) * D); } { MKBAR; xcd_barrier(bar); } }
            norm_phase(lds, G, bid, last ? ML : MT, out, XC, out, XC, WSP(const bf16_t, WS_Y), (G >= 256 && !last) ? WSP(const float, WS_PART) : nullptr, WSP(const float, WS_MOD) + (size_t)l * 5 * NMOD, 5, 1.0f, C.in(I_NPOST) + ((size_t)l * 3 + 1) * D, WSP(bf16_t, WS_H), WSP(const float, WS_MOD) + (size_t)l * 5 * NMOD, 6, C.in(I_NPRE) + ((size_t)l * 3 + 2) * D); }
        SEAM(pb + 9);
        if (IN(pb + 10) && EN(10)) for (int _rep = 0; _rep < (((PROBE_MASK >> 10) & 1) ? 2 : 1); ++_rep) { if (_rep) { MKBAR; xcd_barrier(bar); } GRID; unsigned char* const ws = C.ws();
            pg8::RectOrder S; S.init((last ? ML : MT) / 256, NGU / 256, G, bid, 0, WSP(bf16_t, WS_H), 256 * D * 2, WLP(bf16_t, l, WL_GU) + (size_t)NGU * D, 256 * D * 2);
            pg8::EpiSwiglu E{WSP(bf16_t, WS_Z)}; pg8::gemm_phase<pg8::EpiSwiglu, pg8::RectOrder, true>(lds, D, D, D, S, E); }
        if (IN(pb + 10) && EN(10)) { GRID; cvt_pull(C, lds, l * CV_LAYER + CV_LAYER + CV_E0, CW_DONE + 64 * (pb + 10), G); }
        SEAM(pb + 10);
        if (IN(pb + 11) && EN(11)) for (int _rep = 0; _rep < (((PROBE_MASK >> 11) & 1) ? 2 : 1); ++_rep) { if (_rep) { MKBAR; xcd_barrier(bar); } GRID; unsigned char* const ws = C.ws();
            const bool split = (G >= 256) && !last;
            { pg8::RectOrder S; S.init((last || split ? ML : MT) / 256, D / 256, G, bid, 0, WSP(bf16_t, WS_Z), 256 * DFF * 2, WLP(bf16_t, l, WL_D) + (size_t)D * DFF, 256 * DFF * 2);
              pg8::EpiPlain<false> E{WSP(bf16_t, WS_Y), D, nullptr}; pg8::gemm_phase<pg8::EpiPlain<false>, pg8::RectOrder, true>(lds, DFF, DFF, DFF, S, E); }
            if (split) { const int tile = bid >> 3, part = bid & 7, ks = part < 5 ? 10 * part : 50 + 12 * (part - 5), kn = part < 5 ? 10 : 12;
              pg8::SplitOrder S; S.pm = ML / 256 + (tile >> 3); S.pn = tile & 7; S.part = part; S.have = bid < 256;
              S.A = (const char*)(WSP(bf16_t, WS_Z) + (size_t)S.pm * 256 * DFF + ks * 64); S.B = (const char*)(WLP(bf16_t, l, WL_D) + (size_t)D * DFF + (size_t)S.pn * 256 * DFF + ks * 64);
              pg8::EpiPartial E{WSP(float, WS_PART), ML, (size_t)MC * D}; pg8::gemm_phase<pg8::EpiPartial, pg8::SplitOrder, true>(lds, kn * 64, DFF, DFF, S, E); } }
        SEAM(pb + 11);
    }
    if (IN(NPHASE - 1) && EN(13)) { GRID; unsigned char* const ws = C.ws(); float* const out = C.out(); float* const XC = WSP(float, WS_XC);
        const int l = DEPTH - 1;
        norm_phase(lds, G, bid, ML, out, XC, out, XC, WSP(const bf16_t, WS_Y), nullptr, WSP(const float, WS_MOD) + (size_t)l * 5 * NMOD, 8, 0.5f, C.in(I_NPOST) + ((size_t)l * 3 + 2) * D, nullptr, nullptr, 0, nullptr);
    }
#undef IN
#undef SEAM
}


extern "C" void kernel_launch(void* const* d_in, const int* in_sizes, int n_in, void* d_out, int out_size, void* d_ws, size_t ws_size, hipStream_t stream) {
    static int grid = 0;
    if (grid == 0) {
        if (n_in != 28 || out_size != ML * D || ws_size < WS_END) { fprintf(stderr, "kernel_launch: unexpected shapes (n_in %d, out %d, ws %zu < %zu)\n", n_in, out_size, ws_size, (size_t)WS_END); grid = -1; return; }
        int dev = 0, cus = 0, per_cu = 0;
        if (hipGetDevice(&dev) != hipSuccess || hipDeviceGetAttribute(&cus, hipDeviceAttributeMultiprocessorCount, dev) != hipSuccess) { grid = -1; return; }
        if (hipFuncSetAttribute((const void*)mk_fwd, hipFuncAttributeMaxDynamicSharedMemorySize, LDS_BYTES) != hipSuccess) { fprintf(stderr, "kernel_launch: hipFuncSetAttribute failed\n"); grid = -1; return; }
        if (hipOccupancyMaxActiveBlocksPerMultiprocessor(&per_cu, (const void*)mk_fwd, 512, LDS_BYTES) != hipSuccess || per_cu < 1) fprintf(stderr, "kernel_launch: occupancy query says %d\n", per_cu);
        (void)hipGetLastError();
        grid = cus;
    }
    if (grid < 0) return;
    (void)hipMemsetAsync((char*)d_ws + WS_CTL, 0, CTL_ZERO_BYTES, stream);
    Params p{};
    for (int i = 0; i < 28; ++i) p.in[i] = (const float*)d_in[i];
    p.out = (float*)d_out; p.ws = (unsigned char*)d_ws;
#if MK_MULTI
    for (int k = 0; k < NPHASE; ++k) { p.ph_lo = k; p.ph_hi = k + 1; hipLaunchKernelGGL(mk_fwd, dim3(grid), dim3(512), LDS_BYTES, stream, p);
    }
#else
    p.ph_lo = 0; p.ph_hi = NPHASE; hipLaunchKernelGGL(mk_fwd, dim3(grid), dim3(512), LDS_BYTES, stream, p);
#endif
}
```

```cpp
#include <hip/hip_runtime.h>
#include <cstdio>
#include <cstdint>

#define LAS __attribute__((address_space(3)))
#define GAS __attribute__((address_space(1)))
typedef unsigned short bf16_t;
typedef short bf16x8 __attribute__((ext_vector_type(8)));
typedef float f32x4 __attribute__((ext_vector_type(4)));
typedef float f32x2 __attribute__((ext_vector_type(2)));
typedef unsigned u32x4 __attribute__((ext_vector_type(4)));
typedef unsigned u32x2 __attribute__((ext_vector_type(2)));

#ifndef PROBE_MASK
#define PROBE_MASK 0
#endif
#ifndef MK_CHECK_LAYER
#define MK_CHECK_LAYER 1
#endif
#ifndef NORM_NR
#define NORM_NR 2
#endif
#ifndef MERGE_N
#define MERGE_N 4
#define MERGE_MAP 0x3210
#endif
#ifndef PROBE_LOCMASK
#define PROBE_LOCMASK 15
#endif
#ifndef LOCMASK
#define LOCMASK 15
#endif
#ifndef PHMASK
#define PHMASK 0xffff
#endif
#define EN(j) (((PHMASK) >> (j)) & 1)
#ifndef MK_MULTI
#define MK_MULTI 0
#endif

constexpr int D = 2048, NB = 4, SEQ = 4096, DEPTH = 2, CTXL = 256, DFF = 5504;
constexpr int ML = NB * SEQ, MC = NB * CTXL, MT = ML + MC;
constexpr int NMOD = 9 * D, NIN = 11840, NZ = 11776, NZW = 12032, NGU = 2 * DFF;
constexpr int ZC_CQ = 2048, ZC_CKV = 2560, ZC_KR = 2816, ZC_QD = 2880, ZC_KD = 3392, ZC_G = 3584;
constexpr float EPS = 1e-6f;
constexpr float LOG2E = 1.4426950408889634f;

__device__ __forceinline__ unsigned f2bf(float f) { unsigned u = __builtin_bit_cast(unsigned, f); return (u + 0x7fffu + ((u >> 16) & 1u)) >> 16; }
__device__ __forceinline__ unsigned pk2(float lo, float hi) { return f2bf(lo) | (f2bf(hi) << 16); }
__device__ __forceinline__ float bflo(unsigned w) { return __builtin_bit_cast(float, w << 16); }
__device__ __forceinline__ float bfhi(unsigned w) { return __builtin_bit_cast(float, w & 0xffff0000u); }
__device__ __forceinline__ float bf2f(bf16_t h) { return __builtin_bit_cast(float, ((unsigned)h) << 16); }
__device__ __forceinline__ unsigned cvt_pk_bf16(float lo, float hi) { unsigned r; asm volatile("v_cvt_pk_bf16_f32 %0, %1, %2" : "=v"(r) : "v"(lo), "v"(hi)); return r; }
__device__ __forceinline__ float fast_exp2(float x) { return __builtin_amdgcn_exp2f(x); }
__device__ __forceinline__ float fast_rcp(float x) { return __builtin_amdgcn_rcpf(x); }
__device__ __forceinline__ float sigmoidf_(float x) { return fast_rcp(1.0f + fast_exp2(-x * LOG2E)); }
__device__ __forceinline__ int fresh_tid() { int t = threadIdx.x; asm volatile("" : "+v"(t)); return t; }
__device__ __forceinline__ float wave_sum(float v) {
#pragma unroll
    for (int o = 1; o < 64; o <<= 1) v += __shfl_xor(v, o);
    return v;
}
__device__ __forceinline__ float gelu1(float v) {
    const float av = __builtin_fabsf(v), t = fast_rcp(av * 0.2316418882f + 1.0f);
    float q = t * 0.5307027145f + (-0.7265760135f); q = q * t + 0.7107068705f; q = q * t + (-0.142248368f); q = q * t + 0.127414796f; q = q * t;
    const float e = fast_exp2((v * v) * (-0.72134752044f));
    const float m = v * (q * e);
    return v < 0.f ? m : v - m;
}

namespace pg8 {
constexpr int BM = 256, BK = 64, HALF = 128, HTB = HALF * BK * 2, STAGE_BYTES = 8 * HTB, NXCD = 8, WGM = 8;
__host__ __device__ __forceinline__ int lds_byte(int r, int c) { const int st = (r >> 4) * 2 + (c >> 5), rr = r & 15, cc = c & 31, ob = rr * 64 + cc * 2; return st * 1024 + (ob ^ (((ob >> 9) & 1) << 5)); }
__host__ __device__ __forceinline__ void stage_rc(int b, int& R, int& C) { const int st = b / 1024, sb = b % 1024, swz = sb ^ (((sb >> 9) & 1) << 5); R = (st >> 1) * 16 + swz / 64; C = (st & 1) * 32 + (swz % 64) / 2; }
__host__ __device__ __forceinline__ int perm32(int rho) { const int n = rho >> 4, i = rho & 15; return 8 * (i >> 2) + 4 * n + (i & 3); }

struct Unit { int pm, pn, sub; };
struct RectOrder {
    int nM, nN, nwg, G, c; const char* A; const char* B; unsigned tA, tB;
    __device__ __forceinline__ void init(int nM_, int nN_, int G_, int c_, int rot, const void* A_, unsigned tA_, const void* B_, unsigned tB_) { nM = nM_; nN = nN_; nwg = nM * nN; G = G_; c = (c_ + G_ - (rot % G_)) % G_; A = (const char*)A_; B = (const char*)B_; tA = tA_; tB = tB_; }
    __device__ __forceinline__ void tile_of(int wgid, Unit& u) const {
        { const int q = nwg / NXCD, r = nwg % NXCD, xcd = wgid % NXCD, off = wgid / NXCD; wgid = (xcd < r ? xcd * (q + 1) : r * (q + 1) + (xcd - r) * q) + off; }
        const int nig = WGM * nN, gid = wgid / nig, fm = gid * WGM, gsz = (nM - fm) < WGM ? (nM - fm) : WGM;
        u.pm = fm + ((wgid % nig) % gsz); u.pn = (wgid % nig) / gsz;
    }
    __device__ __forceinline__ bool next(int i, Unit& u) const { const long L = (long)i * G + c; if (L >= nwg) return false; tile_of((int)L, u); u.sub = 0; return true; }
    __device__ __forceinline__ const char* aptr(const Unit& u) const { return A + (size_t)u.pm * tA; }
    __device__ __forceinline__ const char* bptr(const Unit& u) const { return B + (size_t)u.pn * tB; }
};
struct SplitOrder {
    int pm, pn, part; bool have; const char* A; const char* B;
    __device__ __forceinline__ bool next(int i, Unit& u) const { if (i > 0 || !have) return false; u.pm = pm; u.pn = pn; u.sub = part; return true; }
    __device__ __forceinline__ const char* aptr(const Unit&) const { return A; }
    __device__ __forceinline__ const char* bptr(const Unit&) const { return B; }
};
struct ChainOrder : RectOrder {
    int nsub, map; size_t sA, sB;
    __device__ __forceinline__ bool next(int i, Unit& u) const { const int su = i / nsub; const long L = (long)su * G + c; if (L >= nwg) return false; tile_of((int)L, u); u.sub = i - su * nsub; return true; }
    __device__ __forceinline__ const char* aptr(const Unit& u) const { return A + (size_t)u.pm * tA + (size_t)((map >> (4 * u.sub)) & 15) * sA; }
    __device__ __forceinline__ const char* bptr(const Unit& u) const { return B + (size_t)u.pn * tB + (size_t)((map >> (4 * u.sub)) & 15) * sB; }
};

template <class Epi, class Sched, bool ALIGN_EPI, bool HALFN = false>
__device__ __forceinline__ void gemm_phase(LAS unsigned char* lds, const int K, const int lda, const int ldb, const Sched& S, const Epi& E) {
    const int tid = fresh_tid(), wid = __builtin_amdgcn_readfirstlane(tid >> 6), lane = tid & 63, wr = wid >> 2, wc = wid & 3, fr = lane & 15, fq = lane >> 4;
    const int nt = K / BK;
    unsigned voffA[2], voffB[2];
#pragma unroll
    for (int i = 0; i < 2; ++i) { int R, C; stage_rc(tid * 16 + i * 8192, R, C); const int Rb = Epi::PERM ? ((R & ~31) + perm32(R & 31)) : R;
        voffA[i] = (unsigned)(R * lda + C) * 2u; voffB[i] = (unsigned)(Rb * ldb + C) * 2u; }
    const size_t kstep = (size_t)(BK * 2);
    const size_t hstepA = (size_t)HALF * lda * 2, hstepB = (size_t)HALF * ldb * 2;
    const unsigned ldsw = (unsigned)wid * 1024u;
    const int aoff = lds_byte(wr * 64 + fr, fq * 8), boff = lds_byte(wc * 32 + fr, fq * 8);
#define PG8_SA(b, h) (((b) * 2 + (h)) * HTB)
#define PG8_SB(b, h) ((4 + (b) * 2 + (h)) * HTB)
#define PG8_STAGE(bufoff, gbase, voff) do { _Pragma("unroll") for (int _i = 0; _i < 2; ++_i) \
        __builtin_amdgcn_global_load_lds((const unsigned*)((const char*)(gbase) + (voff)[_i]), (LAS unsigned*)(lds + (bufoff) + ldsw + _i * 8192), 16, 0, 0); } while (0)
#define PG8_LDA(dst, b, h) do { _Pragma("unroll") for (int m = 0; m < 4; ++m) _Pragma("unroll") for (int k = 0; k < 2; ++k) dst[m][k] = *(const LAS bf16x8*)(lds + PG8_SA(b, h) + aoff + m * 2048 + k * 1024); } while (0)
#define PG8_LDB(dst, b, h) do { _Pragma("unroll") for (int n = 0; n < 2; ++n) _Pragma("unroll") for (int k = 0; k < 2; ++k) dst[n][k] = *(const LAS bf16x8*)(lds + PG8_SB(b, h) + boff + n * 2048 + k * 1024); } while (0)
#define PG8_MMA(ai, bj, At, Bt) do { __builtin_amdgcn_s_setprio(1); _Pragma("unroll") for (int m = 0; m < 4; ++m) _Pragma("unroll") for (int n = 0; n < 2; ++n) _Pragma("unroll") for (int k = 0; k < 2; ++k) \
        acc[ai][bj][m][n] = __builtin_amdgcn_mfma_f32_16x16x32_bf16(Bt[n][k], At[m][k], acc[ai][bj][m][n], 0, 0, 0); __builtin_amdgcn_s_setprio(0); } while (0)
#define PG8_WAIT_V(n) asm volatile("s_waitcnt vmcnt(" #n ")" ::: "memory")
#define PG8_WAIT_L(n) asm volatile("s_waitcnt lgkmcnt(" #n ")" ::: "memory")
#define PG8_WAIT_VH do { if constexpr (HALFN) PG8_WAIT_V(6); else PG8_WAIT_V(8); } while (0)
#define PG8_BAR __builtin_amdgcn_s_barrier()
#define PG8_SCHED __builtin_amdgcn_sched_barrier(0)
    Unit cur, nxt; int ui = 0;
    if (!S.next(0, cur)) return;
    f32x4 acc[2][2][4][2];
#pragma unroll
    for (int a = 0; a < 2; ++a)
#pragma unroll
        for (int b = 0; b < 2; ++b)
#pragma unroll
            for (int m = 0; m < 4; ++m)
#pragma unroll
                for (int n = 0; n < 2; ++n) acc[a][b][m][n] = (f32x4){0.f, 0.f, 0.f, 0.f};
    bf16x8 At[4][2], B0[2][2], B1[2][2];
    const char* cA = S.aptr(cur); const char* cB = S.bptr(cur);
    PG8_STAGE(PG8_SB(0, 0), cB, voffB); if constexpr (!HALFN) PG8_STAGE(PG8_SB(0, 1), cB + hstepB, voffB); PG8_STAGE(PG8_SA(0, 0), cA, voffA); PG8_STAGE(PG8_SA(0, 1), cA + hstepA, voffA);
    if (wr == 1) PG8_BAR;
    PG8_WAIT_V(2); PG8_BAR;
    PG8_STAGE(PG8_SB(1, 0), cB + kstep, voffB); PG8_STAGE(PG8_SA(1, 0), cA + kstep, voffA); if constexpr (!HALFN) PG8_STAGE(PG8_SB(1, 1), cB + hstepB + kstep, voffB);
    if constexpr (HALFN) PG8_WAIT_V(4); else PG8_WAIT_V(6);
    PG8_BAR;
    for (;;) {
        const bool has_next = S.next(ui + 1, nxt);
        const char* nA = has_next ? S.aptr(nxt) : cA; const char* nB = has_next ? S.bptr(nxt) : cB;
#pragma unroll 1
        for (int t = 0; t < nt; t += 2) {
            const bool last = (t == nt - 2);
            const char* a1 = cA + (size_t)(t + 1) * kstep;
            const char* a2 = last ? nA : cA + (size_t)(t + 2) * kstep; const char* b2 = last ? nB : cB + (size_t)(t + 2) * kstep;
            const char* a3 = a2 + kstep; const char* b3 = b2 + kstep;
            PG8_LDB(B0, 0, 0); if constexpr (!HALFN) PG8_LDB(B1, 0, 1); PG8_SCHED; PG8_LDA(At, 0, 0); PG8_STAGE(PG8_SA(1, 1), a1 + hstepA, voffA);
            PG8_WAIT_VH; PG8_WAIT_L(0); PG8_BAR; PG8_MMA(0, 0, At, B0); if constexpr (!HALFN) PG8_MMA(0, 1, At, B1); PG8_BAR; PG8_SCHED;
            PG8_LDA(At, 0, 1); PG8_STAGE(PG8_SB(0, 0), b2, voffB); if constexpr (!HALFN) PG8_STAGE(PG8_SB(0, 1), b2 + hstepB, voffB); PG8_STAGE(PG8_SA(0, 0), a2, voffA);
            PG8_WAIT_VH; PG8_WAIT_L(0); PG8_BAR; PG8_MMA(1, 0, At, B0); if constexpr (!HALFN) PG8_MMA(1, 1, At, B1); PG8_BAR; PG8_SCHED;
            PG8_LDB(B0, 1, 0); if constexpr (!HALFN) PG8_LDB(B1, 1, 1); PG8_SCHED; PG8_LDA(At, 1, 0); PG8_STAGE(PG8_SA(0, 1), a2 + hstepA, voffA);
            PG8_WAIT_VH; PG8_WAIT_L(0); PG8_BAR; PG8_MMA(0, 0, At, B0); if constexpr (!HALFN) PG8_MMA(0, 1, At, B1); PG8_BAR; PG8_SCHED;
            PG8_LDA(At, 1, 1); PG8_STAGE(PG8_SB(1, 0), b3, voffB); if constexpr (!HALFN) PG8_STAGE(PG8_SB(1, 1), b3 + hstepB, voffB); PG8_STAGE(PG8_SA(1, 0), a3, voffA);
            PG8_WAIT_VH; PG8_WAIT_L(0); PG8_BAR; PG8_MMA(1, 0, At, B0); if constexpr (!HALFN) PG8_MMA(1, 1, At, B1); PG8_BAR; PG8_SCHED;
        }
        if constexpr (ALIGN_EPI) { if (wr == 0) PG8_BAR; }
        const bool keep = E(acc, cur, wr, wc, fr, fq);
        if (!has_next) break;
        if (!keep) {
#pragma unroll
        for (int a = 0; a < 2; ++a)
#pragma unroll
            for (int b = 0; b < 2; ++b)
#pragma unroll
                for (int m = 0; m < 4; ++m)
#pragma unroll
                    for (int n = 0; n < 2; ++n) acc[a][b][m][n] = (f32x4){0.f, 0.f, 0.f, 0.f};
        }
        cur = nxt; cA = nA; cB = nB; ++ui;
        if constexpr (ALIGN_EPI) { if (wr == 1) PG8_BAR; }
    }
    PG8_WAIT_V(0);
    if constexpr (!ALIGN_EPI) { if (wr == 0) PG8_BAR; }
    PG8_BAR;
#undef PG8_SA
#undef PG8_SB
#undef PG8_STAGE
#undef PG8_LDA
#undef PG8_LDB
#undef PG8_MMA
#undef PG8_WAIT_V
#undef PG8_WAIT_L
#undef PG8_WAIT_VH
#undef PG8_BAR
#undef PG8_SCHED
}
}

constexpr size_t MiB = 1u << 20;
constexpr size_t WS_CTL = 0, CTL_ZERO_BYTES = 1 * MiB;
constexpr size_t WS_MOD = 1 * MiB;
constexpr size_t WS_TAB = 2 * MiB;
constexpr size_t WS_SSP = 2 * MiB + 65536;
constexpr size_t WS_XC = 3 * MiB;
constexpr size_t WS_H = 11 * MiB;
constexpr size_t WS_Y = 79 * MiB;
constexpr size_t WS_HB = 147 * MiB;
constexpr size_t WS_YBR = 164 * MiB;
constexpr size_t WS_QM = 232 * MiB;
constexpr size_t WS_KN = 258 * MiB;
constexpr size_t WS_VTM = 275 * MiB;
constexpr size_t WS_Z = 292 * MiB;
constexpr size_t WS_W = 692 * MiB;
constexpr size_t WL_GU = 0, WL_D = 86 * MiB, WL_IN = 129 * MiB, WL_UQ = 176 * MiB, WL_KV = 177 * MiB, WL_BR = 178 * MiB, WL_OUT = 186 * MiB, WL_GMW = 194 * MiB, WL_BZ = 194 * MiB + 262144, WL_SIZE = 195 * MiB;
constexpr size_t WS_VTD = WS_W + DEPTH * WL_SIZE;
constexpr size_t WS_XB = WS_VTD + 9 * MiB;
constexpr size_t WS_END = WS_XB + 68 * MiB;
static_assert(WS_SSP + (size_t)MT * 12 * 4 <= WS_XC && WS_XC + (size_t)MC * D * 4 <= WS_H && WS_H + (size_t)MT * D * 2 <= WS_Y && WS_Y + (size_t)MT * D * 2 <= WS_HB, "ws map 1");
static_assert(WS_HB + (size_t)MT * 512 * 2 <= WS_YBR && WS_YBR + (size_t)4 * MT * 512 * 2 <= WS_QM && WS_QM + (size_t)MT * 768 * 2 <= WS_KN && WS_KN + (size_t)MT * 512 * 2 <= WS_VTM && WS_VTM + (size_t)512 * MT * 2 <= WS_Z && WS_Z + (size_t)MT * NZ * 2 <= WS_W, "ws map 2");
static_assert((size_t)2 * NGU * D * 2 <= WL_D && WL_D + (size_t)2 * D * DFF * 2 <= WL_IN && WL_IN + (size_t)NZW * D * 2 <= WL_UQ && WL_UQ + 768 * 512 * 2 <= WL_KV && WL_KV + 1024 * 256 * 2 <= WL_BR && WL_BR + (size_t)4 * D * 512 * 2 <= WL_OUT && WL_OUT + (size_t)D * D * 2 <= WL_GMW && WL_GMW + 4 * 128 * 128 * 2 <= WL_BZ && WL_BZ + NZW * 4 <= WL_SIZE, "weight map");
static_assert((size_t)DEPTH * 5 * NMOD * 4 <= 1 * MiB, "mod");
constexpr int CW_BAR = 4096;

constexpr int RING_BYTES = 131072, MISC_OFF = RING_BYTES + 320, LTAB_OFF = RING_BYTES + 2048  , LDS_BYTES = 147456;

#define XB_TMO      128
#define XB_XCNT(j)  (256  + 64 * (j))
#define XB_XSUB(j)  (1280 + 64 * (j))
#define XB_XGEN(j)  (2304 + 64 * (j))
#define XB_TOP      3328
#define XB_TOPGEN   3392
#define XCD_BAR_WORDS 3456
#define XB_SPIN_CAP (1u << 20)
__device__ __forceinline__ unsigned xb_ld(unsigned* p)              { return __hip_atomic_load(p, __ATOMIC_RELAXED, __HIP_MEMORY_SCOPE_AGENT); }
__device__ __forceinline__ unsigned xb_add(unsigned* p, unsigned v) { return __hip_atomic_fetch_add(p, v, __ATOMIC_RELAXED, __HIP_MEMORY_SCOPE_AGENT); }
__device__ __forceinline__ unsigned xb_xcc_id() { return (unsigned)__builtin_amdgcn_s_getreg((3 << 11) | 20) & 0xFu; }
#define XB_SPIN(cond, bar) do { unsigned _sp = 0; while (cond) { __builtin_amdgcn_s_sleep(1); \
    if ((++_sp & 255u) == 0u) { if (xb_ld(&(bar)[XB_TMO])) break; if (_sp > XB_SPIN_CAP) { atomicAdd(&(bar)[XB_TMO], 1u); break; } } } } while (0)
struct XcdBarrier { unsigned* bar; unsigned x; volatile LAS unsigned* st; };
__device__ __forceinline__ XcdBarrier xcd_barrier_post(unsigned* bar, volatile LAS unsigned* st) {
    XcdBarrier b; b.bar = bar; b.x = xb_xcc_id(); b.st = st;
    if (threadIdx.x == 0) (void)xb_add(&bar[XB_XCNT(b.x)], 1u);
    return b;
}
__device__ __forceinline__ void xcd_barrier_complete(unsigned* bar, unsigned x, unsigned& nloc, unsigned& nx) {
    const unsigned G = gridDim.x * gridDim.y * gridDim.z;
    unsigned sum, cnt, mine, sp = 0u;
    for (;;) {
        sum = 0u; cnt = 0u; mine = 0u;
#pragma unroll
        for (unsigned j = 0; j < 16; ++j) { const unsigned c = xb_ld(&bar[XB_XCNT(j)]); sum += c; cnt += (c > 0u) ? 1u : 0u; mine = (j == x) ? c : mine; }
        if (sum == G) break;
        __builtin_amdgcn_s_sleep(1);
        if ((++sp & 255u) == 0u) { if (xb_ld(&bar[XB_TMO])) break; if (sp > XB_SPIN_CAP) { atomicAdd(&bar[XB_TMO], 1u); break; } }
    }
    nloc = mine > 0u ? mine : 1u; nx = cnt > 0u ? cnt : 1u;
}
__device__ __forceinline__ void xcd_barrier(const XcdBarrier& b) {
    asm volatile("s_waitcnt vmcnt(0)" ::: "memory");
    __syncthreads();
    if (threadIdx.x == 0) {
        unsigned* bar = b.bar;
        __builtin_amdgcn_s_waitcnt(0);
        unsigned nloc = b.st[0], nx = b.st[1];
        if (nloc == 0u) { xcd_barrier_complete(bar, b.x, nloc, nx); b.st[0] = nloc; b.st[1] = nx; }
        const unsigned old = xb_add(&bar[XB_XSUB(b.x)], 1u);
        const unsigned gen = old / nloc;
        if (old + 1u == (gen + 1u) * nloc) {
            __builtin_amdgcn_fence(__ATOMIC_RELEASE, "agent");
            asm volatile("s_waitcnt vmcnt(0)" ::: "memory");
            const unsigned og = xb_add(&bar[XB_TOP], 1u);
            const unsigned tg = og / nx;
            if (og + 1u == (tg + 1u) * nx) xb_add(&bar[XB_TOPGEN], 1u);
            else XB_SPIN(xb_ld(&bar[XB_TOPGEN]) == tg, bar);
            __builtin_amdgcn_fence(__ATOMIC_ACQUIRE, "agent");
            xb_add(&bar[XB_XGEN(b.x)], 1u);
            asm volatile("s_waitcnt vmcnt(0)" ::: "memory");
        } else {
            XB_SPIN(xb_ld(&bar[XB_XGEN(b.x)]) == gen, bar);
            __builtin_amdgcn_fence(__ATOMIC_ACQUIRE, "agent");
            asm volatile("s_waitcnt vmcnt(0)" ::: "memory");
        }
    }
    __syncthreads();
}

constexpr int RING_BYTES_C = 131072;
struct Params { const float* in[28]; float* out; unsigned char* ws; int ph_lo, ph_hi; };
enum { I_X = 0, I_C, I_CTX, I_CCTX, I_WMOD, I_BMOD, I_NPRE, I_NPOST, I_WG, I_WU, I_WD, I_WIN, I_BIN, I_GMLNG, I_GMLNB, I_GMWS, I_GMBS, I_CVDW, I_CVDB, I_CVLNG, I_CVLNB, I_QNORM, I_KVNORM, I_WUQ, I_WUKV, I_SINK, I_WBR, I_WOUT };

constexpr int PTAB_OFF = RING_BYTES_C + 1024;
struct Ctx { volatile LAS unsigned* tab;
    __device__ __forceinline__ unsigned long long get(int i) const { const unsigned lo = __builtin_amdgcn_readfirstlane(tab[2 * i]), hi = __builtin_amdgcn_readfirstlane(tab[2 * i + 1]); return ((unsigned long long)hi << 32) | lo; }
    __device__ __forceinline__ const float* in(int i) const { return (const float*)(const GAS float*)get(i); }
    __device__ __forceinline__ float* out() const { return (float*)(GAS float*)get(28); }
    __device__ __forceinline__ unsigned char* ws() const { return (unsigned char*)(GAS unsigned char*)get(29); }
};
#define WSP(T, off) ((T*)(ws + (off)))
#define WLP(T, l, off) ((T*)(ws + WS_W + (size_t)(l) * WL_SIZE + (off)))

namespace pg8 {
struct EpiSwiglu { static constexpr bool PERM = true; bf16_t* O;
    __device__ __forceinline__ bool operator()(f32x4 (&acc)[2][2][4][2], const Unit& u, int wr, int wc, int fr, int fq) const {
        const int row0 = u.pm * BM + wr * 64 + fr, col0 = u.pn * HALF + wc * 32 + 8 * fq;
#pragma unroll
        for (int ai = 0; ai < 2; ++ai)
#pragma unroll
            for (int m = 0; m < 4; ++m) { bf16_t* rowp = O + (size_t)(row0 + ai * HALF + m * 16) * DFF + col0; float v[8];
#pragma unroll
                for (int n = 0; n < 2; ++n)
#pragma unroll
                    for (int i = 0; i < 4; ++i) { const float g = acc[ai][0][m][n][i], up = acc[ai][1][m][n][i]; v[4 * n + i] = g * sigmoidf_(g) * up; }
                u32x4 w; w.x = cvt_pk_bf16(v[0], v[1]); w.y = cvt_pk_bf16(v[2], v[3]); w.z = cvt_pk_bf16(v[4], v[5]); w.w = cvt_pk_bf16(v[6], v[7]);
                *(u32x4*)rowp = w; }
        return false;
    }
};
template <bool RS> struct EpiPlain { static constexpr bool PERM = true; bf16_t* O; int ldc; const float* ssp;
    __device__ __forceinline__ bool operator()(f32x4 (&acc)[2][2][4][2], const Unit& u, int wr, int wc, int fr, int fq) const {
        const int row0 = u.pm * BM + wr * 64 + fr, col0 = u.pn * BM + wc * 32 + 8 * fq;
        f32x4 pr[2][4];
        if (RS) {
#pragma unroll
            for (int ai = 0; ai < 2; ++ai)
#pragma unroll
                for (int m = 0; m < 4; ++m) pr[ai][m] = *(const f32x4*)(ssp + (size_t)(row0 + ai * HALF + m * 16) * 12 + 8);
            __builtin_amdgcn_sched_barrier(0);
        }
#pragma unroll
        for (int ai = 0; ai < 2; ++ai)
#pragma unroll
            for (int m = 0; m < 4; ++m) { const int row = row0 + ai * HALF + m * 16; bf16_t* rowp = O + (size_t)row * ldc + col0; float sc = 1.f;
                if (RS) { const f32x4 p = pr[ai][m]; sc = __builtin_amdgcn_rsqf(((p[0] + p[1]) + (p[2] + p[3])) * (1.f / 256.f) + EPS); }
#pragma unroll
                for (int bj = 0; bj < 2; ++bj) { const f32x4 v0 = acc[ai][bj][m][0] * sc, v1 = acc[ai][bj][m][1] * sc;
                    u32x4 w; w.x = cvt_pk_bf16(v0[0], v0[1]); w.y = cvt_pk_bf16(v0[2], v0[3]); w.z = cvt_pk_bf16(v1[0], v1[1]); w.w = cvt_pk_bf16(v1[2], v1[3]);
                    *(u32x4*)(rowp + bj * HALF) = w; } }
        return false;
    }
};
struct EpiPartial { static constexpr bool PERM = false; float* P; int row_base; size_t pstride;
    __device__ __forceinline__ bool operator()(f32x4 (&acc)[2][2][4][2], const Unit& u, int wr, int wc, int fr, int fq) const {
        const int row0 = u.pm * BM - row_base + wr * 64 + fr, col0 = u.pn * BM + wc * 32 + 4 * fq; float* base = P + (size_t)u.sub * pstride;
#pragma unroll
        for (int ai = 0; ai < 2; ++ai)
#pragma unroll
            for (int m = 0; m < 4; ++m) { float* rowp = base + (size_t)(row0 + ai * HALF + m * 16) * D + col0;
#pragma unroll
                for (int bj = 0; bj < 2; ++bj)
#pragma unroll
                    for (int n = 0; n < 2; ++n) *(f32x4*)(rowp + bj * HALF + n * 16) = acc[ai][bj][m][n]; }
        return false;
    }
};
__device__ __forceinline__ void rope4(f32x4& v0, f32x4& v1, const LAS float* tab) {
    const f32x4 t0 = *(const LAS f32x4*)tab, t1 = *(const LAS f32x4*)(tab + 4);
    const float c[4] = {t0[0], t0[2], t1[0], t1[2]}, s[4] = {t0[1], t0[3], t1[1], t1[3]};
#pragma unroll
    for (int i = 0; i < 4; ++i) { const float a = v0[i], b = v1[i]; v0[i] = a * c[i] - b * s[i]; v1[i] = b * c[i] + a * s[i]; }
}
struct EpiQ { static constexpr bool PERM = true; bf16_t* O; const float* ssp; const LAS float* tab;
    __device__ __forceinline__ bool operator()(f32x4 (&acc)[2][2][4][2], const Unit& u, int wr, int wc, int fr, int fq) const {
        const int row0 = u.pm * BM + wr * 64 + fr, col0 = u.pn * BM + wc * 32 + 8 * fq;
        const float qs = 0.07216878364870322f * LOG2E;
#pragma unroll
        for (int ai = 0; ai < 2; ++ai) {
        f32x4 pr0[4], pr1[4];
#pragma unroll
        for (int m = 0; m < 4; ++m) { const size_t ro = (size_t)(row0 + ai * HALF + m * 16) * 12; pr0[m] = *(const f32x4*)(ssp + ro); pr1[m] = *(const f32x4*)(ssp + ro + 4); }
        __builtin_amdgcn_sched_barrier(0);
#pragma unroll
            for (int m = 0; m < 4; ++m) { const int row = row0 + ai * HALF + m * 16; bf16_t* rowp = O + (size_t)row * 768 + col0;
                const f32x4 p0 = pr0[m], p1 = pr1[m];
                const float sc = __builtin_amdgcn_rsqf((((p0[0] + p0[1]) + (p0[2] + p0[3])) + ((p1[0] + p1[1]) + (p1[2] + p1[3]))) * (1.f / 512.f) + EPS) * qs;
                const int t = row & (SEQ - 1); const bool lat = row < ML;
#pragma unroll
                for (int bj = 0; bj < 2; ++bj) { const int grp = (u.pn * 8 + bj * 4 + wc) % 6;
                    f32x4 v0 = acc[ai][bj][m][0] * sc, v1 = acc[ai][bj][m][1] * sc;
                    if (grp >= 4 && lat) { const int pos = (grp == 4) ? (t >> 6) : (t & 63); rope4(v0, v1, tab + (pos * 16 + 4 * fq) * 2); }
                    u32x4 w; w.x = cvt_pk_bf16(v0[0], v0[1]); w.y = cvt_pk_bf16(v0[2], v0[3]); w.z = cvt_pk_bf16(v1[0], v1[1]); w.w = cvt_pk_bf16(v1[2], v1[3]);
                    *(u32x4*)(rowp + bj * HALF) = w; } }
        __builtin_amdgcn_sched_barrier(0); }
        return false;
    }
};
struct EpiZ { static constexpr bool PERM = true; bf16_t* Z; bf16_t* HB; float* ssp; const float* bias; const LAS float* tab; int pn_off, row_base;
    __device__ __forceinline__ bool operator()(f32x4 (&acc)[2][2][4][2], const Unit& u, int wr, int wc, int fr, int fq) const {
        const int pn = u.pn + pn_off;
        const int row0 = row_base + u.pm * BM + wr * 64 + fr, col0 = pn * BM + wc * 32 + 8 * fq;
        f32x4 bv[2][2];
#pragma unroll
        for (int bj = 0; bj < 2; ++bj)
#pragma unroll
            for (int n = 0; n < 2; ++n) bv[bj][n] = *(const f32x4*)(bias + col0 + bj * HALF + 4 * n);
        if (pn >= 4 && pn < 8) {
#pragma unroll
            for (int ai = 0; ai < 2; ++ai)
#pragma unroll
                for (int m = 0; m < 4; ++m) { bf16_t* rowp = HB + (size_t)(row0 + ai * HALF + m * 16) * 512 + (pn - 4) * HALF + wc * 32 + 8 * fq; float h[8];
#pragma unroll
                    for (int n = 0; n < 2; ++n) { const f32x4 a = acc[ai][0][m][n] + bv[0][n], gt = acc[ai][1][m][n] + bv[1][n];
#pragma unroll
                        for (int i = 0; i < 4; ++i) h[4 * n + i] = a[i] * sigmoidf_(gt[i]); }
                    u32x4 w; w.x = cvt_pk_bf16(h[0], h[1]); w.y = cvt_pk_bf16(h[2], h[3]); w.z = cvt_pk_bf16(h[4], h[5]); w.w = cvt_pk_bf16(h[6], h[7]); *(u32x4*)rowp = w; }
        } else {
#pragma unroll
        for (int ai = 0; ai < 2; ++ai)
#pragma unroll
            for (int m = 0; m < 4; ++m) { const int row = row0 + ai * HALF + m * 16; bf16_t* rowp = Z + (size_t)row * NZ + col0; float ss = 0.f;
                const int t = row & (SEQ - 1); const bool lat = row < ML;
#pragma unroll
                for (int bj = 0; bj < 2; ++bj) { f32x4 v0 = acc[ai][bj][m][0] + bv[bj][0], v1 = acc[ai][bj][m][1] + bv[bj][1];
                    if (pn < 4) {
#pragma unroll
                        for (int i = 0; i < 4; ++i) { v0[i] = gelu1(v0[i]); v1[i] = gelu1(v1[i]); }
                    } else if (pn < 11) {
#pragma unroll
                        for (int i = 0; i < 4; ++i) ss += v0[i] * v0[i] + v1[i] * v1[i];
                    } else if (pn < 14) { const int grp = pn * 8 + bj * 4 + wc;
                        if (grp >= 88 && grp < 110 && lat) { const int pos = (grp & 1) ? (t & 63) : (t >> 6); rope4(v0, v1, tab + (pos * 16 + 4 * fq) * 2); }
                        if (grp >= 90 && grp < 106) { v0 = v0 * (0.125f * LOG2E); v1 = v1 * (0.125f * LOG2E); }
                    } else {
#pragma unroll
                        for (int i = 0; i < 4; ++i) { v0[i] = sigmoidf_(v0[i]); v1[i] = sigmoidf_(v1[i]); }
                    }
                    u32x4 w; w.x = cvt_pk_bf16(v0[0], v0[1]); w.y = cvt_pk_bf16(v0[2], v0[3]); w.z = cvt_pk_bf16(v1[0], v1[1]); w.w = cvt_pk_bf16(v1[2], v1[3]);
                    *(u32x4*)(rowp + bj * HALF) = w; }
                if (pn >= 8 && pn < 11) { ss += __shfl_xor(ss, 16); ss += __shfl_xor(ss, 32); ssp[(size_t)row * 12 + (pn - 8) * 4 + wc] = ss; } }
        }
        asm volatile("" :: "v"(bv[0][0]), "v"(bv[0][1]), "v"(bv[1][0]), "v"(bv[1][1]));
        return false;
    }
};
template <bool COLSCALE> struct EpiVt { static constexpr bool PERM = true; bf16_t* O; int ldc; const float* rbias; const float* ssp;
    __device__ __forceinline__ bool operator()(f32x4 (&acc)[2][2][4][2], const Unit& u, int wr, int wc, int fr, int fq) const {
        const int row0 = u.pm * BM + wr * 64 + fr, col0 = u.pn * BM + wc * 32 + 8 * fq;
        float sc[2][8];
        if (COLSCALE) {
#pragma unroll
            for (int bj = 0; bj < 2; ++bj) { f32x4 pc[8];
#pragma unroll
                for (int e = 0; e < 8; ++e) pc[e] = *(const f32x4*)(ssp + (size_t)(col0 + bj * HALF + e) * 12 + 8);
                __builtin_amdgcn_sched_barrier(0);
#pragma unroll
                for (int e = 0; e < 8; ++e) { const f32x4 p = pc[e]; sc[bj][e] = __builtin_amdgcn_rsqf(((p[0] + p[1]) + (p[2] + p[3])) * (1.f / 256.f) + EPS); }
                __builtin_amdgcn_sched_barrier(0); }
        } else {
#pragma unroll
            for (int bj = 0; bj < 2; ++bj)
#pragma unroll
                for (int e = 0; e < 8; ++e) sc[bj][e] = 1.f;
        }
        float rbv[2][4];
#pragma unroll
        for (int ai = 0; ai < 2; ++ai)
#pragma unroll
            for (int m = 0; m < 4; ++m) rbv[ai][m] = COLSCALE ? 0.f : rbias[row0 + ai * HALF + m * 16];
        __builtin_amdgcn_sched_barrier(0);
#pragma unroll
        for (int ai = 0; ai < 2; ++ai)
#pragma unroll
            for (int m = 0; m < 4; ++m) { const int row = row0 + ai * HALF + m * 16; bf16_t* rowp = O + (size_t)row * ldc + col0; const float rb = rbv[ai][m];
#pragma unroll
                for (int bj = 0; bj < 2; ++bj) { const f32x4 a0 = acc[ai][bj][m][0] + rb, a1 = acc[ai][bj][m][1] + rb;
                    u32x4 w; w.x = cvt_pk_bf16(a0[0] * sc[bj][0], a0[1] * sc[bj][1]); w.y = cvt_pk_bf16(a0[2] * sc[bj][2], a0[3] * sc[bj][3]); w.z = cvt_pk_bf16(a1[0] * sc[bj][4], a1[1] * sc[bj][5]); w.w = cvt_pk_bf16(a1[2] * sc[bj][6], a1[3] * sc[bj][7]);
                    *(u32x4*)(rowp + bj * HALF) = w; } }
        return false;
    }
};
struct EpiM1 { static constexpr bool PERM = true; const bf16_t* Z; bf16_t* T; int nlast, map;
    __device__ __forceinline__ void loadb(const bf16_t* sp, const bf16_t* sp2, int b, u32x4 (&s)[2][2], u32x4 (&s2)[2][2]) const {
#pragma unroll
        for (int mm = 0; mm < 2; ++mm)
#pragma unroll
            for (int bj = 0; bj < 2; ++bj) { const size_t ro = (size_t)((b >> 1) * HALF + (2 * (b & 1) + mm) * 16) * NZ + bj * HALF; s[mm][bj] = *(const u32x4*)(sp + ro); s2[mm][bj] = *(const u32x4*)(sp2 + ro); }
    }
    __device__ __forceinline__ bool operator()(f32x4 (&acc)[2][2][4][2], const Unit& u, int wr, int wc, int fr, int fq) const {
        const int row0 = u.pm * BM + wr * 64 + fr, col0 = u.pn * BM + wc * 32 + 8 * fq; const int sub = u.sub;
        const int br = (map >> (4 * sub)) & 15, br2 = (map >> (4 * sub + 4)) & 15; const bool mid = sub < nlast;
        const bf16_t* sp = Z + (size_t)row0 * NZ + ZC_G + br * D + col0; const bf16_t* sp2 = Z + (size_t)row0 * NZ + ZC_G + (mid ? br2 : br) * D + col0;
        u32x4 sA[2][2], s2A[2][2], sB[2][2], s2B[2][2];
        loadb(sp, sp2, 0, sA, s2A);
#pragma unroll
        for (int b = 0; b < 4; ++b) {
            if (b + 1 < 4) { if (b & 1) loadb(sp, sp2, b + 1, sA, s2A); else loadb(sp, sp2, b + 1, sB, s2B); }
            __builtin_amdgcn_sched_barrier(0);
            const int ai = b >> 1, mp = b & 1;
#pragma unroll
            for (int mm = 0; mm < 2; ++mm)
#pragma unroll
                for (int bj = 0; bj < 2; ++bj) { const int m = 2 * mp + mm; const u32x4 a = (b & 1) ? sB[mm][bj] : sA[mm][bj], c = (b & 1) ? s2B[mm][bj] : s2A[mm][bj];
                    float g[8] = {bflo(a.x), bfhi(a.x), bflo(a.y), bfhi(a.y), bflo(a.z), bfhi(a.z), bflo(a.w), bfhi(a.w)};
                    if (mid) { const float g2[8] = {bflo(c.x), bfhi(c.x), bflo(c.y), bfhi(c.y), bflo(c.z), bfhi(c.z), bflo(c.w), bfhi(c.w)};
#pragma unroll
                        for (int i = 0; i < 8; ++i) g[i] = g[i] * fast_rcp(__builtin_fmaxf(g2[i], 1e-30f));
#pragma unroll
                        for (int i = 0; i < 4; ++i) { acc[ai][bj][m][0][i] *= g[i]; acc[ai][bj][m][1][i] *= g[4 + i]; }
                    } else { f32x4 v0, v1; asm volatile("" :: "v"(c));
#pragma unroll
                        for (int i = 0; i < 4; ++i) { v0[i] = acc[ai][bj][m][0][i] * g[i]; v1[i] = acc[ai][bj][m][1][i] * g[4 + i]; }
                        u32x4 w; w.x = cvt_pk_bf16(v0[0], v0[1]); w.y = cvt_pk_bf16(v0[2], v0[3]); w.z = cvt_pk_bf16(v1[0], v1[1]); w.w = cvt_pk_bf16(v1[2], v1[3]);
                        *(u32x4*)(T + (size_t)(row0 + ai * HALF + m * 16) * D + col0 + bj * HALF) = w; } }
            __builtin_amdgcn_sched_barrier(0);
        }
        return mid;
    }
};
struct EpiM1H { static constexpr bool PERM = true; const bf16_t* Z; bf16_t* T; int nlast, map;
    __device__ __forceinline__ bool operator()(f32x4 (&acc)[2][2][4][2], const Unit& u, int wr, int wc, int fr, int fq) const {
        const int row0 = u.pm * BM + wr * 64 + fr, col0 = u.pn * HALF + wc * 32 + 8 * fq; const int sub = u.sub; const int br = (map >> (4 * sub)) & 15;
        const bf16_t* sp = Z + (size_t)row0 * NZ + ZC_G + br * D + col0;
        u32x4 s[2][4];
#pragma unroll
        for (int ai = 0; ai < 2; ++ai)
#pragma unroll
            for (int m = 0; m < 4; ++m) s[ai][m] = *(const u32x4*)(sp + (size_t)(ai * HALF + m * 16) * NZ);
        __builtin_amdgcn_sched_barrier(0);
#pragma unroll
        for (int ai = 0; ai < 2; ++ai)
#pragma unroll
            for (int m = 0; m < 4; ++m) { const u32x4 a = s[ai][m];
                const f32x4 g0 = (f32x4){bflo(a.x), bfhi(a.x), bflo(a.y), bfhi(a.y)}, g1 = (f32x4){bflo(a.z), bfhi(a.z), bflo(a.w), bfhi(a.w)};
                acc[ai][1][m][0] += g0 * acc[ai][0][m][0]; acc[ai][1][m][1] += g1 * acc[ai][0][m][1];
                acc[ai][0][m][0] = (f32x4){0.f, 0.f, 0.f, 0.f}; acc[ai][0][m][1] = (f32x4){0.f, 0.f, 0.f, 0.f};
                if (sub == nlast) { const f32x4 v0 = acc[ai][1][m][0], v1 = acc[ai][1][m][1];
                    u32x4 w; w.x = cvt_pk_bf16(v0[0], v0[1]); w.y = cvt_pk_bf16(v0[2], v0[3]); w.z = cvt_pk_bf16(v1[0], v1[1]); w.w = cvt_pk_bf16(v1[2], v1[3]);
                    *(u32x4*)(T + (size_t)(row0 + ai * HALF + m * 16) * D + col0) = w;
                    acc[ai][1][m][0] = (f32x4){0.f, 0.f, 0.f, 0.f}; acc[ai][1][m][1] = (f32x4){0.f, 0.f, 0.f, 0.f}; } }
        return true;
    }
};
}

#define LDS_WAIT() asm volatile("s_waitcnt lgkmcnt(0)" ::: "memory")
__device__ __forceinline__ void cvt_item(const float* W, int ldw, int srccol0, bf16_t* dst, int K, int k0, const float* kscale, LAS float* scr, int lane, bool perm) {
    const int sc8 = perm ? (((lane & 7) >> 1) + 4 * (lane & 1)) : (lane & 7);
    f32x4 v[8];
    float ksv[8];
#pragma unroll
    for (int i = 0; i < 8; ++i) ksv[i] = 1.f;
    if (kscale) {
#pragma unroll
        for (int i = 0; i < 8; ++i) ksv[i] = kscale[k0 + 8 * i + (lane >> 3)];
    }
    const int scc = srccol0 >= 0 ? srccol0 : 0; const float zf = srccol0 >= 0 ? 1.f : 0.f;
#pragma unroll
    for (int i = 0; i < 8; ++i) { const int kk = 8 * i + (lane >> 3);
        v[i] = __builtin_nontemporal_load((const f32x4*)(W + (size_t)(k0 + kk) * ldw + scc + sc8 * 4)); }
#pragma unroll
    for (int i = 0; i < 8; ++i) { const int kk = 8 * i + (lane >> 3); f32x4 x = v[i] * (zf * ksv[i]);
        LAS float* d = scr + kk * 33 + (lane & 7) * 4; d[0] = x[0]; d[1] = x[1]; d[2] = x[2]; d[3] = x[3]; }
    LDS_WAIT(); asm volatile("" ::: "memory");
    const int c = lane & 7;
#pragma unroll
    for (int j = 0; j < 4; ++j) { const int n = (lane >> 3) + 8 * j; const LAS float* s = scr + (8 * c) * 33 + n;
        u32x4 o; o.x = pk2(s[0 * 33], s[1 * 33]); o.y = pk2(s[2 * 33], s[3 * 33]); o.z = pk2(s[4 * 33], s[5 * 33]); o.w = pk2(s[6 * 33], s[7 * 33]);
        __builtin_nontemporal_store(o, (u32x4*)(dst + (size_t)n * K + k0 + 8 * c)); }
    LDS_WAIT(); asm volatile("" ::: "memory");
}
__device__ __forceinline__ int zsrc_col(int n) {
    if (n < 1024) return n;
    if (n < 2048) { const int t = (n - 1024) >> 8, j = (n - 1024) & 255; return j < 128 ? 1024 + 128 * t + j : 1536 + 128 * t + (j - 128); }
    if (n < 3520) return n;
    if (n < 3584) return -1;
    if (n < NZ) return n + 64;
    if (n < NZ + 128) return 3520 + (n - NZ);
    return -1;
}
constexpr int CV_GU = 2 * (NGU / 32) * (D / 64), CV_D = 2 * (D / 32) * (DFF / 64), CV_IN = (NZW / 32) * (D / 64), CV_UQ = (768 / 32) * (512 / 64), CV_KV = (1024 / 32) * (256 / 64),
              CV_BR = 4 * (D / 32) * (512 / 64), CV_OUT = (D / 32) * (D / 64), CV_LAYER = CV_GU + CV_D + CV_IN + CV_UQ + CV_KV + CV_BR + CV_OUT;
constexpr int CV_E0 = CV_GU / 2, CV_E1 = CV_E0 + CV_D / 2, CV_E2 = CV_E1 + CV_IN, CV_E3 = CV_E2 + CV_UQ, CV_E4 = CV_E3 + CV_KV, CV_E5 = CV_E4 + CV_BR, CV_E6 = CV_E5 + CV_OUT, CV_E7 = CV_E6 + CV_GU / 2, CV_E8 = CV_E7 + CV_D / 2;
static_assert(CV_E8 == CV_LAYER, "conversion item count");
constexpr int CW_QHEAD = 2048, CW_DONE = 2112;
__device__ __forceinline__ void cvt_item_idx(const Ctx& C, unsigned char* ws, int it, LAS float* scr, int lane) {
    const int l = it / CV_LAYER; int r = it - l * CV_LAYER;
    const float* W; int ldw, sc0, K, k0; bf16_t* dst; const float* ks = nullptr; bool perm = false;
    if (r < CV_E0 || (r >= CV_E6 && r < CV_E7)) { const int f = r >= CV_E6; if (f) r -= CV_E6; const int kb = r / (NGU / 32), nb = r - kb * (NGU / 32); const int n = nb * 32, tile = n >> 8, j = n & 255;
        W = (j < 128 ? C.in(I_WG) : C.in(I_WU)) + (size_t)(l * 2 + f) * D * DFF; ldw = DFF; sc0 = 128 * tile + (j & 127); dst = WLP(bf16_t, l, WL_GU) + ((size_t)f * NGU + n) * D; K = D; k0 = kb * 64; }
    else if (r < CV_E1 || r >= CV_E7) { const int f = r >= CV_E7; r -= f ? CV_E7 : CV_E0; const int kb = r / (D / 32), nb = r - kb * (D / 32);
        W = C.in(I_WD) + (size_t)(l * 2 + f) * DFF * D; ldw = D; sc0 = nb * 32; dst = WLP(bf16_t, l, WL_D) + ((size_t)f * D + nb * 32) * DFF; K = DFF; k0 = kb * 64; }
    else if (r < CV_E2) { r -= CV_E1; const int kb = r / (NZW / 32), nb = r - kb * (NZW / 32);
        W = C.in(I_WIN) + (size_t)l * D * NIN; ldw = NIN; sc0 = zsrc_col(nb * 32); perm = (nb >= ZC_KR / 32 && nb < 3520 / 32); dst = WLP(bf16_t, l, WL_IN) + (size_t)nb * 32 * D; K = D; k0 = kb * 64; }
    else if (r < CV_E3) { r -= CV_E2; const int kb = r / 24, nb = r - kb * 24;
        W = C.in(I_WUQ) + (size_t)l * 512 * 768; ldw = 768; sc0 = nb * 32; perm = (nb % 6) >= 4; dst = WLP(bf16_t, l, WL_UQ) + (size_t)nb * 32 * 512; K = 512; k0 = kb * 64; ks = C.in(I_QNORM) + l * 512; }
    else if (r < CV_E4) { r -= CV_E3; const int kb = r / 32, nb = r - kb * 32;
        W = C.in(I_WUKV) + (size_t)l * 256 * 1024; ldw = 1024; sc0 = (((nb * 32) & 511) >> 7) * 256 + ((nb * 32) >> 9) * 128 + ((nb * 32) & 127); dst = WLP(bf16_t, l, WL_KV) + (size_t)nb * 32 * 256; K = 256; k0 = kb * 64; ks = C.in(I_KVNORM) + l * 256; }
    else if (r < CV_E5) { r -= CV_E4; const int b = r / (CV_BR / 4); r -= b * (CV_BR / 4); const int kb = r / 64, nb = r - kb * 64;
        W = C.in(I_WBR) + (size_t)(l * 4 + b) * 512 * D; ldw = D; sc0 = nb * 32; dst = WLP(bf16_t, l, WL_BR) + ((size_t)b * D + nb * 32) * 512; K = 512; k0 = kb * 64; }
    else { r -= CV_E5; const int kb = r / 64, nb = r - kb * 64;
        W = C.in(I_WOUT) + (size_t)l * D * D; ldw = D; sc0 = nb * 32; dst = WLP(bf16_t, l, WL_OUT) + (size_t)nb * 32 * D; K = D; k0 = kb * 64; }
    cvt_item(W, ldw, sc0, dst, K, k0, ks, scr, lane, perm);
}
__device__ __forceinline__ void cvt_pull(const Ctx& C, LAS unsigned char* lds, int mand_end, int done_word  , int G) {
    const int tid = fresh_tid(), lane = tid & 63, wid = tid >> 6;
    volatile LAS unsigned* sh = (volatile LAS unsigned*)(lds + 8 * 8448);
    if (done_word && tid == 0) (void)__hip_atomic_fetch_add((unsigned*)(C.ws() + WS_CTL) + done_word, 1u, __ATOMIC_RELAXED, __HIP_MEMORY_SCOPE_AGENT);
    for (;;) {
        __syncthreads();
        if (tid == 0) { unsigned* const ctl = (unsigned*)(C.ws() + WS_CTL); const unsigned h = __hip_atomic_load(ctl + CW_QHEAD, __ATOMIC_RELAXED, __HIP_MEMORY_SCOPE_AGENT); bool go = false;
            if (h < (unsigned)(DEPTH * CV_LAYER)) { if (h < (unsigned)mand_end) go = true; else if (done_word && __hip_atomic_load(ctl + done_word, __ATOMIC_RELAXED, __HIP_MEMORY_SCOPE_AGENT) < (unsigned)G) go = true; }
            sh[0] = go ? __hip_atomic_fetch_add(ctl + CW_QHEAD, 16u, __ATOMIC_RELAXED, __HIP_MEMORY_SCOPE_AGENT) : 0xffffffffu; }
        __syncthreads();
        const unsigned base = sh[0];
        if (base == 0xffffffffu) break;
#pragma unroll 1
        for (int i = 0; i < 2; ++i) { const int it = (int)base + wid * 2 + i; if (it < DEPTH * CV_LAYER) cvt_item_idx(C, C.ws(), it, (LAS float*)(lds + wid * 8448), lane); }
    }
}
__device__ __forceinline__ void prologue_phase(const Ctx& C, LAS unsigned char* lds, int G, int bid) {
    unsigned char* const ws = C.ws();
    const int tid = fresh_tid(), lane = tid & 63, wid = tid >> 6;
    if (bid == 0) { float* tab = WSP(float, WS_TAB);
        for (int i = tid; i < 64 * 16; i += 512) { const int pos = i >> 4, f = i & 15; const float ang = (float)pos * exp2f(-(float)f * (13.287712379549449f / 16.f)); float s, c; sincosf(ang, &s, &c); tab[2 * i] = c; tab[2 * i + 1] = s; } }
    {
        LAS float* SC = (LAS float*)lds; LAS float* PART = (LAS float*)(lds + 40960);
        { const float* const cp = C.in(I_C); const float* const cc = C.in(I_CCTX); float xs[20];
#pragma unroll
          for (int j = 0; j < 20; ++j) { const int i = tid + 512 * j; xs[j] = j < 16 ? cp[i] : cc[i - 4 * D]; }
#pragma unroll
          for (int j = 0; j < 20; ++j) { const float x = xs[j]; SC[tid + 512 * j] = x / (1.f + expf(-x)); } }
        __syncthreads();
        const int kg = tid >> 3, ct = tid & 7;
        for (int it = bid; it < DEPTH * (NMOD / 32); it += G) { const int l = it / (NMOD / 32), ng = it - l * (NMOD / 32);
            const float* wp = C.in(I_WMOD) + ((size_t)l * D + kg * 32) * NMOD + ng * 32 + ct * 4;
            f32x4 a[5];
#pragma unroll
            for (int s = 0; s < 5; ++s) a[s] = (f32x4){0.f, 0.f, 0.f, 0.f};
#pragma unroll 4
            for (int kk = 0; kk < 32; ++kk) { const f32x4 w = __builtin_nontemporal_load((const f32x4*)(wp + (size_t)kk * NMOD));
#pragma unroll
                for (int s = 0; s < 5; ++s) a[s] += w * SC[s * D + kg * 32 + kk]; }
#pragma unroll
            for (int s = 0; s < 5; ++s) *(LAS f32x4*)(PART + (kg * 5 + s) * 32 + ct * 4) = a[s];
            __syncthreads();
            if (tid < 160) { const int s = tid >> 5, cc = tid & 31; float v = C.in(I_BMOD)[(size_t)l * NMOD + ng * 32 + cc];
                for (int k2 = 0; k2 < 64; ++k2) v += PART[(k2 * 5 + s) * 32 + cc];
                WSP(float, WS_MOD)[((size_t)l * 5 + s) * NMOD + ng * 32 + cc] = v; }
            __syncthreads();
        }
    }
    { const int gt = bid * 512 + tid, GT = G * 512;
        for (int i = gt; i < DEPTH * 65536; i += GT) { const int l = i >> 16; WLP(bf16_t, l, WL_GMW)[i & 65535] = (bf16_t)f2bf(C.in(I_GMWS)[i]); }
        for (int i = gt; i < DEPTH * NZW; i += GT) { const int l = i / NZW, n = i - l * NZW; int nn = n; if (n >= ZC_KR && n < 3520) { const int pp = n & 31; nn = (n & ~31) + 4 * (pp >> 3) + (pp & 3) + 16 * ((pp >> 2) & 1); }
            const int sc = zsrc_col(nn); WLP(float, l, WL_BZ)[n] = sc >= 0 ? C.in(I_BIN)[(size_t)l * NIN + sc] : 0.f; } }
    __syncthreads();
    cvt_pull(C, lds, CV_E0, 0, G);
}

struct NormArgs { const float* xin_lat; const float* xin_ctx; bf16_t* XB; float* outf; const bf16_t* Y; const float* part; bf16_t* H; bool store; };
#define NCOL(r, j) (4 * lane + 256 * (((j) + (r)) & 7))
template <bool XF32> __device__ __forceinline__ void norm_row_load(const NormArgs& A, int r, int lane, f32x4 (&x)[8], u32x2 (&xr)[8], u32x2 (&yr)[8]) {
    if (XF32) { const float* xi = r < ML ? A.xin_lat + (size_t)r * D : A.xin_ctx + (size_t)(r - ML) * D;
#pragma unroll
        for (int j = 0; j < 8; ++j) x[j] = __builtin_nontemporal_load((const f32x4*)(xi + NCOL(r, j)));
    } else {
#pragma unroll
        for (int j = 0; j < 8; ++j) xr[j] = __builtin_nontemporal_load((const u32x2*)(A.XB + (size_t)r * D + NCOL(r, j)));
    }
    if (A.Y && !(A.part && r >= ML)) {
#pragma unroll
        for (int j = 0; j < 8; ++j) yr[j] = __builtin_nontemporal_load((const u32x2*)(A.Y + (size_t)r * D + NCOL(r, j)));
    }
}
template <bool XF32> __device__ __forceinline__ void norm_row_compute(const NormArgs& A, const LAS float* V, int r, int lane, const f32x4 (&xf)[8], const u32x2 (&xr)[8], u32x2 (&yr)[8]) {
    float rs = 0.f;
    if (A.Y) {
        if (A.part && r >= ML) {
#pragma unroll
            for (int j = 0; j < 8; ++j) { const float* pp = A.part + (size_t)(r - ML) * D + NCOL(r, j); f32x4 pq[8];
#pragma unroll
                for (int q = 0; q < 8; ++q) pq[q] = __builtin_nontemporal_load((const f32x4*)(pp + (size_t)q * MC * D));
                __builtin_amdgcn_sched_barrier(0);
                const f32x4 a = ((pq[0] + pq[1]) + (pq[2] + pq[3])) + ((pq[4] + pq[5]) + (pq[6] + pq[7]));
                yr[j].x = cvt_pk_bf16(a[0], a[1]); yr[j].y = cvt_pk_bf16(a[2], a[3]); }
        }
        float ss = 0.f;
#pragma unroll
        for (int j = 0; j < 8; ++j) { const float y0 = bflo(yr[j].x), y1 = bfhi(yr[j].x), y2 = bflo(yr[j].y), y3 = bfhi(yr[j].y); ss += (y0 * y0 + y1 * y1) + (y2 * y2 + y3 * y3); }
        rs = __builtin_amdgcn_rsqf(wave_sum(ss) * (1.f / D) + EPS);
    }
#define NORM_X(j) ((XF32 ? xf[j] : (f32x4){bflo(xr[j].x), bfhi(xr[j].x), bflo(xr[j].y), bfhi(xr[j].y)}) + (A.Y ? *(const LAS f32x4*)(V + NCOL(r, j)) * ((f32x4){bflo(yr[j].x), bfhi(yr[j].x), bflo(yr[j].y), bfhi(yr[j].y)} * rs) : (f32x4){0.f, 0.f, 0.f, 0.f}))
    float rx = 0.f;
    if (A.H) { float ss = 0.f;
#pragma unroll
        for (int j = 0; j < 8; ++j) { const f32x4 x = NORM_X(j); ss += (x[0] * x[0] + x[1] * x[1]) + (x[2] * x[2] + x[3] * x[3]); if (j & 1) __builtin_amdgcn_sched_barrier(0); }
        rx = __builtin_amdgcn_rsqf(wave_sum(ss) * (1.f / D) + EPS); }
#pragma unroll
    for (int j = 0; j < 8; ++j) { const f32x4 x = NORM_X(j);
        if (A.outf) __builtin_nontemporal_store(x, (f32x4*)(A.outf + (size_t)r * D + NCOL(r, j)));
        else if (A.store) { u32x2 w; w.x = cvt_pk_bf16(x[0], x[1]); w.y = cvt_pk_bf16(x[2], x[3]); __builtin_nontemporal_store(w, (u32x2*)(A.XB + (size_t)r * D + NCOL(r, j))); }
        if (A.H) { const f32x4 h = (x * rx) * *(const LAS f32x4*)(V + D + NCOL(r, j)) + *(const LAS f32x4*)(V + 2 * D + NCOL(r, j)); u32x2 w; w.x = cvt_pk_bf16(h[0], h[1]); w.y = cvt_pk_bf16(h[2], h[3]);
            *(u32x2*)(A.H + (size_t)r * D + NCOL(r, j)) = w; }
        if (j & 1) __builtin_amdgcn_sched_barrier(0); }
#undef NORM_X
}
template <bool XF32> __device__ __forceinline__ void norm_phase(LAS unsigned char* lds, int G, int bid, int rows, const float* xin_lat, const float* xin_ctx, bf16_t* XB, float* outf, bool store,
                                           const bf16_t* Y, const float* part  , const float* modg  , int kgate, float coef, const float* gpost,
                                           bf16_t* H, const float* modh  , int kshift, const float* gpre) {
    constexpr int NR = XF32 ? 2 : NORM_NR;
    const int tid = fresh_tid(), lane = tid & 63, wid = __builtin_amdgcn_readfirstlane(tid >> 6);
    const NormArgs A{xin_lat, xin_ctx, XB, outf, Y, part, H, store};
    LAS float* V = (LAS float*)lds;
    int s_have = -1;
    for (int r0 = bid * 8 * NR; r0 < rows + (rows > ML ? 0 : 0); r0 += G * 8 * NR) {
        if (r0 >= ML) break;
        const int s = r0 >> 12;
        if (s != s_have) { __syncthreads();
            { const int c = 4 * tid; f32x4 gg = (f32x4){0.f, 0.f, 0.f, 0.f}, a = gg, b = gg;
              if (Y) gg = *(const f32x4*)(modg + (size_t)s * NMOD + kgate * D + c) * *(const f32x4*)(gpost + c) * coef;
              if (H) { a = *(const f32x4*)(gpre + c) * (*(const f32x4*)(modh + (size_t)s * NMOD + (kshift + 1) * D + c) + 1.f); b = *(const f32x4*)(modh + (size_t)s * NMOD + kshift * D + c); }
              *(LAS f32x4*)(V + c) = gg; *(LAS f32x4*)(V + D + c) = a; *(LAS f32x4*)(V + 2 * D + c) = b; }
            __syncthreads(); s_have = s; }
        f32x4 xf[XF32 ? NR : 1][8]; u32x2 xr[XF32 ? 1 : NR][8], yr[NR][8];
#pragma unroll
        for (int k = 0; k < NR; ++k)
#pragma unroll
            for (int j = 0; j < 8; ++j) { yr[k][j] = (u32x2){0u, 0u}; if (XF32) xf[k][j] = (f32x4){0.f, 0.f, 0.f, 0.f}; else xr[k][j] = (u32x2){0u, 0u}; }
#pragma unroll
        for (int k = 0; k < NR; ++k) norm_row_load<XF32>(A, r0 + wid + 8 * k, lane, xf[XF32 ? k : 0], xr[XF32 ? 0 : k], yr[k]);
        __builtin_amdgcn_sched_barrier(0);
#pragma unroll
        for (int k = 0; k < NR; ++k) { norm_row_compute<XF32>(A, V, r0 + wid + 8 * k, lane, xf[XF32 ? k : 0], xr[XF32 ? 0 : k], yr[k]); __builtin_amdgcn_sched_barrier(0); }
    }
    if (rows > ML) {
        for (int r0 = ML + bid * 8; r0 < rows; r0 += G * 8) {
            if (s_have != 4) { __syncthreads();
                { const int c = 4 * tid; f32x4 gg = (f32x4){0.f, 0.f, 0.f, 0.f}, a = gg, b = gg;
                  if (Y) gg = *(const f32x4*)(modg + (size_t)4 * NMOD + kgate * D + c) * *(const f32x4*)(gpost + c) * coef;
                  if (H) { a = *(const f32x4*)(gpre + c) * (*(const f32x4*)(modh + (size_t)4 * NMOD + (kshift + 1) * D + c) + 1.f); b = *(const f32x4*)(modh + (size_t)4 * NMOD + kshift * D + c); }
                  *(LAS f32x4*)(V + c) = gg; *(LAS f32x4*)(V + D + c) = a; *(LAS f32x4*)(V + 2 * D + c) = b; }
                __syncthreads(); s_have = 4; }
            f32x4 x[8]; u32x2 xr[8], yr[8];
#pragma unroll
            for (int j = 0; j < 8; ++j) { yr[j] = (u32x2){0u, 0u}; xr[j] = (u32x2){0u, 0u}; x[j] = (f32x4){0.f, 0.f, 0.f, 0.f}; }
            norm_row_load<XF32>(A, r0 + wid, lane, x, xr, yr);
            norm_row_compute<XF32>(A, V, r0 + wid, lane, x, xr, yr);
        }
    }
    __syncthreads();
}
#undef NCOL

__device__ __forceinline__ f32x4 mfma16(bf16x8 a, bf16x8 b, f32x4 c) { return __builtin_amdgcn_mfma_f32_16x16x32_bf16(a, b, c, 0, 0, 0); }
__device__ __forceinline__ void gmlp_chunk(const Ctx& C, int l, LAS unsigned char* lds, int R0, int g_lo) {
    unsigned char* const ws = C.ws();
    const bf16_t* Z = WSP(const bf16_t, WS_Z); bf16_t* YA = WSP(bf16_t, WS_YBR);
    const float* lng = C.in(I_GMLNG) + l * 512; const float* lnb = C.in(I_GMLNB) + l * 512; const float* bs = C.in(I_GMBS) + l * 512; const bf16_t* WS = WLP(const bf16_t, l, WL_GMW);
    LAS float* stats = (LAS float*)lds; LAS bf16_t* vnT = (LAS bf16_t*)(lds + 1024);
    const int tid = fresh_tid(), lane = tid & 63, wid = tid >> 6, i16 = lane & 15, g4 = lane >> 4;
    for (int rr = 0; rr < 16; ++rr) { const int q = 16 * wid + rr; const u32x4 w = *(const u32x4*)(Z + (size_t)(R0 + q) * NZ + 512 + 8 * lane);
        const float v[8] = {bflo(w.x), bfhi(w.x), bflo(w.y), bfhi(w.y), bflo(w.z), bfhi(w.z), bflo(w.w), bfhi(w.w)};
        float s = 0.f;
#pragma unroll
        for (int e = 0; e < 8; ++e) s += v[e];
        const float mean = wave_sum(s) * (1.f / 512.f); float q2 = 0.f;
#pragma unroll
        for (int e = 0; e < 8; ++e) { const float d = v[e] - mean; q2 += d * d; }
        const float rstd = __builtin_amdgcn_rsqf(wave_sum(q2) * (1.f / 512.f) + EPS);
        if (lane == 0) { stats[2 * q] = mean; stats[2 * q + 1] = rstd; } }
    __syncthreads();
    for (int g = g_lo; g < g_lo + 2; ++g) {
        u32x4 wj[4];
#pragma unroll
        for (int j = 0; j < 4; ++j) { const int id = tid + 512 * j, q = id >> 4, cc = id & 15; wj[j] = *(const u32x4*)(Z + (size_t)(R0 + q) * NZ + 512 + g * 128 + 8 * cc); }
        __builtin_amdgcn_sched_barrier(0);
#pragma unroll
        for (int j = 0; j < 4; ++j) { const int id = tid + 512 * j, q = id >> 4, cc = id & 15; const u32x4 w = wj[j];
            const float v[8] = {bflo(w.x), bfhi(w.x), bflo(w.y), bfhi(w.y), bflo(w.z), bfhi(w.z), bflo(w.w), bfhi(w.w)};
            const float mean = stats[2 * q], rstd = stats[2 * q + 1];
            const f32x4 g0 = *(const f32x4*)(lng + g * 128 + 8 * cc), g1 = *(const f32x4*)(lng + g * 128 + 8 * cc + 4), b0 = *(const f32x4*)(lnb + g * 128 + 8 * cc), b1 = *(const f32x4*)(lnb + g * 128 + 8 * cc + 4);
            const float gg[8] = {g0[0], g0[1], g0[2], g0[3], g1[0], g1[1], g1[2], g1[3]}, bb[8] = {b0[0], b0[1], b0[2], b0[3], b1[0], b1[1], b1[2], b1[3]};
#pragma unroll
            for (int e = 0; e < 8; ++e) vnT[(8 * cc + e) * 136 + q] = (bf16_t)f2bf((v[e] - mean) * rstd * gg[e] + bb[e]); }
        __syncthreads();
        bf16x8 bw[4];
#pragma unroll
        for (int ks = 0; ks < 4; ++ks) bw[ks] = *(const bf16x8*)(WS + (size_t)(g * 128 + 16 * wid + i16) * 128 + 32 * ks + 8 * g4);
        f32x4 acc[8];
#pragma unroll
        for (int ct = 0; ct < 8; ++ct) { acc[ct] = (f32x4){0.f, 0.f, 0.f, 0.f};
#pragma unroll
            for (int ks = 0; ks < 4; ++ks) { const bf16x8 a = *(const LAS bf16x8*)(vnT + (16 * ct + i16) * 136 + 32 * ks + 8 * g4); acc[ct] = mfma16(a, bw[ks], acc[ct]); } }
        const int prow = R0 + 16 * wid + i16; const float bsv = bs[g * 128 + 16 * wid + i16];
        u32x2 uwv[8];
#pragma unroll
        for (int ct = 0; ct < 8; ++ct) uwv[ct] = *(const u32x2*)(Z + (size_t)prow * NZ + g * 128 + 16 * ct + 4 * g4);
        __builtin_amdgcn_sched_barrier(0);
#pragma unroll
        for (int ct = 0; ct < 8; ++ct) { const int c4 = g * 128 + 16 * ct + 4 * g4; const u32x2 uw = uwv[ct];
            u32x2 o; o.x = cvt_pk_bf16(bflo(uw.x) * (acc[ct][0] + bsv), bfhi(uw.x) * (acc[ct][1] + bsv)); o.y = cvt_pk_bf16(bflo(uw.y) * (acc[ct][2] + bsv), bfhi(uw.y) * (acc[ct][3] + bsv));
            *(u32x2*)(YA + (size_t)prow * 512 + c4) = o; }
        __syncthreads();
    }
}
__device__ __forceinline__ void conv_block(const Ctx& C, int l, LAS unsigned char* lds, int SR0, int SL, int p0) {
    unsigned char* const ws = C.ws();
    const bf16_t* HB = WSP(const bf16_t, WS_HB); bf16_t* YB = WSP(bf16_t, WS_YBR) + (size_t)MT * 512;
    const float* lng = C.in(I_CVLNG) + l * 512; const float* lnb = C.in(I_CVLNB) + l * 512;
    LAS float* tile = (LAS float*)lds;
    const int tid = fresh_tid(), lane = tid & 63, wid = tid >> 6;
    float dw[31]; const float db = C.in(I_CVDB)[l * 512 + tid]; const float* const dwp = C.in(I_CVDW) + (size_t)l * 31 * 512 + tid;
#pragma unroll
    for (int j = 0; j < 31; ++j) dw[j] = dwp[j * 512];
    __builtin_amdgcn_sched_barrier(0);
    float hv[62]; unsigned raw[62];
#pragma unroll
    for (int j = 0; j < 62; ++j) { const int p = p0 - 15 + j; const int pc = p < 0 ? 0 : (p >= SL ? SL - 1 : p);
        raw[j] = HB[(size_t)(SR0 + pc) * 512 + tid]; }
    __builtin_amdgcn_sched_barrier(0);
#pragma unroll
    for (int j = 0; j < 62; ++j) { const int p = p0 - 15 + j; hv[j] = (p >= 0 && p < SL) ? __builtin_bit_cast(float, raw[j] << 16) : 0.f; }
#pragma unroll
    for (int o = 0; o < 32; ++o) { float s = db;
#pragma unroll
        for (int j = 0; j < 31; ++j) s += dw[j] * hv[o + j];
        tile[o * 512 + tid] = s; }
    __syncthreads();
    const f32x4 lga = *(const f32x4*)(lng + 4 * lane), lgb = *(const f32x4*)(lng + 256 + 4 * lane), lba = *(const f32x4*)(lnb + 4 * lane), lbb = *(const f32x4*)(lnb + 256 + 4 * lane);
#pragma unroll
    for (int rr = 0; rr < 4; ++rr) { const int o = 4 * wid + rr; f32x4 a = *(const LAS f32x4*)(tile + o * 512 + 4 * lane), b = *(const LAS f32x4*)(tile + o * 512 + 256 + 4 * lane);
        const float mean = wave_sum((a[0] + a[1]) + (a[2] + a[3]) + (b[0] + b[1]) + (b[2] + b[3])) * (1.f / 512.f);
        a = a - mean; b = b - mean;
        const float rstd = __builtin_amdgcn_rsqf(wave_sum((a[0] * a[0] + a[1] * a[1]) + (a[2] * a[2] + a[3] * a[3]) + (b[0] * b[0] + b[1] * b[1]) + (b[2] * b[2] + b[3] * b[3])) * (1.f / 512.f) + EPS);
        const f32x4 ya = a * rstd * lga + lba, yb = b * rstd * lgb + lbb;
        u32x2 wa, wb; wa.x = cvt_pk_bf16(ya[0] * sigmoidf_(ya[0]), ya[1] * sigmoidf_(ya[1])); wa.y = cvt_pk_bf16(ya[2] * sigmoidf_(ya[2]), ya[3] * sigmoidf_(ya[3]));
        wb.x = cvt_pk_bf16(yb[0] * sigmoidf_(yb[0]), yb[1] * sigmoidf_(yb[1])); wb.y = cvt_pk_bf16(yb[2] * sigmoidf_(yb[2]), yb[3] * sigmoidf_(yb[3]));
        bf16_t* op = YB + (size_t)(SR0 + p0 + o) * 512; *(u32x2*)(op + 4 * lane) = wa; *(u32x2*)(op + 256 + 4 * lane) = wb; }
    __syncthreads();
}

struct AttnSrc { const bf16_t* k1; int k1ld; const bf16_t* k2; int k2ld; const bf16_t* vt; };
template <int DK1, int DK2, int DV> struct AttnGeo {
    static constexpr int DK = DK1 + DK2, KS = DK / 32, DT = DV / 16, KROW = DK + 8, VROW = 72, KC = DK / 8, NKC = 64 * KC / 512, NVC = DV * 8 / 512, KBYTES = 64 * KROW * 2, BUF = KBYTES + DV * VROW * 2;
    static_assert((64 * KC) % 512 == 0 && (DV * 8) % 512 == 0, "staging geometry");
};
template <int DK1, int DK2, int DV>
__device__ __forceinline__ void attn_load(const AttnSrc& S, int row0, int tid, u32x4 (&kr)[AttnGeo<DK1, DK2, DV>::NKC], u32x4 (&vr)[AttnGeo<DK1, DK2, DV>::NVC]) {
    typedef AttnGeo<DK1, DK2, DV> Gm;
#pragma unroll
    for (int i = 0; i < Gm::NKC; ++i) { const int c = tid + 512 * i, key = c / Gm::KC, part = c - key * Gm::KC;
        const bf16_t* src = (part < DK1 / 8) ? S.k1 + (size_t)(row0 + key) * S.k1ld + part * 8 : S.k2 + (size_t)(row0 + key) * S.k2ld + (part - DK1 / 8) * 8; kr[i] = *(const u32x4*)src; }
#pragma unroll
    for (int i = 0; i < Gm::NVC; ++i) { const int c = tid + 512 * i, d = c >> 3, c8 = c & 7; vr[i] = *(const u32x4*)(S.vt + (size_t)d * MT + row0 + 8 * c8); }
}
template <int DK1, int DK2, int DV>
__device__ __forceinline__ void attn_store(LAS unsigned char* buf, int tid, const u32x4 (&kr)[AttnGeo<DK1, DK2, DV>::NKC], const u32x4 (&vr)[AttnGeo<DK1, DK2, DV>::NVC]) {
    typedef AttnGeo<DK1, DK2, DV> Gm; LAS bf16_t* Ks = (LAS bf16_t*)buf; LAS bf16_t* Vt = (LAS bf16_t*)(buf + Gm::KBYTES);
#pragma unroll
    for (int i = 0; i < Gm::NKC; ++i) { const int c = tid + 512 * i, key = c / Gm::KC, part = c - key * Gm::KC;
        const int rho = (key & 32) + 16 * ((key >> 2) & 1) + 4 * ((key >> 3) & 3) + (key & 3);
        *(LAS u32x4*)(Ks + rho * Gm::KROW + part * 8) = kr[i]; }
#pragma unroll
    for (int i = 0; i < Gm::NVC; ++i) { const int c = tid + 512 * i, d = c >> 3, c8 = c & 7; *(LAS u32x4*)(Vt + d * Gm::VROW + 8 * c8) = vr[i]; }
}
template <int DT, bool MASK>
__device__ __forceinline__ void attn_softmax(f32x4 (&st)[2], float& m, float& l, f32x4 (&ot)[DT], bf16x8& pf, int kp0  , bool masked) {
    if (MASK && masked) {
#pragma unroll
        for (int t2 = 0; t2 < 2; ++t2)
#pragma unroll
            for (int r = 0; r < 4; ++r) if ((unsigned)(kp0 + 4 * t2 + r) > 256u) st[t2][r] = -1e30f;
    }
    float mx = __builtin_fmaxf(__builtin_fmaxf(__builtin_fmaxf(st[0][0], st[0][1]), __builtin_fmaxf(st[0][2], st[0][3])), __builtin_fmaxf(__builtin_fmaxf(st[1][0], st[1][1]), __builtin_fmaxf(st[1][2], st[1][3])));
    { auto r16 = __builtin_amdgcn_permlane16_swap(__builtin_bit_cast(unsigned, mx), __builtin_bit_cast(unsigned, mx), false, false);
      mx = __builtin_fmaxf(__builtin_bit_cast(float, r16[0]), __builtin_bit_cast(float, r16[1]));
      auto r32 = __builtin_amdgcn_permlane32_swap(__builtin_bit_cast(unsigned, mx), __builtin_bit_cast(unsigned, mx), false, false);
      mx = __builtin_fmaxf(__builtin_bit_cast(float, r32[0]), __builtin_bit_cast(float, r32[1])); }
    const float mn = __builtin_fmaxf(m, mx);
    if (__any(mn > m)) { const float alpha = fast_exp2(m - mn); l *= alpha;
#pragma unroll
        for (int dt = 0; dt < DT; ++dt) ot[dt] = ot[dt] * alpha; }
    m = mn;
    float ps = 0.f;
#pragma unroll
    for (int t2 = 0; t2 < 2; ++t2)
#pragma unroll
        for (int r = 0; r < 4; ++r) { st[t2][r] = fast_exp2(st[t2][r] - mn); ps += st[t2][r]; }
    union { u32x4 u; bf16x8 b; } q; q.u.x = cvt_pk_bf16(st[0][0], st[0][1]); q.u.y = cvt_pk_bf16(st[0][2], st[0][3]); q.u.z = cvt_pk_bf16(st[1][0], st[1][1]); q.u.w = cvt_pk_bf16(st[1][2], st[1][3]);
    pf = q.b;
    l += ps;
}
template <int DK1, int DK2, int DV, bool MASK>
__device__ __forceinline__ void attn_unit(LAS unsigned char* lds, const AttnSrc& S, const bf16_t* q0p, const bf16_t* q1p, bf16_t* o0p, bf16_t* o1p,
                                          int ctx_row0, int nctx, int loc_row0, int loc_pos0, int nloc, int qpos0, int qpos1, float m0, float l0) {
    typedef AttnGeo<DK1, DK2, DV> Gm; constexpr int KS = Gm::KS, DT = Gm::DT, KROW = Gm::KROW, VROW = Gm::VROW;
    const int tid = fresh_tid(), lane = tid & 63, i16 = lane & 15, g4 = lane >> 4;
    bf16x8 qf0[KS], qf1[KS];
#pragma unroll
    for (int ks = 0; ks < KS; ++ks) { qf0[ks] = *(const bf16x8*)(q0p + 32 * ks + 8 * g4); qf1[ks] = *(const bf16x8*)(q1p + 32 * ks + 8 * g4); }
    f32x4 ot0[DT], ot1[DT];
#pragma unroll
    for (int dt = 0; dt < DT; ++dt) { ot0[dt] = (f32x4){0.f, 0.f, 0.f, 0.f}; ot1[dt] = (f32x4){0.f, 0.f, 0.f, 0.f}; }
    float ma = m0, mb = m0, la = (g4 == 0) ? l0 : 0.f, lb = la;
    const int NT = nctx + nloc;
    u32x4 kr[Gm::NKC], vr[Gm::NVC];
#define TROW(t) ((t) < nctx ? ctx_row0 + 64 * (t) : loc_row0 + 64 * ((t) - nctx))
    attn_load<DK1, DK2, DV>(S, TROW(0), tid, kr, vr);
    __syncthreads();
    attn_store<DK1, DK2, DV>(lds, tid, kr, vr);
    __syncthreads();
    if (NT > 1) attn_load<DK1, DK2, DV>(S, TROW(1), tid, kr, vr);
    for (int tt = 0; tt < NT; ++tt) {
        LAS unsigned char* buf = lds + (tt & 1) * Gm::BUF; const LAS bf16_t* Ks = (const LAS bf16_t*)buf; const LAS bf16_t* Vt = (const LAS bf16_t*)(buf + Gm::KBYTES);
        const bool masked = MASK && tt >= nctx; const int kpb = loc_pos0 + 64 * (tt - nctx) + 8 * g4 + 128;
#pragma unroll
        for (int hh = 0; hh < 2; ++hh) {
            f32x4 sa[2], sb[2];
#pragma unroll
            for (int t2 = 0; t2 < 2; ++t2) { sa[t2] = (f32x4){0.f, 0.f, 0.f, 0.f}; sb[t2] = (f32x4){0.f, 0.f, 0.f, 0.f};
                bf16x8 kf[KS];
#pragma unroll
                for (int ks = 0; ks < KS; ++ks) kf[ks] = *(const LAS bf16x8*)(Ks + (32 * hh + 16 * t2 + i16) * KROW + 32 * ks + 8 * g4);
                __builtin_amdgcn_sched_barrier(0);
#pragma unroll
                for (int ks = 0; ks < KS; ++ks) { sa[t2] = mfma16(kf[ks], qf0[ks], sa[t2]); sb[t2] = mfma16(kf[ks], qf1[ks], sb[t2]); }
                __builtin_amdgcn_sched_barrier(0); }
            bf16x8 pa, pb;
            attn_softmax<DT, MASK>(sa, ma, la, ot0, pa, kpb + 32 * hh - qpos0, masked);
            attn_softmax<DT, MASK>(sb, mb, lb, ot1, pb, kpb + 32 * hh - qpos1, masked);
            __builtin_amdgcn_sched_barrier(0);
#pragma unroll
            for (int d4 = 0; d4 < DT; d4 += 4) { bf16x8 vf[4];
#pragma unroll
                for (int dd = 0; dd < 4; ++dd) vf[dd] = *(const LAS bf16x8*)(Vt + (16 * (d4 + dd) + i16) * VROW + 32 * hh + 8 * g4);
                __builtin_amdgcn_sched_barrier(0);
#pragma unroll
                for (int dd = 0; dd < 4; ++dd) { ot0[d4 + dd] = mfma16(vf[dd], pa, ot0[d4 + dd]); ot1[d4 + dd] = mfma16(vf[dd], pb, ot1[d4 + dd]); }
                __builtin_amdgcn_sched_barrier(0); }
        }
        if (tt + 1 < NT) attn_store<DK1, DK2, DV>(lds + ((tt + 1) & 1) * Gm::BUF, tid, kr, vr);
        __syncthreads();
        if (tt + 2 < NT) attn_load<DK1, DK2, DV>(S, TROW(tt + 2), tid, kr, vr);
    }
#undef TROW
    float lt = la + __shfl_xor(la, 16); lt += __shfl_xor(lt, 32); const float ia = 1.f / lt;
    lt = lb + __shfl_xor(lb, 16); lt += __shfl_xor(lt, 32); const float ib = 1.f / lt;
#pragma unroll
    for (int dt = 0; dt < DT; ++dt) { u32x2 w; w.x = cvt_pk_bf16(ot0[dt][0] * ia, ot0[dt][1] * ia); w.y = cvt_pk_bf16(ot0[dt][2] * ia, ot0[dt][3] * ia); *(u32x2*)(o0p + 16 * dt + 4 * g4) = w;
        w.x = cvt_pk_bf16(ot1[dt][0] * ib, ot1[dt][1] * ib); w.y = cvt_pk_bf16(ot1[dt][2] * ib, ot1[dt][3] * ib); *(u32x2*)(o1p + 16 * dt + 4 * g4) = w; }
}

constexpr int NPHASE = 2 + 12 * DEPTH;
__global__ void __launch_bounds__(512, 2) mk_fwd(Params P) {
    extern __shared__ __attribute__((aligned(16))) unsigned char lds_raw[];
    LAS unsigned char* lds = (LAS unsigned char*)lds_raw;
    const int tid = fresh_tid();
    volatile LAS unsigned* MISC = (volatile LAS unsigned*)(lds + MISC_OFF);
    for (int u = tid; u < (LDS_BYTES - RING_BYTES) / 4; u += 512) ((LAS unsigned*)(lds + RING_BYTES))[u] = 0u;
    __syncthreads();
    Ctx C; C.tab = (volatile LAS unsigned*)(lds + PTAB_OFF);
    if (tid == 0) {
#pragma unroll
        for (int i = 0; i < 28; ++i) { const unsigned long long v = (unsigned long long)P.in[i]; C.tab[2 * i] = (unsigned)v; C.tab[2 * i + 1] = (unsigned)(v >> 32); }
        { const unsigned long long v = (unsigned long long)P.out; C.tab[56] = (unsigned)v; C.tab[57] = (unsigned)(v >> 32); }
        { const unsigned long long v = (unsigned long long)P.ws; C.tab[58] = (unsigned)v; C.tab[59] = (unsigned)(v >> 32); }
        C.tab[60] = (unsigned)P.ph_lo; C.tab[61] = (unsigned)P.ph_hi;
    }
    __syncthreads();
    if (!MK_MULTI) (void)xcd_barrier_post((unsigned*)(C.ws() + WS_CTL) + CW_BAR, MISC + 8);
#define LO ((int)__builtin_amdgcn_readfirstlane(C.tab[60]))
#define HI ((int)__builtin_amdgcn_readfirstlane(C.tab[61]))
#define IN(k) (LO <= (k) && (k) < HI)
#define MKBAR XcdBarrier bar; bar.bar = (unsigned*)(C.ws() + WS_CTL) + CW_BAR; bar.x = xb_xcc_id(); bar.st = (volatile LAS unsigned*)(lds + MISC_OFF) + 8
#define SEAM(k) do { if (!MK_MULTI && IN(k) && IN((k) + 1)) { MKBAR; xcd_barrier(bar); } } while (0)
#define GRID const int G = gridDim.x, bid = blockIdx.x

    if (IN(0) && EN(12)) for (int _rep = 0; _rep < (((PROBE_MASK >> 12) & 1) ? 2 : 1); ++_rep) { if (_rep) { MKBAR; xcd_barrier(bar); } GRID; prologue_phase(C, lds, G, bid); }
    SEAM(0);

    for (int l = 0; l < DEPTH; ++l) {
        const int pb = 1 + 12 * l; const bool last = (l == DEPTH - 1);
        if (IN(pb + 0) && EN(0)) for (int _rep = 0; _rep < (((PROBE_MASK >> 0) & 1) ? 2 : 1); ++_rep) { if (_rep) { MKBAR; xcd_barrier(bar); } GRID; unsigned char* const ws = C.ws(); float* const out = C.out(); float* const XC = WSP(float, WS_XC);
            const float* modl = WSP(const float, WS_MOD) + (size_t)l * 5 * NMOD; const float* npre = C.in(I_NPRE) + (size_t)l * 3 * D; const float* npost = C.in(I_NPOST) + (size_t)l * 3 * D;
            if (l == 0) norm_phase<true>(lds, G, bid, MT, C.in(I_X), C.in(I_CTX), WSP(bf16_t, WS_XB), nullptr, false  , nullptr, nullptr, modl, 0, 0.f, nullptr, WSP(bf16_t, WS_H), modl, 0, npre);
            else norm_phase<false>(lds, G, bid, MT, nullptr, nullptr, WSP(bf16_t, WS_XB), nullptr, true, WSP(const bf16_t, WS_Y), (G >= 256 ? (const float*)C.out() : nullptr), modl - (size_t)5 * NMOD, 8, 0.5f, npost - D, WSP(bf16_t, WS_H), modl, 0, npre);
        }
        SEAM(pb + 0);
        if (IN(pb + 1) && EN(1)) for (int _rep = 0; _rep < (((PROBE_MASK >> 1) & 1) ? 2 : 1); ++_rep) { if (_rep) { MKBAR; xcd_barrier(bar); } GRID; unsigned char* const ws = C.ws();
            pg8::RectOrder S; S.init(MT / 256, NGU / 256, G, bid, 0, WSP(bf16_t, WS_H), 256 * D * 2, WLP(bf16_t, l, WL_GU), 256 * D * 2);
            pg8::EpiSwiglu E{WSP(bf16_t, WS_Z)}; pg8::gemm_phase<pg8::EpiSwiglu, pg8::RectOrder, true>(lds, D, D, D, S, E); }
        if (IN(pb + 1) && EN(1)) { GRID; cvt_pull(C, lds, l * CV_LAYER + CV_E2, CW_DONE + 64 * (pb + 1), G); }
        SEAM(pb + 1);
        if (IN(pb + 2) && EN(2)) for (int _rep = 0; _rep < (((PROBE_MASK >> 2) & 1) ? 2 : 1); ++_rep) { if (_rep) { MKBAR; xcd_barrier(bar); } GRID; unsigned char* const ws = C.ws();
            const bool split = (G >= 256);
            { pg8::RectOrder S; S.init((split ? ML : MT) / 256, D / 256, G, bid, 0, WSP(bf16_t, WS_Z), 256 * DFF * 2, WLP(bf16_t, l, WL_D), 256 * DFF * 2);
              pg8::EpiPlain<false> E{WSP(bf16_t, WS_Y), D, nullptr}; pg8::gemm_phase<pg8::EpiPlain<false>, pg8::RectOrder, true>(lds, DFF, DFF, DFF, S, E); }
            if (split) { const int tile = bid >> 3, part = bid & 7, ks = part < 5 ? 10 * part : 50 + 12 * (part - 5), kn = part < 5 ? 10 : 12;
              pg8::SplitOrder S; S.pm = ML / 256 + (tile >> 3); S.pn = tile & 7; S.part = part; S.have = bid < 256;
              S.A = (const char*)(WSP(bf16_t, WS_Z) + (size_t)S.pm * 256 * DFF + ks * 64); S.B = (const char*)(WLP(bf16_t, l, WL_D) + (size_t)S.pn * 256 * DFF + ks * 64);
              pg8::EpiPartial E{C.out(), ML, (size_t)MC * D}; pg8::gemm_phase<pg8::EpiPartial, pg8::SplitOrder, true>(lds, kn * 64, DFF, DFF, S, E); } }
        SEAM(pb + 2);
        if (IN(pb + 3) && EN(3)) for (int _rep = 0; _rep < (((PROBE_MASK >> 3) & 1) ? 2 : 1); ++_rep) { if (_rep) { MKBAR; xcd_barrier(bar); } GRID; unsigned char* const ws = C.ws(); float* const out = C.out(); float* const XC = WSP(float, WS_XC);
            const float* const modl = WSP(const float, WS_MOD) + (size_t)l * 5 * NMOD;
            if (l == 0) norm_phase<true>(lds, G, bid, MT, C.in(I_X), C.in(I_CTX), WSP(bf16_t, WS_XB), nullptr, true, WSP(const bf16_t, WS_Y), (G >= 256 ? (const float*)C.out() : nullptr), modl, 2, 0.5f, C.in(I_NPOST) + (size_t)l * 3 * D, WSP(bf16_t, WS_H), modl, 3, C.in(I_NPRE) + ((size_t)l * 3 + 1) * D);
            else norm_phase<false>(lds, G, bid, MT, nullptr, nullptr, WSP(bf16_t, WS_XB), nullptr, true, WSP(const bf16_t, WS_Y), (G >= 256 ? (const float*)C.out() : nullptr), modl, 2, 0.5f, C.in(I_NPOST) + (size_t)l * 3 * D, WSP(bf16_t, WS_H), modl, 3, C.in(I_NPRE) + ((size_t)l * 3 + 1) * D); }
        SEAM(pb + 3);
        if (IN(pb + 4) && EN(4)) for (int _rep = 0; _rep < (((PROBE_MASK >> 4) & 1) ? 2 : 1); ++_rep) { if (_rep) { MKBAR; xcd_barrier(bar); } GRID; unsigned char* const ws = C.ws();
            bf16_t* const Z = WSP(bf16_t, WS_Z); bf16_t* const H = WSP(bf16_t, WS_H);
            LAS float* const LTAB = (LAS float*)(lds + LTAB_OFF);
            { const int t_ = fresh_tid(); for (int i = t_; i < 2048; i += 512) LTAB[i] = WSP(const float, WS_TAB)[i]; __syncthreads(); }
            pg8::EpiZ E{Z, WSP(bf16_t, WS_HB), WSP(float, WS_SSP), WLP(const float, l, WL_BZ), LTAB, 0, 0};
            { pg8::RectOrder S; S.init(ML / 256, NZ / 256, G, bid, 0, H, 256 * D * 2, WLP(bf16_t, l, WL_IN), 256 * D * 2);
              pg8::gemm_phase<pg8::EpiZ, pg8::RectOrder, true>(lds, D, D, D, S, E); }
            int used = (ML / 256) * (NZ / 256);
            {
                const int ct0 = last ? 10 : 0, nct = last ? 4 : 14;
                pg8::EpiZ E2{Z, WSP(bf16_t, WS_HB), WSP(float, WS_SSP), WLP(const float, l, WL_BZ), LTAB, ct0, ML};
                pg8::RectOrder S; S.init(MC / 256, nct, G, bid, used, H + (size_t)ML * D, 256 * D * 2, WLP(bf16_t, l, WL_IN) + (size_t)ct0 * 256 * D, 256 * D * 2);
                pg8::gemm_phase<pg8::EpiZ, pg8::RectOrder, true>(lds, D, D, D, S, E2); used += (MC / 256) * nct; }
            {
                pg8::EpiVt<false> E3{WSP(bf16_t, WS_VTD), MT, WLP(const float, l, WL_BZ) + NZ, nullptr};
                pg8::RectOrder S; S.init(1, MT / 256, G, bid, used, WLP(bf16_t, l, WL_IN) + (size_t)NZ * D, 0, H, 256 * D * 2);
                pg8::gemm_phase<pg8::EpiVt<false>, pg8::RectOrder, true>(lds, D, D, D, S, E3); }
        }
        if (IN(pb + 4) && EN(4)) { GRID; cvt_pull(C, lds, l * CV_LAYER + CV_E7, CW_DONE + 64 * (pb + 4), G); }
        SEAM(pb + 4);
        if (IN(pb + 5) && EN(5)) for (int _rep = 0; _rep < (((PROBE_MASK >> 5) & 1) ? 2 : 1); ++_rep) { if (_rep) { MKBAR; xcd_barrier(bar); } GRID;
            const int lm_ = _rep ? PROBE_LOCMASK : LOCMASK;
            const int nch = 2 * ((last ? ML : MT) / 128), ncb = (last ? ML : MT) / 32;
            for (int it = bid; it < nch + ncb; it += G) {
                if (it < nch) { if (lm_ & 1) gmlp_chunk(C, l, lds, (it >> 1) * 128, 2 * (it & 1)); }
                else { const int cb = it - nch; int SR0, SL, p0; if (cb < ML / 32) { SR0 = (cb >> 7) * SEQ; SL = SEQ; p0 = (cb & 127) * 32; } else { const int c2 = cb - ML / 32; SR0 = ML + (c2 >> 3) * CTXL; SL = CTXL; p0 = (c2 & 7) * 32; }
                    if (lm_ & 2) conv_block(C, l, lds, SR0, SL, p0); }
            }
            __syncthreads();
            const int pan_q = (last ? ML : MT) / 256;
            if (!last) { unsigned char* const ws = C.ws();
              LAS float* const LTAB = (LAS float*)(lds + LTAB_OFF);
              pg8::EpiZ E2{WSP(bf16_t, WS_Z), WSP(bf16_t, WS_HB), WSP(float, WS_SSP), WLP(const float, l, WL_BZ), LTAB, 14, ML};
              pg8::RectOrder S; S.init(MC / 256, NZ / 256 - 14, G, bid, G / 2, WSP(bf16_t, WS_H) + (size_t)ML * D, 256 * D * 2, WLP(bf16_t, l, WL_IN) + (size_t)14 * 256 * D, 256 * D * 2);
              pg8::gemm_phase<pg8::EpiZ, pg8::RectOrder, true>(lds, D, D, D, S, E2); }
            if (lm_ & 4) { unsigned char* const ws = C.ws();
              pg8::RectOrder S; S.init(pan_q, 3, G, bid, 0, WSP(bf16_t, WS_Z) + ZC_CQ, 256 * NZ * 2, WLP(bf16_t, l, WL_UQ), 256 * 512 * 2);
              LAS float* const LTAB = (LAS float*)(lds + LTAB_OFF); { const int t_ = fresh_tid(); for (int i = t_; i < 2048; i += 512) LTAB[i] = WSP(const float, WS_TAB)[i]; __syncthreads(); }
              pg8::EpiQ E{WSP(bf16_t, WS_QM), WSP(const float, WS_SSP), LTAB}; pg8::gemm_phase<pg8::EpiQ, pg8::RectOrder, true>(lds, 512, NZ, 512, S, E); }
            if (lm_ & 8) { unsigned char* const ws = C.ws();
              { pg8::RectOrder S; S.init(MT / 256, 2, G, bid, last ? pan_q * 3 : 0, WSP(bf16_t, WS_Z) + ZC_CKV, 256 * NZ * 2, WLP(bf16_t, l, WL_KV), 256 * 256 * 2);
                pg8::EpiPlain<true> E{WSP(bf16_t, WS_KN), 512, WSP(const float, WS_SSP)}; pg8::gemm_phase<pg8::EpiPlain<true>, pg8::RectOrder, true>(lds, 256, NZ, 256, S, E); }
              { pg8::RectOrder S; S.init(2, MT / 256, G, bid, last ? pan_q * 3 + (MT / 256) * 2 : 0, WLP(bf16_t, l, WL_KV) + 512 * 256, 256 * 256 * 2, WSP(bf16_t, WS_Z) + ZC_CKV, 256 * NZ * 2);
                pg8::EpiVt<true> E{WSP(bf16_t, WS_VTM), MT, nullptr, WSP(const float, WS_SSP)}; pg8::gemm_phase<pg8::EpiVt<true>, pg8::RectOrder, true>(lds, 256, 256, NZ, S, E); } }
        }
        SEAM(pb + 5);
        if (IN(pb + 6) && EN(6)) for (int _rep = 0; _rep < (((PROBE_MASK >> 6) & 1) ? 2 : 1); ++_rep) { if (_rep) { MKBAR; xcd_barrier(bar); } GRID; unsigned char* const ws = C.ws();
            bf16_t* const YC = WSP(bf16_t, WS_YBR) + (size_t)2 * MT * 512; bf16_t* const YD = WSP(bf16_t, WS_YBR) + (size_t)3 * MT * 512;
            const bf16_t* const QM = WSP(const bf16_t, WS_QM); const bf16_t* const KN = WSP(const bf16_t, WS_KN); const bf16_t* const Z = WSP(const bf16_t, WS_Z);
            const bf16_t* const VTM = WSP(const bf16_t, WS_VTM); const bf16_t* const VTD = WSP(const bf16_t, WS_VTD);
            const float* const sink = C.in(I_SINK) + l * 8;
            const int tid2 = fresh_tid(), wid = __builtin_amdgcn_readfirstlane(tid2 >> 6), i16 = tid2 & 15;
            for (int u = bid; u < 256; u += G) { const int bh = (u & 7) + 8 * ((u >> 7) & 1), qb = (u >> 3) & 15, b = bh >> 2, h = bh & 3;
                const int row = b * SEQ + 256 * qb + 32 * wid + i16;
                AttnSrc S{KN + h * 128, 512, Z + ZC_KR, NZ, VTM + (size_t)h * 128 * MT};
                attn_unit<128, 64, 128, false>(lds, S, QM + (size_t)row * 768 + h * 192, QM + (size_t)(row + 16) * 768 + h * 192, YC + (size_t)row * 512 + h * 128, YC + (size_t)(row + 16) * 512 + h * 128,
                                               ML + b * CTXL, 4, b * SEQ, 0, 64, 0, 0, -1e30f, 0.f); }
            for (int u = bid; u < 512; u += G) { const int b = u >> 7, kvh = (u >> 6) & 1, qb = u & 63, q0 = 64 * qb, head = 4 * kvh + (wid >> 1);
                const int q = q0 + 32 * (wid & 1) + i16, row = b * SEQ + q;
                int tlo = (128 - q0) / 64; if (tlo < 0) tlo = 0; int thi = (SEQ + 128 - q0) / 64; if (thi > 5) thi = 5;
                const int lp0 = q0 - 128 + 64 * tlo;
                AttnSrc S{Z + ZC_KD + 64 * kvh, NZ, Z, NZ, VTD + (size_t)kvh * 64 * MT};
                attn_unit<64, 0, 64, true>(lds, S, Z + (size_t)row * NZ + ZC_QD + 64 * head, Z + (size_t)(row + 16) * NZ + ZC_QD + 64 * head, YD + (size_t)row * 512 + 64 * head, YD + (size_t)(row + 16) * 512 + 64 * head,
                                           ML + b * CTXL, 4, b * SEQ + lp0, lp0, thi - tlo, q, q + 16, sink[head] * LOG2E, 1.f); }
            if (!last) {
                for (int u = bid; u < 16; u += G) { const int b = u >> 2, h = u & 3; const int row = ML + b * CTXL + 32 * wid + i16;
                    AttnSrc S{KN + h * 128, 512, Z + ZC_KR, NZ, VTM + (size_t)h * 128 * MT};
                    attn_unit<128, 64, 128, false>(lds, S, QM + (size_t)row * 768 + h * 192, QM + (size_t)(row + 16) * 768 + h * 192, YC + (size_t)row * 512 + h * 128, YC + (size_t)(row + 16) * 512 + h * 128,
                                                   ML + b * CTXL, 4, 0, 0, 0, 0, 0, -1e30f, 0.f); }
                for (int u = bid - 16; u >= 0 && u < 32; u += G) { const int b = u >> 3, kvh = (u >> 2) & 1, qb = u & 3, head = 4 * kvh + (wid >> 1);
                    const int q = 64 * qb + 32 * (wid & 1) + i16, row = ML + b * CTXL + q;
                    AttnSrc S{Z + ZC_KD + 64 * kvh, NZ, Z, NZ, VTD + (size_t)kvh * 64 * MT};
                    attn_unit<64, 0, 64, false>(lds, S, Z + (size_t)row * NZ + ZC_QD + 64 * head, Z + (size_t)(row + 16) * NZ + ZC_QD + 64 * head, YD + (size_t)row * 512 + 64 * head, YD + (size_t)(row + 16) * 512 + 64 * head,
                                                ML + b * CTXL, 4, 0, 0, 0, 0, 0, sink[head] * LOG2E, 1.f); }
            }
            __syncthreads();
        }
        SEAM(pb + 6);
        if (IN(pb + 7) && EN(7)) for (int _rep = 0; _rep < (((PROBE_MASK >> 7) & 1) ? 2 : 1); ++_rep) { if (_rep) { MKBAR; xcd_barrier(bar); } GRID; unsigned char* const ws = C.ws();
            pg8::ChainOrder S; S.init((last ? ML : MT) / 256, D / 128, G, bid, 0, WSP(bf16_t, WS_YBR), 256 * 512 * 2, WLP(bf16_t, l, WL_BR), 128 * 512 * 2); S.nsub = MERGE_N; S.map = MERGE_MAP; S.sA = (size_t)MT * 512 * 2; S.sB = (size_t)D * 512 * 2;
            pg8::EpiM1H E{WSP(const bf16_t, WS_Z), WSP(bf16_t, WS_H), S.nsub - 1, S.map}; pg8::gemm_phase<pg8::EpiM1H, pg8::ChainOrder, true, true>(lds, 512, 512, 512, S, E); }
        SEAM(pb + 7);
        if (IN(pb + 8) && EN(8)) for (int _rep = 0; _rep < (((PROBE_MASK >> 8) & 1) ? 2 : 1); ++_rep) { if (_rep) { MKBAR; xcd_barrier(bar); } GRID; unsigned char* const ws = C.ws();
            const bool split = (G >= 256) && !last;
            { pg8::RectOrder S; S.init((last || split ? ML : MT) / 256, D / 256, G, bid, 0, WSP(bf16_t, WS_H), 256 * D * 2, WLP(bf16_t, l, WL_OUT), 256 * D * 2);
              pg8::EpiPlain<false> E{WSP(bf16_t, WS_Y), D, nullptr}; pg8::gemm_phase<pg8::EpiPlain<false>, pg8::RectOrder, true>(lds, D, D, D, S, E); }
            if (split) { const int tile = bid >> 3, part = bid & 7;
              pg8::SplitOrder S; S.pm = ML / 256 + (tile >> 3); S.pn = tile & 7; S.part = part; S.have = bid < 256;
              S.A = (const char*)(WSP(bf16_t, WS_H) + (size_t)S.pm * 256 * D + part * 256); S.B = (const char*)(WLP(bf16_t, l, WL_OUT) + (size_t)S.pn * 256 * D + part * 256);
              pg8::EpiPartial E{C.out(), ML, (size_t)MC * D}; pg8::gemm_phase<pg8::EpiPartial, pg8::SplitOrder, true>(lds, 256, D, D, S, E); } }
        SEAM(pb + 8);
        if (IN(pb + 9) && EN(9)) for (int _rep = 0; _rep < (((PROBE_MASK >> 9) & 1) ? 2 : 1); ++_rep) { if (_rep) { MKBAR; xcd_barrier(bar); } GRID; unsigned char* const ws = C.ws(); float* const out = C.out(); float* const XC = WSP(float, WS_XC);
            norm_phase<false>(lds, G, bid, last ? ML : MT, nullptr, nullptr, WSP(bf16_t, WS_XB), nullptr, true, WSP(const bf16_t, WS_Y), (G >= 256 && !last) ? (const float*)C.out() : nullptr, WSP(const float, WS_MOD) + (size_t)l * 5 * NMOD, 5, 1.0f, C.in(I_NPOST) + ((size_t)l * 3 + 1) * D, WSP(bf16_t, WS_H), WSP(const float, WS_MOD) + (size_t)l * 5 * NMOD, 6, C.in(I_NPRE) + ((size_t)l * 3 + 2) * D); }
        SEAM(pb + 9);
        if (IN(pb + 10) && EN(10)) for (int _rep = 0; _rep < (((PROBE_MASK >> 10) & 1) ? 2 : 1); ++_rep) { if (_rep) { MKBAR; xcd_barrier(bar); } GRID; unsigned char* const ws = C.ws();
            pg8::RectOrder S; S.init((last ? ML : MT) / 256, NGU / 256, G, bid, 0, WSP(bf16_t, WS_H), 256 * D * 2, WLP(bf16_t, l, WL_GU) + (size_t)NGU * D, 256 * D * 2);
            pg8::EpiSwiglu E{WSP(bf16_t, WS_Z)}; pg8::gemm_phase<pg8::EpiSwiglu, pg8::RectOrder, true>(lds, D, D, D, S, E); }
        if (IN(pb + 10) && EN(10)) { GRID; cvt_pull(C, lds, l * CV_LAYER + CV_LAYER + CV_E0, CW_DONE + 64 * (pb + 10), G); }
        SEAM(pb + 10);
        if (IN(pb + 11) && EN(11)) for (int _rep = 0; _rep < (((PROBE_MASK >> 11) & 1) ? 2 : 1); ++_rep) { if (_rep) { MKBAR; xcd_barrier(bar); } GRID; unsigned char* const ws = C.ws();
            const bool split = (G >= 256) && !last;
            { pg8::RectOrder S; S.init((last || split ? ML : MT) / 256, D / 256, G, bid, 0, WSP(bf16_t, WS_Z), 256 * DFF * 2, WLP(bf16_t, l, WL_D) + (size_t)D * DFF, 256 * DFF * 2);
              pg8::EpiPlain<false> E{WSP(bf16_t, WS_Y), D, nullptr}; pg8::gemm_phase<pg8::EpiPlain<false>, pg8::RectOrder, true>(lds, DFF, DFF, DFF, S, E); }
            if (split) { const int tile = bid >> 3, part = bid & 7, ks = part < 5 ? 10 * part : 50 + 12 * (part - 5), kn = part < 5 ? 10 : 12;
              pg8::SplitOrder S; S.pm = ML / 256 + (tile >> 3); S.pn = tile & 7; S.part = part; S.have = bid < 256;
              S.A = (const char*)(WSP(bf16_t, WS_Z) + (size_t)S.pm * 256 * DFF + ks * 64); S.B = (const char*)(WLP(bf16_t, l, WL_D) + (size_t)D * DFF + (size_t)S.pn * 256 * DFF + ks * 64);
              pg8::EpiPartial E{C.out(), ML, (size_t)MC * D}; pg8::gemm_phase<pg8::EpiPartial, pg8::SplitOrder, true>(lds, kn * 64, DFF, DFF, S, E); } }
        SEAM(pb + 11);
    }
    if (IN(NPHASE - 1) && EN(13)) { GRID; unsigned char* const ws = C.ws(); float* const out = C.out(); float* const XC = WSP(float, WS_XC);
        const int l = DEPTH - 1;
        norm_phase<false>(lds, G, bid, ML, nullptr, nullptr, WSP(bf16_t, WS_XB), out, false, WSP(const bf16_t, WS_Y), nullptr, WSP(const float, WS_MOD) + (size_t)l * 5 * NMOD, 8, 0.5f, C.in(I_NPOST) + ((size_t)l * 3 + 2) * D, nullptr, nullptr, 0, nullptr);
    }
#undef IN
#undef SEAM
}


extern "C" void kernel_launch(void* const* d_in, const int* in_sizes, int n_in, void* d_out, int out_size, void* d_ws, size_t ws_size, hipStream_t stream) {
    static int grid = 0;
    if (grid == 0) {
        if (n_in != 28 || out_size != ML * D || ws_size < WS_END) { fprintf(stderr, "kernel_launch: unexpected shapes (n_in %d, out %d, ws %zu < %zu)\n", n_in, out_size, ws_size, (size_t)WS_END); grid = -1; return; }
        int dev = 0, cus = 0, per_cu = 0;
        if (hipGetDevice(&dev) != hipSuccess || hipDeviceGetAttribute(&cus, hipDeviceAttributeMultiprocessorCount, dev) != hipSuccess) { grid = -1; return; }
        if (hipFuncSetAttribute((const void*)mk_fwd, hipFuncAttributeMaxDynamicSharedMemorySize, LDS_BYTES) != hipSuccess) { fprintf(stderr, "kernel_launch: hipFuncSetAttribute failed\n"); grid = -1; return; }
        if (hipOccupancyMaxActiveBlocksPerMultiprocessor(&per_cu, (const void*)mk_fwd, 512, LDS_BYTES) != hipSuccess || per_cu < 1) fprintf(stderr, "kernel_launch: occupancy query says %d\n", per_cu);
        (void)hipGetLastError();
        grid = cus;
    }
    if (grid < 0) return;
    (void)hipMemsetAsync((char*)d_ws + WS_CTL, 0, CTL_ZERO_BYTES, stream);
    Params p{};
    for (int i = 0; i < 28; ++i) p.in[i] = (const float*)d_in[i];
    p.out = (float*)d_out; p.ws = (unsigned char*)d_ws;
#if MK_MULTI
    for (int k = 0; k < NPHASE; ++k) { p.ph_lo = k; p.ph_hi = k + 1; hipLaunchKernelGGL(mk_fwd, dim3(grid), dim3(512), LDS_BYTES, stream, p);
    }
#else
    p.ph_lo = 0; p.ph_hi = NPHASE; hipLaunchKernelGGL(mk_fwd, dim3(grid), dim3(512), LDS_BYTES, stream, p);
#endif
}
```

```cpp
#include <hip/hip_runtime.h>
#include <cstdio>
#include <cstdint>

#define LAS __attribute__((address_space(3)))
#define GAS __attribute__((address_space(1)))
typedef unsigned short bf16_t;
typedef short bf16x8 __attribute__((ext_vector_type(8)));
typedef float f32x4 __attribute__((ext_vector_type(4)));
typedef float f32x2 __attribute__((ext_vector_type(2)));
typedef unsigned u32x4 __attribute__((ext_vector_type(4)));
typedef unsigned u32x2 __attribute__((ext_vector_type(2)));

#ifndef PROBE_MASK
#define PROBE_MASK 0
#endif
#ifndef MK_CHECK_LAYER
#define MK_CHECK_LAYER 1
#endif
#ifndef NORM_NR
#define NORM_NR 4
#endif
#ifndef MERGE_N
#define MERGE_N 4
#define MERGE_MAP 0x3210
#endif
#ifndef PROBE_LOCMASK
#define PROBE_LOCMASK 15
#endif
#ifndef LOCMASK
#define LOCMASK 15
#endif
#ifndef PHMASK
#define PHMASK 0xffff
#endif
#define EN(j) (((PHMASK) >> (j)) & 1)
#ifndef MK_MULTI
#define ROLE_WID 4
#define MK_MULTI 0
#endif

constexpr int D = 2048, NB = 4, SEQ = 4096, DEPTH = 2, CTXL = 256, DFF = 5504;
constexpr int ML = NB * SEQ, MC = NB * CTXL, MT = ML + MC;
constexpr int NMOD = 9 * D, NIN = 11840, NZ = 11776, NZW = 12032, NGU = 2 * DFF;
constexpr int ZC_CQ = 2048, ZC_CKV = 2560, ZC_KR = 2816, ZC_QD = 2880, ZC_KD = 3392, ZC_G = 3584;
constexpr float EPS = 1e-6f;
constexpr float LOG2E = 1.4426950408889634f;

__device__ __forceinline__ unsigned f2bf(float f) { unsigned u = __builtin_bit_cast(unsigned, f); return (u + 0x7fffu + ((u >> 16) & 1u)) >> 16; }
__device__ __forceinline__ unsigned pk2(float lo, float hi) { return f2bf(lo) | (f2bf(hi) << 16); }
__device__ __forceinline__ float bflo(unsigned w) { return __builtin_bit_cast(float, w << 16); }
__device__ __forceinline__ float bfhi(unsigned w) { return __builtin_bit_cast(float, w & 0xffff0000u); }
__device__ __forceinline__ float bf2f(bf16_t h) { return __builtin_bit_cast(float, ((unsigned)h) << 16); }
__device__ __forceinline__ unsigned cvt_pk_bf16(float lo, float hi) { unsigned r; asm volatile("v_cvt_pk_bf16_f32 %0, %1, %2" : "=v"(r) : "v"(lo), "v"(hi)); return r; }
__device__ __forceinline__ float fast_exp2(float x) { return __builtin_amdgcn_exp2f(x); }
__device__ __forceinline__ float vmax(float a, float b) { float r; asm("v_max_f32 %0, %1, %2" : "=v"(r) : "v"(a), "v"(b)); return r; }
__device__ __forceinline__ float vmax3(float a, float b, float c) { float r; asm("v_max3_f32 %0, %1, %2, %3" : "=v"(r) : "v"(a), "v"(b), "v"(c)); return r; }
__device__ __forceinline__ float fast_rcp(float x) { return __builtin_amdgcn_rcpf(x); }
__device__ __forceinline__ float sigmoidf_(float x) { return fast_rcp(1.0f + fast_exp2(-x * LOG2E)); }
__device__ __forceinline__ int fresh_tid() { int t = threadIdx.x; asm volatile("" : "+v"(t)); return t; }
__device__ __forceinline__ float wave_sum(float v) {
#pragma unroll
    for (int o = 1; o < 64; o <<= 1) v += __shfl_xor(v, o);
    return v;
}
__device__ __forceinline__ float gelu1(float v) {
    const float av = __builtin_fabsf(v), t = fast_rcp(av * 0.2316418882f + 1.0f);
    float q = t * 0.5307027145f + (-0.7265760135f); q = q * t + 0.7107068705f; q = q * t + (-0.142248368f); q = q * t + 0.127414796f; q = q * t;
    const float e = fast_exp2((v * v) * (-0.72134752044f));
    const float m = v * (q * e);
    return v < 0.f ? m : v - m;
}

namespace pg8 {
constexpr int BM = 256, BK = 64, HALF = 128, HTB = HALF * BK * 2, STAGE_BYTES = 8 * HTB, NXCD = 8, WGM = 8;
__host__ __device__ __forceinline__ int lds_byte(int r, int c) { const int st = (r >> 4) * 2 + (c >> 5), rr = r & 15, cc = c & 31, ob = rr * 64 + cc * 2; return st * 1024 + (ob ^ (((ob >> 9) & 1) << 5)); }
__host__ __device__ __forceinline__ void stage_rc(int b, int& R, int& C) { const int st = b / 1024, sb = b % 1024, swz = sb ^ (((sb >> 9) & 1) << 5); R = (st >> 1) * 16 + swz / 64; C = (st & 1) * 32 + (swz % 64) / 2; }
__host__ __device__ __forceinline__ int perm32(int rho) { const int n = rho >> 4, i = rho & 15; return 8 * (i >> 2) + 4 * n + (i & 3); }

struct Unit { int pm, pn, sub; };
struct RectOrder {
    int nM, nN, nwg, G, c; const char* A; const char* B; unsigned tA, tB;
    __device__ __forceinline__ void init(int nM_, int nN_, int G_, int c_, int rot, const void* A_, unsigned tA_, const void* B_, unsigned tB_) { nM = nM_; nN = nN_; nwg = nM * nN; G = G_; c = (c_ + G_ - (rot % G_)) % G_; A = (const char*)A_; B = (const char*)B_; tA = tA_; tB = tB_; }
    __device__ __forceinline__ void tile_of(int wgid, Unit& u) const {
        { const int q = nwg / NXCD, r = nwg % NXCD, xcd = wgid % NXCD, off = wgid / NXCD; wgid = (xcd < r ? xcd * (q + 1) : r * (q + 1) + (xcd - r) * q) + off; }
        const int nig = WGM * nN, gid = wgid / nig, fm = gid * WGM, gsz = (nM - fm) < WGM ? (nM - fm) : WGM;
        u.pm = fm + ((wgid % nig) % gsz); u.pn = (wgid % nig) / gsz;
    }
    __device__ __forceinline__ bool next(int i, Unit& u) const { const long L = (long)i * G + c; if (L >= nwg) return false; tile_of((int)L, u); u.sub = 0; return true; }
    __device__ __forceinline__ const char* aptr(const Unit& u) const { return A + (size_t)u.pm * tA; }
    __device__ __forceinline__ const char* bptr(const Unit& u) const { return B + (size_t)u.pn * tB; }
};
struct SplitOrder {
    int pm, pn, part; bool have; const char* A; const char* B;
    __device__ __forceinline__ bool next(int i, Unit& u) const { if (i > 0 || !have) return false; u.pm = pm; u.pn = pn; u.sub = part; return true; }
    __device__ __forceinline__ const char* aptr(const Unit&) const { return A; }
    __device__ __forceinline__ const char* bptr(const Unit&) const { return B; }
};
struct ChainOrder : RectOrder {
    int nsub, map; size_t sA, sB;
    __device__ __forceinline__ bool next(int i, Unit& u) const { const int su = i / nsub; const long L = (long)su * G + c; if (L >= nwg) return false; tile_of((int)L, u); u.sub = i - su * nsub; return true; }
    __device__ __forceinline__ const char* aptr(const Unit& u) const { return A + (size_t)u.pm * tA + (size_t)((map >> (4 * u.sub)) & 15) * sA; }
    __device__ __forceinline__ const char* bptr(const Unit& u) const { return B + (size_t)u.pn * tB + (size_t)((map >> (4 * u.sub)) & 15) * sB; }
};

template <class Epi, class Sched, bool ALIGN_EPI, bool HALFN = false>
__device__ __forceinline__ void gemm_phase(LAS unsigned char* lds, const int K, const int lda, const int ldb, const Sched& S, const Epi& E) {
    const int tid = fresh_tid(), wid = __builtin_amdgcn_readfirstlane(tid >> 6), lane = tid & 63, wr = wid >> 2, wc = wid & 3, fr = lane & 15, fq = lane >> 4;
    const int nt = K / BK;
    unsigned voffA[2], voffB[2];
#pragma unroll
    for (int i = 0; i < 2; ++i) { int R, C; stage_rc(tid * 16 + i * 8192, R, C); const int Rb = Epi::PERM ? ((R & ~31) + perm32(R & 31)) : R;
        voffA[i] = (unsigned)(R * lda + C) * 2u; voffB[i] = (unsigned)(Rb * ldb + C) * 2u; }
    const size_t kstep = (size_t)(BK * 2);
    const size_t hstepA = (size_t)HALF * lda * 2, hstepB = (size_t)HALF * ldb * 2;
    const unsigned ldsw = (unsigned)wid * 1024u;
    const int aoff = lds_byte(wr * 64 + fr, fq * 8), boff = lds_byte(wc * 32 + fr, fq * 8);
#define PG8_SA(b, h) (((b) * 2 + (h)) * HTB)
#define PG8_SB(b, h) ((4 + (b) * 2 + (h)) * HTB)
#define PG8_STAGE(bufoff, gbase, voff) do { _Pragma("unroll") for (int _i = 0; _i < 2; ++_i) \
        __builtin_amdgcn_global_load_lds((const unsigned*)((const char*)(gbase) + (voff)[_i]), (LAS unsigned*)(lds + (bufoff) + ldsw + _i * 8192), 16, 0, 0); } while (0)
#define PG8_LDA(dst, b, h) do { _Pragma("unroll") for (int m = 0; m < 4; ++m) _Pragma("unroll") for (int k = 0; k < 2; ++k) dst[m][k] = *(const LAS bf16x8*)(lds + PG8_SA(b, h) + aoff + m * 2048 + k * 1024); } while (0)
#define PG8_LDB(dst, b, h) do { _Pragma("unroll") for (int n = 0; n < 2; ++n) _Pragma("unroll") for (int k = 0; k < 2; ++k) dst[n][k] = *(const LAS bf16x8*)(lds + PG8_SB(b, h) + boff + n * 2048 + k * 1024); } while (0)
#define PG8_MMA(ai, bj, At, Bt) do { __builtin_amdgcn_s_setprio(1); _Pragma("unroll") for (int m = 0; m < 4; ++m) _Pragma("unroll") for (int n = 0; n < 2; ++n) _Pragma("unroll") for (int k = 0; k < 2; ++k) \
        acc[ai][bj][m][n] = __builtin_amdgcn_mfma_f32_16x16x32_bf16(Bt[n][k], At[m][k], acc[ai][bj][m][n], 0, 0, 0); __builtin_amdgcn_s_setprio(0); } while (0)
#define PG8_WAIT_V(n) asm volatile("s_waitcnt vmcnt(" #n ")" ::: "memory")
#define PG8_WAIT_L(n) asm volatile("s_waitcnt lgkmcnt(" #n ")" ::: "memory")
#define PG8_WAIT_VH do { if constexpr (HALFN) PG8_WAIT_V(6); else PG8_WAIT_V(8); } while (0)
#define PG8_BAR __builtin_amdgcn_s_barrier()
#define PG8_SCHED __builtin_amdgcn_sched_barrier(0)
    Unit cur, nxt; int ui = 0;
    if (!S.next(0, cur)) return;
    f32x4 acc[2][2][4][2];
#pragma unroll
    for (int a = 0; a < 2; ++a)
#pragma unroll
        for (int b = 0; b < 2; ++b)
#pragma unroll
            for (int m = 0; m < 4; ++m)
#pragma unroll
                for (int n = 0; n < 2; ++n) acc[a][b][m][n] = (f32x4){0.f, 0.f, 0.f, 0.f};
    bf16x8 At[4][2], B0[2][2], B1[2][2];
    const char* cA = S.aptr(cur); const char* cB = S.bptr(cur);
    PG8_STAGE(PG8_SB(0, 0), cB, voffB); if constexpr (!HALFN) PG8_STAGE(PG8_SB(0, 1), cB + hstepB, voffB); PG8_STAGE(PG8_SA(0, 0), cA, voffA); PG8_STAGE(PG8_SA(0, 1), cA + hstepA, voffA);
    if (wr == 1) PG8_BAR;
    PG8_WAIT_V(2); PG8_BAR;
    PG8_STAGE(PG8_SB(1, 0), cB + kstep, voffB); PG8_STAGE(PG8_SA(1, 0), cA + kstep, voffA); if constexpr (!HALFN) PG8_STAGE(PG8_SB(1, 1), cB + hstepB + kstep, voffB);
    if constexpr (HALFN) PG8_WAIT_V(4); else PG8_WAIT_V(6);
    PG8_BAR;
    for (;;) {
        const bool has_next = S.next(ui + 1, nxt);
        const char* nA = has_next ? S.aptr(nxt) : cA; const char* nB = has_next ? S.bptr(nxt) : cB;
#pragma unroll 1
        for (int t = 0; t < nt; t += 2) {
            const bool last = (t == nt - 2);
            const char* a1 = cA + (size_t)(t + 1) * kstep;
            const char* a2 = last ? nA : cA + (size_t)(t + 2) * kstep; const char* b2 = last ? nB : cB + (size_t)(t + 2) * kstep;
            const char* a3 = a2 + kstep; const char* b3 = b2 + kstep;
            PG8_LDB(B0, 0, 0); if constexpr (!HALFN) PG8_LDB(B1, 0, 1); PG8_SCHED; PG8_LDA(At, 0, 0); PG8_STAGE(PG8_SA(1, 1), a1 + hstepA, voffA);
            PG8_WAIT_VH; PG8_WAIT_L(0); PG8_BAR; PG8_MMA(0, 0, At, B0); if constexpr (!HALFN) PG8_MMA(0, 1, At, B1); PG8_BAR; PG8_SCHED;
            PG8_LDA(At, 0, 1); PG8_STAGE(PG8_SB(0, 0), b2, voffB); if constexpr (!HALFN) PG8_STAGE(PG8_SB(0, 1), b2 + hstepB, voffB); PG8_STAGE(PG8_SA(0, 0), a2, voffA);
            PG8_WAIT_VH; PG8_WAIT_L(0); PG8_BAR; PG8_MMA(1, 0, At, B0); if constexpr (!HALFN) PG8_MMA(1, 1, At, B1); PG8_BAR; PG8_SCHED;
            PG8_LDB(B0, 1, 0); if constexpr (!HALFN) PG8_LDB(B1, 1, 1); PG8_SCHED; PG8_LDA(At, 1, 0); PG8_STAGE(PG8_SA(0, 1), a2 + hstepA, voffA);
            PG8_WAIT_VH; PG8_WAIT_L(0); PG8_BAR; PG8_MMA(0, 0, At, B0); if constexpr (!HALFN) PG8_MMA(0, 1, At, B1); PG8_BAR; PG8_SCHED;
            PG8_LDA(At, 1, 1); PG8_STAGE(PG8_SB(1, 0), b3, voffB); if constexpr (!HALFN) PG8_STAGE(PG8_SB(1, 1), b3 + hstepB, voffB); PG8_STAGE(PG8_SA(1, 0), a3, voffA);
            PG8_WAIT_VH; PG8_WAIT_L(0); PG8_BAR; PG8_MMA(1, 0, At, B0); if constexpr (!HALFN) PG8_MMA(1, 1, At, B1); PG8_BAR; PG8_SCHED;
        }
        if constexpr (ALIGN_EPI) { if (wr == 0) PG8_BAR; }
        const bool keep = E(acc, cur, wr, wc, fr, fq);
        if (!has_next) break;
        if (!keep) {
#pragma unroll
        for (int a = 0; a < 2; ++a)
#pragma unroll
            for (int b = 0; b < 2; ++b)
#pragma unroll
                for (int m = 0; m < 4; ++m)
#pragma unroll
                    for (int n = 0; n < 2; ++n) acc[a][b][m][n] = (f32x4){0.f, 0.f, 0.f, 0.f};
        }
        cur = nxt; cA = nA; cB = nB; ++ui;
        if constexpr (ALIGN_EPI) { if (wr == 1) PG8_BAR; }
    }
    PG8_WAIT_V(0);
    if constexpr (!ALIGN_EPI) { if (wr == 0) PG8_BAR; }
    PG8_BAR;
#undef PG8_SA
#undef PG8_SB
#undef PG8_STAGE
#undef PG8_LDA
#undef PG8_LDB
#undef PG8_MMA
#undef PG8_WAIT_V
#undef PG8_WAIT_L
#undef PG8_WAIT_VH
#undef PG8_BAR
#undef PG8_SCHED
}
}

constexpr size_t MiB = 1u << 20;
constexpr size_t WS_CTL = 0, CTL_ZERO_BYTES = 1 * MiB;
constexpr size_t WS_MOD = 1 * MiB;
constexpr size_t WS_TAB = 2 * MiB;
constexpr size_t WS_SSP = 2 * MiB + 65536;
constexpr size_t WS_XC = 3 * MiB;
constexpr size_t WS_H = 11 * MiB;
constexpr size_t WS_Y = 79 * MiB;
constexpr size_t WS_HB = 147 * MiB;
constexpr size_t WS_YBR = 164 * MiB;
constexpr size_t WS_QM = 232 * MiB;
constexpr size_t WS_KN = 258 * MiB;
constexpr size_t WS_VTM = 275 * MiB;
constexpr size_t WS_Z = 292 * MiB;
constexpr size_t WS_W = 692 * MiB;
constexpr size_t WL_GU = 0, WL_D = 86 * MiB, WL_IN = 129 * MiB, WL_UQ = 176 * MiB, WL_KV = 177 * MiB, WL_BR = 178 * MiB, WL_OUT = 186 * MiB, WL_GMW = 194 * MiB, WL_BZ = 194 * MiB + 262144, WL_SIZE = 195 * MiB;
constexpr size_t WS_VTD = WS_W + DEPTH * WL_SIZE;
constexpr size_t WS_XB = WS_VTD + 9 * MiB;
constexpr size_t WS_END = WS_XB + 68 * MiB;
static_assert(WS_SSP + (size_t)MT * 12 * 4 <= WS_XC && WS_XC + (size_t)MC * D * 4 <= WS_H && WS_H + (size_t)MT * D * 2 <= WS_Y && WS_Y + (size_t)MT * D * 2 <= WS_HB, "ws map 1");
static_assert(WS_HB + (size_t)MT * 512 * 2 <= WS_YBR && WS_YBR + (size_t)4 * MT * 512 * 2 <= WS_QM && WS_QM + (size_t)MT * 768 * 2 <= WS_KN && WS_KN + (size_t)MT * 512 * 2 <= WS_VTM && WS_VTM + (size_t)512 * MT * 2 <= WS_Z && WS_Z + (size_t)MT * NZ * 2 <= WS_W, "ws map 2");
static_assert((size_t)2 * NGU * D * 2 <= WL_D && WL_D + (size_t)2 * D * DFF * 2 <= WL_IN && WL_IN + (size_t)NZW * D * 2 <= WL_UQ && WL_UQ + 768 * 512 * 2 <= WL_KV && WL_KV + 1024 * 256 * 2 <= WL_BR && WL_BR + (size_t)4 * D * 512 * 2 <= WL_OUT && WL_OUT + (size_t)D * D * 2 <= WL_GMW && WL_GMW + 4 * 128 * 128 * 2 <= WL_BZ && WL_BZ + NZW * 4 <= WL_SIZE, "weight map");
static_assert((size_t)DEPTH * 5 * NMOD * 4 <= 1 * MiB, "mod");
constexpr int CW_BAR = 4096;

constexpr int RING_BYTES = 131072, MISC_OFF = RING_BYTES + 320, LTAB_OFF = RING_BYTES + 2048  , LDS_BYTES = 147456;

#define XB_TMO      128
#define XB_XCNT(j)  (256  + 64 * (j))
#define XB_XSUB(j)  (1280 + 64 * (j))
#define XB_XGEN(j)  (2304 + 64 * (j))
#define XB_TOP      3328
#define XB_TOPGEN   3392
#define XCD_BAR_WORDS 3456
#define XB_SPIN_CAP (1u << 20)
__device__ __forceinline__ unsigned xb_ld(unsigned* p)              { return __hip_atomic_load(p, __ATOMIC_RELAXED, __HIP_MEMORY_SCOPE_AGENT); }
__device__ __forceinline__ unsigned xb_add(unsigned* p, unsigned v) { return __hip_atomic_fetch_add(p, v, __ATOMIC_RELAXED, __HIP_MEMORY_SCOPE_AGENT); }
__device__ __forceinline__ unsigned xb_xcc_id() { return (unsigned)__builtin_amdgcn_s_getreg((3 << 11) | 20) & 0xFu; }
#define XB_SPIN(cond, bar) do { unsigned _sp = 0; while (cond) { __builtin_amdgcn_s_sleep(1); \
    if ((++_sp & 255u) == 0u) { if (xb_ld(&(bar)[XB_TMO])) break; if (_sp > XB_SPIN_CAP) { atomicAdd(&(bar)[XB_TMO], 1u); break; } } } } while (0)
struct XcdBarrier { unsigned* bar; unsigned x; volatile LAS unsigned* st; };
__device__ __forceinline__ XcdBarrier xcd_barrier_post(unsigned* bar, volatile LAS unsigned* st) {
    XcdBarrier b; b.bar = bar; b.x = xb_xcc_id(); b.st = st;
    if (threadIdx.x == 0) (void)xb_add(&bar[XB_XCNT(b.x)], 1u);
    return b;
}
__device__ __forceinline__ void xcd_barrier_complete(unsigned* bar, unsigned x, unsigned& nloc, unsigned& nx) {
    const unsigned G = gridDim.x * gridDim.y * gridDim.z;
    unsigned sum, cnt, mine, sp = 0u;
    for (;;) {
        sum = 0u; cnt = 0u; mine = 0u;
#pragma unroll
        for (unsigned j = 0; j < 16; ++j) { const unsigned c = xb_ld(&bar[XB_XCNT(j)]); sum += c; cnt += (c > 0u) ? 1u : 0u; mine = (j == x) ? c : mine; }
        if (sum == G) break;
        __builtin_amdgcn_s_sleep(1);
        if ((++sp & 255u) == 0u) { if (xb_ld(&bar[XB_TMO])) break; if (sp > XB_SPIN_CAP) { atomicAdd(&bar[XB_TMO], 1u); break; } }
    }
    nloc = mine > 0u ? mine : 1u; nx = cnt > 0u ? cnt : 1u;
}
__device__ __forceinline__ void xcd_barrier(const XcdBarrier& b) {
    asm volatile("s_waitcnt vmcnt(0)" ::: "memory");
    __syncthreads();
    if (threadIdx.x == 0) {
        unsigned* bar = b.bar;
        __builtin_amdgcn_s_waitcnt(0);
        unsigned nloc = b.st[0], nx = b.st[1];
        if (nloc == 0u) { xcd_barrier_complete(bar, b.x, nloc, nx); b.st[0] = nloc; b.st[1] = nx; }
        const unsigned old = xb_add(&bar[XB_XSUB(b.x)], 1u);
        const unsigned gen = old / nloc;
        if (old + 1u == (gen + 1u) * nloc) {
            __builtin_amdgcn_fence(__ATOMIC_RELEASE, "agent");
            asm volatile("s_waitcnt vmcnt(0)" ::: "memory");
            const unsigned og = xb_add(&bar[XB_TOP], 1u);
            const unsigned tg = og / nx;
            if (og + 1u == (tg + 1u) * nx) xb_add(&bar[XB_TOPGEN], 1u);
            else XB_SPIN(xb_ld(&bar[XB_TOPGEN]) == tg, bar);
            __builtin_amdgcn_fence(__ATOMIC_ACQUIRE, "agent");
            xb_add(&bar[XB_XGEN(b.x)], 1u);
            asm volatile("s_waitcnt vmcnt(0)" ::: "memory");
        } else {
            XB_SPIN(xb_ld(&bar[XB_XGEN(b.x)]) == gen, bar);
            __builtin_amdgcn_fence(__ATOMIC_ACQUIRE, "agent");
            asm volatile("s_waitcnt vmcnt(0)" ::: "memory");
        }
    }
    __syncthreads();
}

constexpr int RING_BYTES_C = 131072;
struct Params { const float* in[28]; float* out; unsigned char* ws; int ph_lo, ph_hi; };
enum { I_X = 0, I_C, I_CTX, I_CCTX, I_WMOD, I_BMOD, I_NPRE, I_NPOST, I_WG, I_WU, I_WD, I_WIN, I_BIN, I_GMLNG, I_GMLNB, I_GMWS, I_GMBS, I_CVDW, I_CVDB, I_CVLNG, I_CVLNB, I_QNORM, I_KVNORM, I_WUQ, I_WUKV, I_SINK, I_WBR, I_WOUT };

constexpr int PTAB_OFF = RING_BYTES_C + 1024;
struct Ctx { volatile LAS unsigned* tab;
    __device__ __forceinline__ unsigned long long get(int i) const { const unsigned lo = __builtin_amdgcn_readfirstlane(tab[2 * i]), hi = __builtin_amdgcn_readfirstlane(tab[2 * i + 1]); return ((unsigned long long)hi << 32) | lo; }
    __device__ __forceinline__ const float* in(int i) const { return (const float*)(const GAS float*)get(i); }
    __device__ __forceinline__ float* out() const { return (float*)(GAS float*)get(28); }
    __device__ __forceinline__ unsigned char* ws() const { return (unsigned char*)(GAS unsigned char*)get(29); }
};
#define WSP(T, off) ((T*)(ws + (off)))
#define WLP(T, l, off) ((T*)(ws + WS_W + (size_t)(l) * WL_SIZE + (off)))

namespace pg8 {
struct EpiSwiglu { static constexpr bool PERM = true; bf16_t* O;
    __device__ __forceinline__ bool operator()(f32x4 (&acc)[2][2][4][2], const Unit& u, int wr, int wc, int fr, int fq) const {
        const int row0 = u.pm * BM + wr * 64 + fr, col0 = u.pn * HALF + wc * 32 + 8 * fq;
#pragma unroll
        for (int ai = 0; ai < 2; ++ai)
#pragma unroll
            for (int m = 0; m < 4; ++m) { bf16_t* rowp = O + (size_t)(row0 + ai * HALF + m * 16) * DFF + col0; float v[8];
#pragma unroll
                for (int n = 0; n < 2; ++n)
#pragma unroll
                    for (int i = 0; i < 4; ++i) { const float g = acc[ai][0][m][n][i], up = acc[ai][1][m][n][i]; v[4 * n + i] = g * sigmoidf_(g) * up; }
                u32x4 w; w.x = cvt_pk_bf16(v[0], v[1]); w.y = cvt_pk_bf16(v[2], v[3]); w.z = cvt_pk_bf16(v[4], v[5]); w.w = cvt_pk_bf16(v[6], v[7]);
                *(u32x4*)rowp = w; }
        return false;
    }
};
template <bool RS> struct EpiPlain { static constexpr bool PERM = true; bf16_t* O; int ldc; const float* ssp;
    __device__ __forceinline__ bool operator()(f32x4 (&acc)[2][2][4][2], const Unit& u, int wr, int wc, int fr, int fq) const {
        const int row0 = u.pm * BM + wr * 64 + fr, col0 = u.pn * BM + wc * 32 + 8 * fq;
        f32x4 pr[2][4];
        if (RS) {
#pragma unroll
            for (int ai = 0; ai < 2; ++ai)
#pragma unroll
                for (int m = 0; m < 4; ++m) pr[ai][m] = *(const f32x4*)(ssp + (size_t)(row0 + ai * HALF + m * 16) * 12 + 8);
            __builtin_amdgcn_sched_barrier(0);
        }
#pragma unroll
        for (int ai = 0; ai < 2; ++ai)
#pragma unroll
            for (int m = 0; m < 4; ++m) { const int row = row0 + ai * HALF + m * 16; bf16_t* rowp = O + (size_t)row * ldc + col0; float sc = 1.f;
                if (RS) { const f32x4 p = pr[ai][m]; sc = __builtin_amdgcn_rsqf(((p[0] + p[1]) + (p[2] + p[3])) * (1.f / 256.f) + EPS); }
#pragma unroll
                for (int bj = 0; bj < 2; ++bj) { const f32x4 v0 = acc[ai][bj][m][0] * sc, v1 = acc[ai][bj][m][1] * sc;
                    u32x4 w; w.x = cvt_pk_bf16(v0[0], v0[1]); w.y = cvt_pk_bf16(v0[2], v0[3]); w.z = cvt_pk_bf16(v1[0], v1[1]); w.w = cvt_pk_bf16(v1[2], v1[3]);
                    *(u32x4*)(rowp + bj * HALF) = w; } }
        return false;
    }
};
struct EpiPartial { static constexpr bool PERM = false; float* P; int row_base; size_t pstride;
    __device__ __forceinline__ bool operator()(f32x4 (&acc)[2][2][4][2], const Unit& u, int wr, int wc, int fr, int fq) const {
        const int row0 = u.pm * BM - row_base + wr * 64 + fr, col0 = u.pn * BM + wc * 32 + 4 * fq; float* base = P + (size_t)u.sub * pstride;
#pragma unroll
        for (int ai = 0; ai < 2; ++ai)
#pragma unroll
            for (int m = 0; m < 4; ++m) { float* rowp = base + (size_t)(row0 + ai * HALF + m * 16) * D + col0;
#pragma unroll
                for (int bj = 0; bj < 2; ++bj)
#pragma unroll
                    for (int n = 0; n < 2; ++n) *(f32x4*)(rowp + bj * HALF + n * 16) = acc[ai][bj][m][n]; }
        return false;
    }
};
__device__ __forceinline__ void rope4(f32x4& v0, f32x4& v1, const LAS float* tab) {
    const f32x4 t0 = *(const LAS f32x4*)tab, t1 = *(const LAS f32x4*)(tab + 4);
    const float c[4] = {t0[0], t0[2], t1[0], t1[2]}, s[4] = {t0[1], t0[3], t1[1], t1[3]};
#pragma unroll
    for (int i = 0; i < 4; ++i) { const float a = v0[i], b = v1[i]; v0[i] = a * c[i] - b * s[i]; v1[i] = b * c[i] + a * s[i]; }
}
struct EpiQ { static constexpr bool PERM = true; bf16_t* O; const float* ssp; const LAS float* tab;
    __device__ __forceinline__ bool operator()(f32x4 (&acc)[2][2][4][2], const Unit& u, int wr, int wc, int fr, int fq) const {
        const int row0 = u.pm * BM + wr * 64 + fr, col0 = u.pn * BM + wc * 32 + 8 * fq;
        const float qs = 0.07216878364870322f * LOG2E;
#pragma unroll
        for (int ai = 0; ai < 2; ++ai) {
        f32x4 pr0[4], pr1[4];
#pragma unroll
        for (int m = 0; m < 4; ++m) { const size_t ro = (size_t)(row0 + ai * HALF + m * 16) * 12; pr0[m] = *(const f32x4*)(ssp + ro); pr1[m] = *(const f32x4*)(ssp + ro + 4); }
        __builtin_amdgcn_sched_barrier(0);
#pragma unroll
            for (int m = 0; m < 4; ++m) { const int row = row0 + ai * HALF + m * 16; bf16_t* rowp = O + (size_t)row * 768 + col0;
                const f32x4 p0 = pr0[m], p1 = pr1[m];
                const float sc = __builtin_amdgcn_rsqf((((p0[0] + p0[1]) + (p0[2] + p0[3])) + ((p1[0] + p1[1]) + (p1[2] + p1[3]))) * (1.f / 512.f) + EPS) * qs;
                const int t = row & (SEQ - 1); const bool lat = row < ML;
#pragma unroll
                for (int bj = 0; bj < 2; ++bj) { const int grp = (u.pn * 8 + bj * 4 + wc) % 6;
                    f32x4 v0 = acc[ai][bj][m][0] * sc, v1 = acc[ai][bj][m][1] * sc;
                    if (grp >= 4 && lat) { const int pos = (grp == 4) ? (t >> 6) : (t & 63); rope4(v0, v1, tab + (pos * 16 + 4 * fq) * 2); }
                    u32x4 w; w.x = cvt_pk_bf16(v0[0], v0[1]); w.y = cvt_pk_bf16(v0[2], v0[3]); w.z = cvt_pk_bf16(v1[0], v1[1]); w.w = cvt_pk_bf16(v1[2], v1[3]);
                    *(u32x4*)(rowp + bj * HALF) = w; } }
        __builtin_amdgcn_sched_barrier(0); }
        return false;
    }
};
struct EpiZ { static constexpr bool PERM = true; bf16_t* Z; bf16_t* HB; float* ssp; const float* bias; const LAS float* tab; int pn_off, row_base;
    __device__ __forceinline__ bool operator()(f32x4 (&acc)[2][2][4][2], const Unit& u, int wr, int wc, int fr, int fq) const {
        const int pn = u.pn + pn_off;
        const int row0 = row_base + u.pm * BM + wr * 64 + fr, col0 = pn * BM + wc * 32 + 8 * fq;
        f32x4 bv[2][2];
#pragma unroll
        for (int bj = 0; bj < 2; ++bj)
#pragma unroll
            for (int n = 0; n < 2; ++n) bv[bj][n] = *(const f32x4*)(bias + col0 + bj * HALF + 4 * n);
        if (pn >= 4 && pn < 8) {
#pragma unroll
            for (int ai = 0; ai < 2; ++ai)
#pragma unroll
                for (int m = 0; m < 4; ++m) { bf16_t* rowp = HB + (size_t)(row0 + ai * HALF + m * 16) * 512 + (pn - 4) * HALF + wc * 32 + 8 * fq; float h[8];
#pragma unroll
                    for (int n = 0; n < 2; ++n) { const f32x4 a = acc[ai][0][m][n] + bv[0][n], gt = acc[ai][1][m][n] + bv[1][n];
#pragma unroll
                        for (int i = 0; i < 4; ++i) h[4 * n + i] = a[i] * sigmoidf_(gt[i]); }
                    u32x4 w; w.x = cvt_pk_bf16(h[0], h[1]); w.y = cvt_pk_bf16(h[2], h[3]); w.z = cvt_pk_bf16(h[4], h[5]); w.w = cvt_pk_bf16(h[6], h[7]); *(u32x4*)rowp = w; }
        } else {
#pragma unroll
        for (int ai = 0; ai < 2; ++ai)
#pragma unroll
            for (int m = 0; m < 4; ++m) { const int row = row0 + ai * HALF + m * 16; bf16_t* rowp = Z + (size_t)row * NZ + col0; float ss = 0.f;
                const int t = row & (SEQ - 1); const bool lat = row < ML;
#pragma unroll
                for (int bj = 0; bj < 2; ++bj) { f32x4 v0 = acc[ai][bj][m][0] + bv[bj][0], v1 = acc[ai][bj][m][1] + bv[bj][1];
                    if (pn < 4) {
#pragma unroll
                        for (int i = 0; i < 4; ++i) { v0[i] = gelu1(v0[i]); v1[i] = gelu1(v1[i]); }
                    } else if (pn < 11) {
#pragma unroll
                        for (int i = 0; i < 4; ++i) ss += v0[i] * v0[i] + v1[i] * v1[i];
                    } else if (pn < 14) { const int grp = pn * 8 + bj * 4 + wc;
                        if (grp >= 88 && grp < 110 && lat) { const int pos = (grp & 1) ? (t & 63) : (t >> 6); rope4(v0, v1, tab + (pos * 16 + 4 * fq) * 2); }
                        if (grp >= 90 && grp < 106) { v0 = v0 * (0.125f * LOG2E); v1 = v1 * (0.125f * LOG2E); }
                    } else {
#pragma unroll
                        for (int i = 0; i < 4; ++i) { v0[i] = sigmoidf_(v0[i]); v1[i] = sigmoidf_(v1[i]); }
                    }
                    u32x4 w; w.x = cvt_pk_bf16(v0[0], v0[1]); w.y = cvt_pk_bf16(v0[2], v0[3]); w.z = cvt_pk_bf16(v1[0], v1[1]); w.w = cvt_pk_bf16(v1[2], v1[3]);
                    *(u32x4*)(rowp + bj * HALF) = w; }
                if (pn >= 8 && pn < 11) { ss += __shfl_xor(ss, 16); ss += __shfl_xor(ss, 32); ssp[(size_t)row * 12 + (pn - 8) * 4 + wc] = ss; } }
        }
        asm volatile("" :: "v"(bv[0][0]), "v"(bv[0][1]), "v"(bv[1][0]), "v"(bv[1][1]));
        return false;
    }
};
template <bool COLSCALE> struct EpiVt { static constexpr bool PERM = true; bf16_t* O; int ldc; const float* rbias; const float* ssp;
    __device__ __forceinline__ bool operator()(f32x4 (&acc)[2][2][4][2], const Unit& u, int wr, int wc, int fr, int fq) const {
        const int row0 = u.pm * BM + wr * 64 + fr, col0 = u.pn * BM + wc * 32 + 8 * fq;
        float sc[2][8];
        if (COLSCALE) {
#pragma unroll
            for (int bj = 0; bj < 2; ++bj) { f32x4 pc[8];
#pragma unroll
                for (int e = 0; e < 8; ++e) pc[e] = *(const f32x4*)(ssp + (size_t)(col0 + bj * HALF + e) * 12 + 8);
                __builtin_amdgcn_sched_barrier(0);
#pragma unroll
                for (int e = 0; e < 8; ++e) { const f32x4 p = pc[e]; sc[bj][e] = __builtin_amdgcn_rsqf(((p[0] + p[1]) + (p[2] + p[3])) * (1.f / 256.f) + EPS); }
                __builtin_amdgcn_sched_barrier(0); }
        } else {
#pragma unroll
            for (int bj = 0; bj < 2; ++bj)
#pragma unroll
                for (int e = 0; e < 8; ++e) sc[bj][e] = 1.f;
        }
        float rbv[2][4];
#pragma unroll
        for (int ai = 0; ai < 2; ++ai)
#pragma unroll
            for (int m = 0; m < 4; ++m) rbv[ai][m] = COLSCALE ? 0.f : rbias[row0 + ai * HALF + m * 16];
        __builtin_amdgcn_sched_barrier(0);
#pragma unroll
        for (int ai = 0; ai < 2; ++ai)
#pragma unroll
            for (int m = 0; m < 4; ++m) { const int row = row0 + ai * HALF + m * 16; bf16_t* rowp = O + (size_t)row * ldc + col0; const float rb = rbv[ai][m];
#pragma unroll
                for (int bj = 0; bj < 2; ++bj) { const f32x4 a0 = acc[ai][bj][m][0] + rb, a1 = acc[ai][bj][m][1] + rb;
                    u32x4 w; w.x = cvt_pk_bf16(a0[0] * sc[bj][0], a0[1] * sc[bj][1]); w.y = cvt_pk_bf16(a0[2] * sc[bj][2], a0[3] * sc[bj][3]); w.z = cvt_pk_bf16(a1[0] * sc[bj][4], a1[1] * sc[bj][5]); w.w = cvt_pk_bf16(a1[2] * sc[bj][6], a1[3] * sc[bj][7]);
                    *(u32x4*)(rowp + bj * HALF) = w; } }
        return false;
    }
};
struct EpiM1 { static constexpr bool PERM = true; const bf16_t* Z; bf16_t* T; int nlast, map;
    __device__ __forceinline__ void loadb(const bf16_t* sp, const bf16_t* sp2, int b, u32x4 (&s)[2][2], u32x4 (&s2)[2][2]) const {
#pragma unroll
        for (int mm = 0; mm < 2; ++mm)
#pragma unroll
            for (int bj = 0; bj < 2; ++bj) { const size_t ro = (size_t)((b >> 1) * HALF + (2 * (b & 1) + mm) * 16) * NZ + bj * HALF; s[mm][bj] = *(const u32x4*)(sp + ro); s2[mm][bj] = *(const u32x4*)(sp2 + ro); }
    }
    __device__ __forceinline__ bool operator()(f32x4 (&acc)[2][2][4][2], const Unit& u, int wr, int wc, int fr, int fq) const {
        const int row0 = u.pm * BM + wr * 64 + fr, col0 = u.pn * BM + wc * 32 + 8 * fq; const int sub = u.sub;
        const int br = (map >> (4 * sub)) & 15, br2 = (map >> (4 * sub + 4)) & 15; const bool mid = sub < nlast;
        const bf16_t* sp = Z + (size_t)row0 * NZ + ZC_G + br * D + col0; const bf16_t* sp2 = Z + (size_t)row0 * NZ + ZC_G + (mid ? br2 : br) * D + col0;
        u32x4 sA[2][2], s2A[2][2], sB[2][2], s2B[2][2];
        loadb(sp, sp2, 0, sA, s2A);
#pragma unroll
        for (int b = 0; b < 4; ++b) {
            if (b + 1 < 4) { if (b & 1) loadb(sp, sp2, b + 1, sA, s2A); else loadb(sp, sp2, b + 1, sB, s2B); }
            __builtin_amdgcn_sched_barrier(0);
            const int ai = b >> 1, mp = b & 1;
#pragma unroll
            for (int mm = 0; mm < 2; ++mm)
#pragma unroll
                for (int bj = 0; bj < 2; ++bj) { const int m = 2 * mp + mm; const u32x4 a = (b & 1) ? sB[mm][bj] : sA[mm][bj], c = (b & 1) ? s2B[mm][bj] : s2A[mm][bj];
                    float g[8] = {bflo(a.x), bfhi(a.x), bflo(a.y), bfhi(a.y), bflo(a.z), bfhi(a.z), bflo(a.w), bfhi(a.w)};
                    if (mid) { const float g2[8] = {bflo(c.x), bfhi(c.x), bflo(c.y), bfhi(c.y), bflo(c.z), bfhi(c.z), bflo(c.w), bfhi(c.w)};
#pragma unroll
                        for (int i = 0; i < 8; ++i) g[i] = g[i] * fast_rcp(__builtin_fmaxf(g2[i], 1e-30f));
#pragma unroll
                        for (int i = 0; i < 4; ++i) { acc[ai][bj][m][0][i] *= g[i]; acc[ai][bj][m][1][i] *= g[4 + i]; }
                    } else { f32x4 v0, v1; asm volatile("" :: "v"(c));
#pragma unroll
                        for (int i = 0; i < 4; ++i) { v0[i] = acc[ai][bj][m][0][i] * g[i]; v1[i] = acc[ai][bj][m][1][i] * g[4 + i]; }
                        u32x4 w; w.x = cvt_pk_bf16(v0[0], v0[1]); w.y = cvt_pk_bf16(v0[2], v0[3]); w.z = cvt_pk_bf16(v1[0], v1[1]); w.w = cvt_pk_bf16(v1[2], v1[3]);
                        *(u32x4*)(T + (size_t)(row0 + ai * HALF + m * 16) * D + col0 + bj * HALF) = w; } }
            __builtin_amdgcn_sched_barrier(0);
        }
        return mid;
    }
};
struct EpiM1H { static constexpr bool PERM = true; const bf16_t* Z; bf16_t* T; int nlast, map;
    __device__ __forceinline__ bool operator()(f32x4 (&acc)[2][2][4][2], const Unit& u, int wr, int wc, int fr, int fq) const {
        const int row0 = u.pm * BM + wr * 64 + fr, col0 = u.pn * HALF + wc * 32 + 8 * fq; const int sub = u.sub; const int br = (map >> (4 * sub)) & 15;
        const bf16_t* sp = Z + (size_t)row0 * NZ + ZC_G + br * D + col0;
        u32x4 s[2][4];
#pragma unroll
        for (int ai = 0; ai < 2; ++ai)
#pragma unroll
            for (int m = 0; m < 4; ++m) s[ai][m] = *(const u32x4*)(sp + (size_t)(ai * HALF + m * 16) * NZ);
        __builtin_amdgcn_sched_barrier(0);
#pragma unroll
        for (int ai = 0; ai < 2; ++ai)
#pragma unroll
            for (int m = 0; m < 4; ++m) { const u32x4 a = s[ai][m];
                const f32x4 g0 = (f32x4){bflo(a.x), bfhi(a.x), bflo(a.y), bfhi(a.y)}, g1 = (f32x4){bflo(a.z), bfhi(a.z), bflo(a.w), bfhi(a.w)};
                acc[ai][1][m][0] += g0 * acc[ai][0][m][0]; acc[ai][1][m][1] += g1 * acc[ai][0][m][1];
                acc[ai][0][m][0] = (f32x4){0.f, 0.f, 0.f, 0.f}; acc[ai][0][m][1] = (f32x4){0.f, 0.f, 0.f, 0.f};
                if (sub == nlast) { const f32x4 v0 = acc[ai][1][m][0], v1 = acc[ai][1][m][1];
                    u32x4 w; w.x = cvt_pk_bf16(v0[0], v0[1]); w.y = cvt_pk_bf16(v0[2], v0[3]); w.z = cvt_pk_bf16(v1[0], v1[1]); w.w = cvt_pk_bf16(v1[2], v1[3]);
                    *(u32x4*)(T + (size_t)(row0 + ai * HALF + m * 16) * D + col0) = w;
                    acc[ai][1][m][0] = (f32x4){0.f, 0.f, 0.f, 0.f}; acc[ai][1][m][1] = (f32x4){0.f, 0.f, 0.f, 0.f}; } }
        return true;
    }
};
}

#define LDS_WAIT() asm volatile("s_waitcnt lgkmcnt(0)" ::: "memory")
__device__ __forceinline__ void cvt_item(const float* W, int ldw, int srccol0, bf16_t* dst, int K, int k0, const float* kscale, LAS float* scr, int lane, bool perm) {
    const int sc8 = perm ? (((lane & 7) >> 1) + 4 * (lane & 1)) : (lane & 7);
    f32x4 v[8];
    float ksv[8];
#pragma unroll
    for (int i = 0; i < 8; ++i) ksv[i] = 1.f;
    if (kscale) {
#pragma unroll
        for (int i = 0; i < 8; ++i) ksv[i] = kscale[k0 + 8 * i + (lane >> 3)];
    }
    const int scc = srccol0 >= 0 ? srccol0 : 0; const float zf = srccol0 >= 0 ? 1.f : 0.f;
#pragma unroll
    for (int i = 0; i < 8; ++i) { const int kk = 8 * i + (lane >> 3);
        v[i] = __builtin_nontemporal_load((const f32x4*)(W + (size_t)(k0 + kk) * ldw + scc + sc8 * 4)); }
#pragma unroll
    for (int i = 0; i < 8; ++i) { const int kk = 8 * i + (lane >> 3); f32x4 x = v[i] * (zf * ksv[i]);
        LAS float* d = scr + kk * 33 + (lane & 7) * 4; d[0] = x[0]; d[1] = x[1]; d[2] = x[2]; d[3] = x[3]; }
    LDS_WAIT(); asm volatile("" ::: "memory");
    const int c = lane & 7;
#pragma unroll
    for (int j = 0; j < 4; ++j) { const int n = (lane >> 3) + 8 * j; const LAS float* s = scr + (8 * c) * 33 + n;
        u32x4 o; o.x = pk2(s[0 * 33], s[1 * 33]); o.y = pk2(s[2 * 33], s[3 * 33]); o.z = pk2(s[4 * 33], s[5 * 33]); o.w = pk2(s[6 * 33], s[7 * 33]);
        __builtin_nontemporal_store(o, (u32x4*)(dst + (size_t)n * K + k0 + 8 * c)); }
    LDS_WAIT(); asm volatile("" ::: "memory");
}
__device__ __forceinline__ int zsrc_col(int n) {
    if (n < 1024) return n;
    if (n < 2048) { const int t = (n - 1024) >> 8, j = (n - 1024) & 255; return j < 128 ? 1024 + 128 * t + j : 1536 + 128 * t + (j - 128); }
    if (n < 3520) return n;
    if (n < 3584) return -1;
    if (n < NZ) return n + 64;
    if (n < NZ + 128) return 3520 + (n - NZ);
    return -1;
}
constexpr int CV_GU = 2 * (NGU / 32) * (D / 64), CV_D = 2 * (D / 32) * (DFF / 64), CV_IN = (NZW / 32) * (D / 64), CV_UQ = (768 / 32) * (512 / 64), CV_KV = (1024 / 32) * (256 / 64),
              CV_BR = 4 * (D / 32) * (512 / 64), CV_OUT = (D / 32) * (D / 64), CV_LAYER = CV_GU + CV_D + CV_IN + CV_UQ + CV_KV + CV_BR + CV_OUT;
constexpr int CV_E0 = CV_GU / 2, CV_E1 = CV_E0 + CV_D / 2, CV_E2 = CV_E1 + CV_IN, CV_E3 = CV_E2 + CV_UQ, CV_E4 = CV_E3 + CV_KV, CV_E5 = CV_E4 + CV_BR, CV_E6 = CV_E5 + CV_OUT, CV_E7 = CV_E6 + CV_GU / 2, CV_E8 = CV_E7 + CV_D / 2;
static_assert(CV_E8 == CV_LAYER, "conversion item count");
constexpr int CW_QHEAD = 2048, CW_DONE = 2112;
__device__ __forceinline__ void cvt_item_idx(const Ctx& C, unsigned char* ws, int it, LAS float* scr, int lane) {
    const int l = it / CV_LAYER; int r = it - l * CV_LAYER;
    const float* W; int ldw, sc0, K, k0; bf16_t* dst; const float* ks = nullptr; bool perm = false;
    if (r < CV_E0 || (r >= CV_E6 && r < CV_E7)) { const int f = r >= CV_E6; if (f) r -= CV_E6; const int kb = r / (NGU / 32), nb = r - kb * (NGU / 32); const int n = nb * 32, tile = n >> 8, j = n & 255;
        W = (j < 128 ? C.in(I_WG) : C.in(I_WU)) + (size_t)(l * 2 + f) * D * DFF; ldw = DFF; sc0 = 128 * tile + (j & 127); dst = WLP(bf16_t, l, WL_GU) + ((size_t)f * NGU + n) * D; K = D; k0 = kb * 64; }
    else if (r < CV_E1 || r >= CV_E7) { const int f = r >= CV_E7; r -= f ? CV_E7 : CV_E0; const int kb = r / (D / 32), nb = r - kb * (D / 32);
        W = C.in(I_WD) + (size_t)(l * 2 + f) * DFF * D; ldw = D; sc0 = nb * 32; dst = WLP(bf16_t, l, WL_D) + ((size_t)f * D + nb * 32) * DFF; K = DFF; k0 = kb * 64; }
    else if (r < CV_E2) { r -= CV_E1; const int kb = r / (NZW / 32), nb = r - kb * (NZW / 32);
        W = C.in(I_WIN) + (size_t)l * D * NIN; ldw = NIN; sc0 = zsrc_col(nb * 32); perm = (nb >= ZC_KR / 32 && nb < 3520 / 32); dst = WLP(bf16_t, l, WL_IN) + (size_t)nb * 32 * D; K = D; k0 = kb * 64; }
    else if (r < CV_E3) { r -= CV_E2; const int kb = r / 24, nb = r - kb * 24;
        W = C.in(I_WUQ) + (size_t)l * 512 * 768; ldw = 768; sc0 = nb * 32; perm = (nb % 6) >= 4; dst = WLP(bf16_t, l, WL_UQ) + (size_t)nb * 32 * 512; K = 512; k0 = kb * 64; ks = C.in(I_QNORM) + l * 512; }
    else if (r < CV_E4) { r -= CV_E3; const int kb = r / 32, nb = r - kb * 32;
        W = C.in(I_WUKV) + (size_t)l * 256 * 1024; ldw = 1024; sc0 = (((nb * 32) & 511) >> 7) * 256 + ((nb * 32) >> 9) * 128 + ((nb * 32) & 127); dst = WLP(bf16_t, l, WL_KV) + (size_t)nb * 32 * 256; K = 256; k0 = kb * 64; ks = C.in(I_KVNORM) + l * 256; }
    else if (r < CV_E5) { r -= CV_E4; const int b = r / (CV_BR / 4); r -= b * (CV_BR / 4); const int kb = r / 64, nb = r - kb * 64;
        W = C.in(I_WBR) + (size_t)(l * 4 + b) * 512 * D; ldw = D; sc0 = nb * 32; dst = WLP(bf16_t, l, WL_BR) + ((size_t)b * D + nb * 32) * 512; K = 512; k0 = kb * 64; }
    else { r -= CV_E5; const int kb = r / 64, nb = r - kb * 64;
        W = C.in(I_WOUT) + (size_t)l * D * D; ldw = D; sc0 = nb * 32; dst = WLP(bf16_t, l, WL_OUT) + (size_t)nb * 32 * D; K = D; k0 = kb * 64; }
    cvt_item(W, ldw, sc0, dst, K, k0, ks, scr, lane, perm);
}
__device__ __forceinline__ void cvt_pull(const Ctx& C, LAS unsigned char* lds, int mand_end, int done_word  , int G) {
    const int tid = fresh_tid(), lane = tid & 63, wid = tid >> 6;
    volatile LAS unsigned* sh = (volatile LAS unsigned*)(lds + 8 * 8448);
    if (done_word && tid == 0) (void)__hip_atomic_fetch_add((unsigned*)(C.ws() + WS_CTL) + done_word, 1u, __ATOMIC_RELAXED, __HIP_MEMORY_SCOPE_AGENT);
    for (;;) {
        __syncthreads();
        if (tid == 0) { unsigned* const ctl = (unsigned*)(C.ws() + WS_CTL); const unsigned h = __hip_atomic_load(ctl + CW_QHEAD, __ATOMIC_RELAXED, __HIP_MEMORY_SCOPE_AGENT); bool go = false;
            if (h < (unsigned)(DEPTH * CV_LAYER)) { if (h < (unsigned)mand_end) go = true; else if (done_word && __hip_atomic_load(ctl + done_word, __ATOMIC_RELAXED, __HIP_MEMORY_SCOPE_AGENT) < (unsigned)G) go = true; }
            sh[0] = go ? __hip_atomic_fetch_add(ctl + CW_QHEAD, 16u, __ATOMIC_RELAXED, __HIP_MEMORY_SCOPE_AGENT) : 0xffffffffu; }
        __syncthreads();
        const unsigned base = sh[0];
        if (base == 0xffffffffu) break;
#pragma unroll 1
        for (int i = 0; i < 2; ++i) { const int it = (int)base + wid * 2 + i; if (it < DEPTH * CV_LAYER) cvt_item_idx(C, C.ws(), it, (LAS float*)(lds + wid * 8448), lane); }
    }
}
__device__ __forceinline__ void prologue_phase(const Ctx& C, LAS unsigned char* lds, int G, int bid) {
    unsigned char* const ws = C.ws();
    const int tid = fresh_tid(), lane = tid & 63, wid = tid >> 6;
    if (bid == 0) { float* tab = WSP(float, WS_TAB);
        for (int i = tid; i < 64 * 16; i += 512) { const int pos = i >> 4, f = i & 15; const float ang = (float)pos * exp2f(-(float)f * (13.287712379549449f / 16.f)); float s, c; sincosf(ang, &s, &c); tab[2 * i] = c; tab[2 * i + 1] = s; } }
    {
        LAS float* SC = (LAS float*)lds; LAS float* PART = (LAS float*)(lds + 40960);
        { const float* const cp = C.in(I_C); const float* const cc = C.in(I_CCTX); float xs[20];
#pragma unroll
          for (int j = 0; j < 20; ++j) { const int i = tid + 512 * j; xs[j] = j < 16 ? cp[i] : cc[i - 4 * D]; }
#pragma unroll
          for (int j = 0; j < 20; ++j) { const float x = xs[j]; SC[tid + 512 * j] = x / (1.f + expf(-x)); } }
        __syncthreads();
        const int kg = tid >> 3, ct = tid & 7;
        for (int it = bid; it < DEPTH * (NMOD / 32); it += G) { const int l = it / (NMOD / 32), ng = it - l * (NMOD / 32);
            const float* wp = C.in(I_WMOD) + ((size_t)l * D + kg * 32) * NMOD + ng * 32 + ct * 4;
            f32x4 a[5];
#pragma unroll
            for (int s = 0; s < 5; ++s) a[s] = (f32x4){0.f, 0.f, 0.f, 0.f};
#pragma unroll 4
            for (int kk = 0; kk < 32; ++kk) { const f32x4 w = __builtin_nontemporal_load((const f32x4*)(wp + (size_t)kk * NMOD));
#pragma unroll
                for (int s = 0; s < 5; ++s) a[s] += w * SC[s * D + kg * 32 + kk]; }
#pragma unroll
            for (int s = 0; s < 5; ++s) *(LAS f32x4*)(PART + (kg * 5 + s) * 32 + ct * 4) = a[s];
            __syncthreads();
            if (tid < 160) { const int s = tid >> 5, cc = tid & 31; float v = C.in(I_BMOD)[(size_t)l * NMOD + ng * 32 + cc];
                for (int k2 = 0; k2 < 64; ++k2) v += PART[(k2 * 5 + s) * 32 + cc];
                WSP(float, WS_MOD)[((size_t)l * 5 + s) * NMOD + ng * 32 + cc] = v; }
            __syncthreads();
        }
    }
    { const int gt = bid * 512 + tid, GT = G * 512;
        for (int i = gt; i < DEPTH * 65536; i += GT) { const int l = i >> 16; WLP(bf16_t, l, WL_GMW)[i & 65535] = (bf16_t)f2bf(C.in(I_GMWS)[i]); }
        for (int i = gt; i < DEPTH * NZW; i += GT) { const int l = i / NZW, n = i - l * NZW; int nn = n; if (n >= ZC_KR && n < 3520) { const int pp = n & 31; nn = (n & ~31) + 4 * (pp >> 3) + (pp & 3) + 16 * ((pp >> 2) & 1); }
            const int sc = zsrc_col(nn); WLP(float, l, WL_BZ)[n] = sc >= 0 ? C.in(I_BIN)[(size_t)l * NIN + sc] : 0.f; } }
    __syncthreads();
    cvt_pull(C, lds, CV_E0, 0, G);
}

struct NormArgs { const float* xin_lat; const float* xin_ctx; bf16_t* XB; float* outf; const bf16_t* Y; const float* part; bf16_t* H; bool store; };
#define NCOL(r, j) (col[j])
template <bool XF32> __device__ __forceinline__ void norm_row_load(const NormArgs& A, int r, const int (&col)[8], f32x4 (&x)[8], u32x2 (&xr)[8], u32x2 (&yr)[8]) {
    if (XF32) { const float* xi = r < ML ? A.xin_lat + (size_t)r * D : A.xin_ctx + (size_t)(r - ML) * D;
#pragma unroll
        for (int j = 0; j < 8; ++j) x[j] = __builtin_nontemporal_load((const f32x4*)(xi + NCOL(r, j)));
    } else {
#pragma unroll
        for (int j = 0; j < 8; ++j) xr[j] = __builtin_nontemporal_load((const u32x2*)(A.XB + (size_t)r * D + NCOL(r, j)));
    }
    if (A.Y && !(A.part && r >= ML)) {
#pragma unroll
        for (int j = 0; j < 8; ++j) yr[j] = __builtin_nontemporal_load((const u32x2*)(A.Y + (size_t)r * D + NCOL(r, j)));
    }
}
template <bool XF32> __device__ __forceinline__ void norm_row_compute(const NormArgs& A, const LAS float* V, int r, const int (&col)[8], const f32x4 (&xf)[8], const u32x2 (&xr)[8], u32x2 (&yr)[8]) {
    float rs = 0.f;
    if (A.Y) {
        if (A.part && r >= ML) {
#pragma unroll
            for (int j = 0; j < 8; ++j) { const float* pp = A.part + (size_t)(r - ML) * D + NCOL(r, j); f32x4 pq[8];
#pragma unroll
                for (int q = 0; q < 8; ++q) pq[q] = __builtin_nontemporal_load((const f32x4*)(pp + (size_t)q * MC * D));
                __builtin_amdgcn_sched_barrier(0);
                const f32x4 a = ((pq[0] + pq[1]) + (pq[2] + pq[3])) + ((pq[4] + pq[5]) + (pq[6] + pq[7]));
                yr[j].x = cvt_pk_bf16(a[0], a[1]); yr[j].y = cvt_pk_bf16(a[2], a[3]); }
        }
        float ss = 0.f;
#pragma unroll
        for (int j = 0; j < 8; ++j) { const float y0 = bflo(yr[j].x), y1 = bfhi(yr[j].x), y2 = bflo(yr[j].y), y3 = bfhi(yr[j].y); ss += (y0 * y0 + y1 * y1) + (y2 * y2 + y3 * y3); }
        rs = __builtin_amdgcn_rsqf(wave_sum(ss) * (1.f / D) + EPS);
    }
#define NORM_X(j) ((XF32 ? xf[j] : (f32x4){bflo(xr[j].x), bfhi(xr[j].x), bflo(xr[j].y), bfhi(xr[j].y)}) + (A.Y ? *(const LAS f32x4*)(V + NCOL(r, j)) * ((f32x4){bflo(yr[j].x), bfhi(yr[j].x), bflo(yr[j].y), bfhi(yr[j].y)} * rs) : (f32x4){0.f, 0.f, 0.f, 0.f}))
    float rx = 0.f;
    if (A.H) { float ss = 0.f;
#pragma unroll
        for (int j = 0; j < 8; ++j) { const f32x4 x = NORM_X(j); ss += (x[0] * x[0] + x[1] * x[1]) + (x[2] * x[2] + x[3] * x[3]); if (j & 1) __builtin_amdgcn_sched_barrier(0); }
        rx = __builtin_amdgcn_rsqf(wave_sum(ss) * (1.f / D) + EPS); }
#pragma unroll
    for (int j = 0; j < 8; ++j) { const f32x4 x = NORM_X(j);
        if (A.outf) __builtin_nontemporal_store(x, (f32x4*)(A.outf + (size_t)r * D + NCOL(r, j)));
        else if (A.store) { u32x2 w; w.x = cvt_pk_bf16(x[0], x[1]); w.y = cvt_pk_bf16(x[2], x[3]); __builtin_nontemporal_store(w, (u32x2*)(A.XB + (size_t)r * D + NCOL(r, j))); }
        if (A.H) { const f32x4 h = (x * rx) * *(const LAS f32x4*)(V + D + NCOL(r, j)) + *(const LAS f32x4*)(V + 2 * D + NCOL(r, j)); u32x2 w; w.x = cvt_pk_bf16(h[0], h[1]); w.y = cvt_pk_bf16(h[2], h[3]);
            *(u32x2*)(A.H + (size_t)r * D + NCOL(r, j)) = w; }
        if (j & 1) __builtin_amdgcn_sched_barrier(0); }
#undef NORM_X
}
template <bool XF32> __device__ __forceinline__ void norm_phase(LAS unsigned char* lds, int G, int bid, int rows, const float* xin_lat, const float* xin_ctx, bf16_t* XB, float* outf, bool store,
                                           const bf16_t* Y, const float* part  , const float* modg  , int kgate, float coef, const float* gpost,
                                           bf16_t* H, const float* modh  , int kshift, const float* gpre) {
    constexpr int NR = XF32 ? 2 : NORM_NR;
    const int tid = fresh_tid(), lane = tid & 63, wid = __builtin_amdgcn_readfirstlane(tid >> 6);
    asm volatile("" : "+s"(bid));
    float zf = 0.f; asm volatile("" : "+v"(zf));
    const NormArgs A{xin_lat, xin_ctx, XB, outf, Y, part, H, store};
    LAS float* V = (LAS float*)lds;
    int s_have = -1;
    for (int r0 = bid * 8 * NR; r0 < rows + (rows > ML ? 0 : 0); r0 += G * 8 * NR) {
        if (r0 >= ML) break;
        const int s = r0 >> 12;
        if (s != s_have) { __syncthreads();
            { const int c = 4 * fresh_tid(); f32x4 gg = (f32x4){zf, zf, zf, zf}, a = gg, b = gg;
              if (Y) gg = *(const f32x4*)(modg + (size_t)s * NMOD + kgate * D + c) * *(const f32x4*)(gpost + c) * coef;
              if (H) { a = *(const f32x4*)(gpre + c) * (*(const f32x4*)(modh + (size_t)s * NMOD + (kshift + 1) * D + c) + 1.f); b = *(const f32x4*)(modh + (size_t)s * NMOD + kshift * D + c); }
              *(LAS f32x4*)(V + c) = gg; *(LAS f32x4*)(V + D + c) = a; *(LAS f32x4*)(V + 2 * D + c) = b; }
            __syncthreads(); s_have = s; }
        int ln = lane; asm volatile("" : "+v"(ln)); int col[8];
_Pragma("unroll")
        for (int j = 0; j < 8; ++j) col[j] = 4 * ln + 256 * ((j + wid) & 7);
        f32x4 xf[XF32 ? NR : 1][8]; u32x2 xr[XF32 ? 1 : NR][8], yr[NR][8];
#pragma unroll
        for (int k = 0; k < NR; ++k)
#pragma unroll
            for (int j = 0; j < 8; ++j) { yr[k][j] = (u32x2){0u, 0u}; if (XF32) xf[k][j] = (f32x4){0.f, 0.f, 0.f, 0.f}; else xr[k][j] = (u32x2){0u, 0u}; }
#pragma unroll
        for (int k = 0; k < NR; ++k) norm_row_load<XF32>(A, r0 + wid + 8 * k, col, xf[XF32 ? k : 0], xr[XF32 ? 0 : k], yr[k]);
        __builtin_amdgcn_sched_barrier(0);
#pragma unroll
        for (int k = 0; k < NR; ++k) { norm_row_compute<XF32>(A, V, r0 + wid + 8 * k, col, xf[XF32 ? k : 0], xr[XF32 ? 0 : k], yr[k]); __builtin_amdgcn_sched_barrier(0); }
    }
    if (rows > ML) {
        for (int r0 = ML + bid * 8; r0 < rows; r0 += G * 8) {
            if (s_have != 4) { __syncthreads();
                { const int c = 4 * fresh_tid(); f32x4 gg = (f32x4){zf, zf, zf, zf}, a = gg, b = gg;
                  if (Y) gg = *(const f32x4*)(modg + (size_t)4 * NMOD + kgate * D + c) * *(const f32x4*)(gpost + c) * coef;
                  if (H) { a = *(const f32x4*)(gpre + c) * (*(const f32x4*)(modh + (size_t)4 * NMOD + (kshift + 1) * D + c) + 1.f); b = *(const f32x4*)(modh + (size_t)4 * NMOD + kshift * D + c); }
                  *(LAS f32x4*)(V + c) = gg; *(LAS f32x4*)(V + D + c) = a; *(LAS f32x4*)(V + 2 * D + c) = b; }
                __syncthreads(); s_have = 4; }
            int ln = lane; asm volatile("" : "+v"(ln)); int col[8];
_Pragma("unroll")
        for (int j = 0; j < 8; ++j) col[j] = 4 * ln + 256 * ((j + wid) & 7);
            f32x4 x[8]; u32x2 xr[8], yr[8];
#pragma unroll
            for (int j = 0; j < 8; ++j) { yr[j] = (u32x2){0u, 0u}; xr[j] = (u32x2){0u, 0u}; x[j] = (f32x4){0.f, 0.f, 0.f, 0.f}; }
            norm_row_load<XF32>(A, r0 + wid, col, x, xr, yr);
            norm_row_compute<XF32>(A, V, r0 + wid, col, x, xr, yr);
        }
    }
    __syncthreads();
}
#undef NCOL

__device__ __forceinline__ f32x4 mfma16(bf16x8 a, bf16x8 b, f32x4 c) { return __builtin_amdgcn_mfma_f32_16x16x32_bf16(a, b, c, 0, 0, 0); }
__device__ __forceinline__ void gmlp_chunk(const Ctx& C, int l, LAS unsigned char* lds, int R0, int g_lo) {
    unsigned char* const ws = C.ws();
    const bf16_t* Z = WSP(const bf16_t, WS_Z); bf16_t* YA = WSP(bf16_t, WS_YBR);
    const float* lng = C.in(I_GMLNG) + l * 512; const float* lnb = C.in(I_GMLNB) + l * 512; const float* bs = C.in(I_GMBS) + l * 512; const bf16_t* WS = WLP(const bf16_t, l, WL_GMW);
    LAS float* stats = (LAS float*)lds; LAS bf16_t* vnT = (LAS bf16_t*)(lds + 1024);
    const int tid = fresh_tid(), lane = tid & 63, wid = tid >> 6, i16 = lane & 15, g4 = lane >> 4;
    for (int rr = 0; rr < 16; ++rr) { const int q = 16 * wid + rr; const u32x4 w = *(const u32x4*)(Z + (size_t)(R0 + q) * NZ + 512 + 8 * lane);
        const float v[8] = {bflo(w.x), bfhi(w.x), bflo(w.y), bfhi(w.y), bflo(w.z), bfhi(w.z), bflo(w.w), bfhi(w.w)};
        float s = 0.f;
#pragma unroll
        for (int e = 0; e < 8; ++e) s += v[e];
        const float mean = wave_sum(s) * (1.f / 512.f); float q2 = 0.f;
#pragma unroll
        for (int e = 0; e < 8; ++e) { const float d = v[e] - mean; q2 += d * d; }
        const float rstd = __builtin_amdgcn_rsqf(wave_sum(q2) * (1.f / 512.f) + EPS);
        if (lane == 0) { stats[2 * q] = mean; stats[2 * q + 1] = rstd; } }
    __syncthreads();
    for (int g = g_lo; g < g_lo + 2; ++g) {
        u32x4 wj[4];
#pragma unroll
        for (int j = 0; j < 4; ++j) { const int id = tid + 512 * j, q = id >> 4, cc = id & 15; wj[j] = *(const u32x4*)(Z + (size_t)(R0 + q) * NZ + 512 + g * 128 + 8 * cc); }
        __builtin_amdgcn_sched_barrier(0);
#pragma unroll
        for (int j = 0; j < 4; ++j) { const int id = tid + 512 * j, q = id >> 4, cc = id & 15; const u32x4 w = wj[j];
            const float v[8] = {bflo(w.x), bfhi(w.x), bflo(w.y), bfhi(w.y), bflo(w.z), bfhi(w.z), bflo(w.w), bfhi(w.w)};
            const float mean = stats[2 * q], rstd = stats[2 * q + 1];
            const f32x4 g0 = *(const f32x4*)(lng + g * 128 + 8 * cc), g1 = *(const f32x4*)(lng + g * 128 + 8 * cc + 4), b0 = *(const f32x4*)(lnb + g * 128 + 8 * cc), b1 = *(const f32x4*)(lnb + g * 128 + 8 * cc + 4);
            const float gg[8] = {g0[0], g0[1], g0[2], g0[3], g1[0], g1[1], g1[2], g1[3]}, bb[8] = {b0[0], b0[1], b0[2], b0[3], b1[0], b1[1], b1[2], b1[3]};
#pragma unroll
            for (int e = 0; e < 8; ++e) vnT[(8 * cc + e) * 136 + q] = (bf16_t)f2bf((v[e] - mean) * rstd * gg[e] + bb[e]); }
        __syncthreads();
        bf16x8 bw[4];
#pragma unroll
        for (int ks = 0; ks < 4; ++ks) bw[ks] = *(const bf16x8*)(WS + (size_t)(g * 128 + 16 * wid + i16) * 128 + 32 * ks + 8 * g4);
        f32x4 acc[8];
#pragma unroll
        for (int ct = 0; ct < 8; ++ct) { acc[ct] = (f32x4){0.f, 0.f, 0.f, 0.f};
#pragma unroll
            for (int ks = 0; ks < 4; ++ks) { const bf16x8 a = *(const LAS bf16x8*)(vnT + (16 * ct + i16) * 136 + 32 * ks + 8 * g4); acc[ct] = mfma16(a, bw[ks], acc[ct]); } }
        const int prow = R0 + 16 * wid + i16; const float bsv = bs[g * 128 + 16 * wid + i16];
        u32x2 uwv[8];
#pragma unroll
        for (int ct = 0; ct < 8; ++ct) uwv[ct] = *(const u32x2*)(Z + (size_t)prow * NZ + g * 128 + 16 * ct + 4 * g4);
        __builtin_amdgcn_sched_barrier(0);
#pragma unroll
        for (int ct = 0; ct < 8; ++ct) { const int c4 = g * 128 + 16 * ct + 4 * g4; const u32x2 uw = uwv[ct];
            u32x2 o; o.x = cvt_pk_bf16(bflo(uw.x) * (acc[ct][0] + bsv), bfhi(uw.x) * (acc[ct][1] + bsv)); o.y = cvt_pk_bf16(bflo(uw.y) * (acc[ct][2] + bsv), bfhi(uw.y) * (acc[ct][3] + bsv));
            *(u32x2*)(YA + (size_t)prow * 512 + c4) = o; }
        __syncthreads();
    }
}
__device__ __forceinline__ void conv_block(const Ctx& C, int l, LAS unsigned char* lds, int SR0, int SL, int p0) {
    unsigned char* const ws = C.ws();
    const bf16_t* HB = WSP(const bf16_t, WS_HB); bf16_t* YB = WSP(bf16_t, WS_YBR) + (size_t)MT * 512;
    const float* lng = C.in(I_CVLNG) + l * 512; const float* lnb = C.in(I_CVLNB) + l * 512;
    LAS float* tile = (LAS float*)lds;
    const int tid = fresh_tid(), lane = tid & 63, wid = tid >> 6;
    float dw[31]; const float db = C.in(I_CVDB)[l * 512 + tid]; const float* const dwp = C.in(I_CVDW) + (size_t)l * 31 * 512 + tid;
#pragma unroll
    for (int j = 0; j < 31; ++j) dw[j] = dwp[j * 512];
    __builtin_amdgcn_sched_barrier(0);
    float hv[62]; unsigned raw[62];
#pragma unroll
    for (int j = 0; j < 62; ++j) { const int p = p0 - 15 + j; const int pc = p < 0 ? 0 : (p >= SL ? SL - 1 : p);
        raw[j] = HB[(size_t)(SR0 + pc) * 512 + tid]; }
    __builtin_amdgcn_sched_barrier(0);
#pragma unroll
    for (int j = 0; j < 62; ++j) { const int p = p0 - 15 + j; hv[j] = (p >= 0 && p < SL) ? __builtin_bit_cast(float, raw[j] << 16) : 0.f; }
#pragma unroll
    for (int o = 0; o < 32; ++o) { float s = db;
#pragma unroll
        for (int j = 0; j < 31; ++j) s += dw[j] * hv[o + j];
        tile[o * 512 + tid] = s; }
    __syncthreads();
    const f32x4 lga = *(const f32x4*)(lng + 4 * lane), lgb = *(const f32x4*)(lng + 256 + 4 * lane), lba = *(const f32x4*)(lnb + 4 * lane), lbb = *(const f32x4*)(lnb + 256 + 4 * lane);
#pragma unroll
    for (int rr = 0; rr < 4; ++rr) { const int o = 4 * wid + rr; f32x4 a = *(const LAS f32x4*)(tile + o * 512 + 4 * lane), b = *(const LAS f32x4*)(tile + o * 512 + 256 + 4 * lane);
        const float mean = wave_sum((a[0] + a[1]) + (a[2] + a[3]) + (b[0] + b[1]) + (b[2] + b[3])) * (1.f / 512.f);
        a = a - mean; b = b - mean;
        const float rstd = __builtin_amdgcn_rsqf(wave_sum((a[0] * a[0] + a[1] * a[1]) + (a[2] * a[2] + a[3] * a[3]) + (b[0] * b[0] + b[1] * b[1]) + (b[2] * b[2] + b[3] * b[3])) * (1.f / 512.f) + EPS);
        const f32x4 ya = a * rstd * lga + lba, yb = b * rstd * lgb + lbb;
        u32x2 wa, wb; wa.x = cvt_pk_bf16(ya[0] * sigmoidf_(ya[0]), ya[1] * sigmoidf_(ya[1])); wa.y = cvt_pk_bf16(ya[2] * sigmoidf_(ya[2]), ya[3] * sigmoidf_(ya[3]));
        wb.x = cvt_pk_bf16(yb[0] * sigmoidf_(yb[0]), yb[1] * sigmoidf_(yb[1])); wb.y = cvt_pk_bf16(yb[2] * sigmoidf_(yb[2]), yb[3] * sigmoidf_(yb[3]));
        bf16_t* op = YB + (size_t)(SR0 + p0 + o) * 512; *(u32x2*)(op + 4 * lane) = wa; *(u32x2*)(op + 256 + 4 * lane) = wb; }
    __syncthreads();
}

struct AttnSrc { const bf16_t* k1; int k1ld; const bf16_t* k2; int k2ld; const bf16_t* vt; };
template <int DK1, int DK2, int DV> struct AttnGeo {
    static constexpr int DK = DK1 + DK2, KS = DK / 32, DT = DV / 16, KROW = DK + 8, VROW = 72, KC = DK / 8, NKC = 64 * KC / 512, NVC = DV * 8 / 512, KBYTES = 64 * KROW * 2, VBYTES = DV * VROW * 2, VBASE = 2 * KBYTES  ;
    static_assert((64 * KC) % 512 == 0 && (DV * 8) % 512 == 0, "staging geometry");
};
template <int DK1, int DK2, int DV>
__device__ __forceinline__ void attn_load(const AttnSrc& S, int row0, int tid, u32x4 (&kr)[AttnGeo<DK1, DK2, DV>::NKC], u32x4 (&vr)[AttnGeo<DK1, DK2, DV>::NVC]) {
    typedef AttnGeo<DK1, DK2, DV> Gm;
#pragma unroll
    for (int i = 0; i < Gm::NKC; ++i) { const int c = tid + 512 * i, key = c / Gm::KC, part = c - key * Gm::KC;
        const bf16_t* src = (part < DK1 / 8) ? S.k1 + (size_t)(row0 + key) * S.k1ld + part * 8 : S.k2 + (size_t)(row0 + key) * S.k2ld + (part - DK1 / 8) * 8; kr[i] = *(const u32x4*)src; }
#pragma unroll
    for (int i = 0; i < Gm::NVC; ++i) { const int c = tid + 512 * i, d = c >> 3, c8 = c & 7; vr[i] = *(const u32x4*)(S.vt + (size_t)d * MT + row0 + 8 * c8); }
}
template <int DK1, int DK2, int DV>
__device__ __forceinline__ void attn_store(LAS unsigned char* kbuf, LAS unsigned char* vbuf, int tid, const u32x4 (&kr)[AttnGeo<DK1, DK2, DV>::NKC], const u32x4 (&vr)[AttnGeo<DK1, DK2, DV>::NVC]) {
    typedef AttnGeo<DK1, DK2, DV> Gm; LAS bf16_t* Ks = (LAS bf16_t*)kbuf; LAS bf16_t* Vt = (LAS bf16_t*)vbuf;
#pragma unroll
    for (int i = 0; i < Gm::NKC; ++i) { const int c = tid + 512 * i, key = c / Gm::KC, part = c - key * Gm::KC;
        const int rho = (key & 32) + 16 * ((key >> 2) & 1) + 4 * ((key >> 3) & 3) + (key & 3);
        *(LAS u32x4*)(Ks + rho * Gm::KROW + part * 8) = kr[i]; }
#pragma unroll
    for (int i = 0; i < Gm::NVC; ++i) { const int c = tid + 512 * i, d = c >> 3, c8 = c & 7; *(LAS u32x4*)(Vt + d * Gm::VROW + 8 * c8) = vr[i]; }
}
template <int DT, bool MASK>
__device__ __forceinline__ void attn_softmax(f32x4 (&st)[2], float& m, float& l, f32x4 (&ot)[DT], bf16x8& pf, int kp0  , bool masked) {
    if (MASK && masked) {
#pragma unroll
        for (int t2 = 0; t2 < 2; ++t2)
#pragma unroll
            for (int r = 0; r < 4; ++r) if ((unsigned)(kp0 + 4 * t2 + r) > 256u) st[t2][r] = -1e30f;
    }
    float mx = __builtin_fmaxf(__builtin_fmaxf(__builtin_fmaxf(__builtin_fmaxf(st[0][0], st[0][1]), st[0][2]), __builtin_fmaxf(__builtin_fmaxf(st[0][3], st[1][0]), st[1][1])), __builtin_fmaxf(st[1][2], st[1][3]));
    { auto r16 = __builtin_amdgcn_permlane16_swap(__builtin_bit_cast(unsigned, mx), __builtin_bit_cast(unsigned, mx), false, false);
      mx = vmax(__builtin_bit_cast(float, r16[0]), __builtin_bit_cast(float, r16[1]));
      auto r32 = __builtin_amdgcn_permlane32_swap(__builtin_bit_cast(unsigned, mx), __builtin_bit_cast(unsigned, mx), false, false);
      mx = vmax(__builtin_bit_cast(float, r32[0]), __builtin_bit_cast(float, r32[1])); }
    const float mn = vmax(m, mx);
    if (__any(mn > m)) { const float alpha = fast_exp2(m - mn); l *= alpha;
#pragma unroll
        for (int dt = 0; dt < DT; ++dt) ot[dt] = ot[dt] * alpha; }
    m = mn;
    { const float nmn = -mn; const f32x4 d0 = st[0] + nmn, d1 = st[1] + nmn;
      st[0] = (f32x4){fast_exp2(d0[0]), fast_exp2(d0[1]), fast_exp2(d0[2]), fast_exp2(d0[3])}; st[1] = (f32x4){fast_exp2(d1[0]), fast_exp2(d1[1]), fast_exp2(d1[2]), fast_exp2(d1[3])};
      const f32x4 es = st[0] + st[1]; const f32x2 e2 = (f32x2){es[0], es[1]} + (f32x2){es[2], es[3]};
      l += e2[0] + e2[1]; }
    union { u32x4 u; bf16x8 b; } q; q.u.x = cvt_pk_bf16(st[0][0], st[0][1]); q.u.y = cvt_pk_bf16(st[0][2], st[0][3]); q.u.z = cvt_pk_bf16(st[1][0], st[1][1]); q.u.w = cvt_pk_bf16(st[1][2], st[1][3]);
    pf = q.b;
}
template <int DK1, int DK2, int DV, bool MASK>
__device__ __forceinline__ void attn_unit(LAS unsigned char* lds, const AttnSrc& S, const bf16_t* q0p, const bf16_t* q1p, bf16_t* o0p, bf16_t* o1p,
                                          int ctx_row0, int nctx, int loc_row0, int loc_pos0, int nloc, int qpos0, int qpos1, float m0, float l0, int role) {
    typedef AttnGeo<DK1, DK2, DV> Gm; constexpr int KS = Gm::KS, DT = Gm::DT, KROW = Gm::KROW, VROW = Gm::VROW;
    const int tid = fresh_tid(), lane = tid & 63, i16 = lane & 15, g4 = lane >> 4;
    bf16x8 qf0[KS], qf1[KS];
#pragma unroll
    for (int ks = 0; ks < KS; ++ks) { qf0[ks] = *(const bf16x8*)(q0p + 32 * ks + 8 * g4); qf1[ks] = *(const bf16x8*)(q1p + 32 * ks + 8 * g4); }
    f32x4 ot0[DT], ot1[DT];
#pragma unroll
    for (int dt = 0; dt < DT; ++dt) { ot0[dt] = (f32x4){0.f, 0.f, 0.f, 0.f}; ot1[dt] = (f32x4){0.f, 0.f, 0.f, 0.f}; }
    float ma = m0, mb = m0, la = (g4 == 0) ? l0 : 0.f, lb = la;
    const int NT = nctx + nloc;
    u32x4 kr[Gm::NKC], vr[Gm::NVC];
#define TROW(t) ((t) < nctx ? ctx_row0 + 64 * (t) : loc_row0 + 64 * ((t) - nctx))
    attn_load<DK1, DK2, DV>(S, TROW(0), tid, kr, vr);
    __syncthreads();
    attn_store<DK1, DK2, DV>(lds, lds + Gm::VBASE, tid, kr, vr);
    __syncthreads();
    if (NT > 1) attn_load<DK1, DK2, DV>(S, TROW(1), tid, kr, vr);
    int vs = 0;
    for (int tt = 0; tt < NT; ++tt) {
        const LAS bf16_t* Ks = (const LAS bf16_t*)(lds + (tt & 1) * Gm::KBYTES); const LAS bf16_t* Vt = (const LAS bf16_t*)(lds + Gm::VBASE + vs * Gm::VBYTES);
        const bool masked = MASK && tt >= nctx; const int kpb = loc_pos0 + 64 * (tt - nctx) + 8 * g4 + 128;
        f32x4 sa[2], sb[2];
#define AT_X(hh) do { _Pragma("unroll") for (int t2 = 0; t2 < 2; ++t2) { sa[t2] = (f32x4){0.f, 0.f, 0.f, 0.f}; sb[t2] = (f32x4){0.f, 0.f, 0.f, 0.f}; bf16x8 kf[KS]; \
            _Pragma("unroll") for (int ks = 0; ks < KS; ++ks) kf[ks] = *(const LAS bf16x8*)(Ks + (32 * (hh) + 16 * t2 + i16) * KROW + 32 * ks + 8 * g4); \
            __builtin_amdgcn_sched_barrier(0); \
            _Pragma("unroll") for (int ks = 0; ks < KS; ++ks) { sa[t2] = mfma16(kf[ks], qf0[ks], sa[t2]); sb[t2] = mfma16(kf[ks], qf1[ks], sb[t2]); } \
            __builtin_amdgcn_sched_barrier(0); } } while (0)
#define AT_Y(hh) do { bf16x8 pa, pb; \
            attn_softmax<DT, MASK>(sa, ma, la, ot0, pa, kpb + 32 * (hh) - qpos0, masked); \
            attn_softmax<DT, MASK>(sb, mb, lb, ot1, pb, kpb + 32 * (hh) - qpos1, masked); \
            __builtin_amdgcn_sched_barrier(0); \
            _Pragma("unroll") for (int d4 = 0; d4 < DT; d4 += 4) { bf16x8 vf[4]; \
                _Pragma("unroll") for (int dd = 0; dd < 4; ++dd) vf[dd] = *(const LAS bf16x8*)(Vt + (16 * (d4 + dd) + i16) * VROW + 32 * (hh) + 8 * g4); \
                __builtin_amdgcn_sched_barrier(0); \
                _Pragma("unroll") for (int dd = 0; dd < 4; ++dd) { ot0[d4 + dd] = mfma16(vf[dd], pa, ot0[d4 + dd]); ot1[d4 + dd] = mfma16(vf[dd], pb, ot1[d4 + dd]); } \
                __builtin_amdgcn_sched_barrier(0); } } while (0)
        AT_X(0); AT_Y(0); AT_X(1);
        if (role == 0) AT_Y(1);
        const int vn = vs == 2 ? 0 : vs + 1;
        if (tt + 1 < NT) attn_store<DK1, DK2, DV>(lds + ((tt + 1) & 1) * Gm::KBYTES, lds + Gm::VBASE + vn * Gm::VBYTES, tid, kr, vr);
        __syncthreads();
        if (tt + 2 < NT) attn_load<DK1, DK2, DV>(S, TROW(tt + 2), tid, kr, vr);
        if (role != 0) AT_Y(1);
        vs = vn;
#undef AT_X
#undef AT_Y
    }
#undef TROW
    float lt = la + __shfl_xor(la, 16); lt += __shfl_xor(lt, 32); const float ia = 1.f / lt;
    lt = lb + __shfl_xor(lb, 16); lt += __shfl_xor(lt, 32); const float ib = 1.f / lt;
#pragma unroll
    for (int dt = 0; dt < DT; ++dt) { u32x2 w; w.x = cvt_pk_bf16(ot0[dt][0] * ia, ot0[dt][1] * ia); w.y = cvt_pk_bf16(ot0[dt][2] * ia, ot0[dt][3] * ia); *(u32x2*)(o0p + 16 * dt + 4 * g4) = w;
        w.x = cvt_pk_bf16(ot1[dt][0] * ib, ot1[dt][1] * ib); w.y = cvt_pk_bf16(ot1[dt][2] * ib, ot1[dt][3] * ib); *(u32x2*)(o1p + 16 * dt + 4 * g4) = w; }
}

constexpr int NPHASE = 2 + 12 * DEPTH;
__global__ void __launch_bounds__(512, 2) mk_fwd(Params P) {
    extern __shared__ __attribute__((aligned(16))) unsigned char lds_raw[];
    LAS unsigned char* lds = (LAS unsigned char*)lds_raw;
    const int tid = fresh_tid();
    volatile LAS unsigned* MISC = (volatile LAS unsigned*)(lds + MISC_OFF);
    for (int u = tid; u < (LDS_BYTES - RING_BYTES) / 4; u += 512) ((LAS unsigned*)(lds + RING_BYTES))[u] = 0u;
    __syncthreads();
    Ctx C; C.tab = (volatile LAS unsigned*)(lds + PTAB_OFF);
    if (tid == 0) {
#pragma unroll
        for (int i = 0; i < 28; ++i) { const unsigned long long v = (unsigned long long)P.in[i]; C.tab[2 * i] = (unsigned)v; C.tab[2 * i + 1] = (unsigned)(v >> 32); }
        { const unsigned long long v = (unsigned long long)P.out; C.tab[56] = (unsigned)v; C.tab[57] = (unsigned)(v >> 32); }
        { const unsigned long long v = (unsigned long long)P.ws; C.tab[58] = (unsigned)v; C.tab[59] = (unsigned)(v >> 32); }
        C.tab[60] = (unsigned)P.ph_lo; C.tab[61] = (unsigned)P.ph_hi;
    }
    __syncthreads();
    if (!MK_MULTI) (void)xcd_barrier_post((unsigned*)(C.ws() + WS_CTL) + CW_BAR, MISC + 8);
    auto tabw = [&](unsigned off) -> int { asm volatile("" : "+s"(off)); return (int)__builtin_amdgcn_readfirstlane(*(volatile LAS unsigned*)(lds + off)); };
#define LO tabw(PTAB_OFF + 240)
#define HI tabw(PTAB_OFF + 244)
#define IN(k) (LO <= (k) && (k) < HI)
#define MKBAR XcdBarrier bar; bar.bar = (unsigned*)(C.ws() + WS_CTL) + CW_BAR; bar.x = xb_xcc_id(); bar.st = (volatile LAS unsigned*)(lds + MISC_OFF) + 8
#define SEAM(k) do { if (!MK_MULTI && IN(k) && IN((k) + 1)) { MKBAR; xcd_barrier(bar); } } while (0)
#define GRID const int G = gridDim.x, bid = blockIdx.x

    if (IN(0) && EN(12)) for (int _rep = 0; _rep < (((PROBE_MASK >> 12) & 1) ? 2 : 1); ++_rep) { if (_rep) { MKBAR; xcd_barrier(bar); } GRID; prologue_phase(C, lds, G, bid); }
    SEAM(0);

    for (int l = 0; l < DEPTH; ++l) {
        const int pb = 1 + 12 * l; const bool last = (l == DEPTH - 1);
        if (IN(pb + 0) && EN(0)) for (int _rep = 0; _rep < (((PROBE_MASK >> 0) & 1) ? 2 : 1); ++_rep) { if (_rep) { MKBAR; xcd_barrier(bar); } GRID; unsigned char* const ws = C.ws(); float* const out = C.out(); float* const XC = WSP(float, WS_XC);
            const float* modl = WSP(const float, WS_MOD) + (size_t)l * 5 * NMOD; const float* npre = C.in(I_NPRE) + (size_t)l * 3 * D; const float* npost = C.in(I_NPOST) + (size_t)l * 3 * D;
            if (l == 0) norm_phase<true>(lds, G, bid, MT, C.in(I_X), C.in(I_CTX), WSP(bf16_t, WS_XB), nullptr, false  , nullptr, nullptr, modl, 0, 0.f, nullptr, WSP(bf16_t, WS_H), modl, 0, npre);
            else norm_phase<false>(lds, G, bid, MT, nullptr, nullptr, WSP(bf16_t, WS_XB), nullptr, true, WSP(const bf16_t, WS_Y), (G >= 256 ? (const float*)C.out() : nullptr), modl - (size_t)5 * NMOD, 8, 0.5f, npost - D, WSP(bf16_t, WS_H), modl, 0, npre);
        }
        SEAM(pb + 0);
        if (IN(pb + 1) && EN(1)) for (int _rep = 0; _rep < (((PROBE_MASK >> 1) & 1) ? 2 : 1); ++_rep) { if (_rep) { MKBAR; xcd_barrier(bar); } GRID; unsigned char* const ws = C.ws();
            pg8::RectOrder S; S.init(MT / 256, NGU / 256, G, bid, 0, WSP(bf16_t, WS_H), 256 * D * 2, WLP(bf16_t, l, WL_GU), 256 * D * 2);
            pg8::EpiSwiglu E{WSP(bf16_t, WS_Z)}; pg8::gemm_phase<pg8::EpiSwiglu, pg8::RectOrder, true>(lds, D, D, D, S, E); }
        if (IN(pb + 1) && EN(1)) { GRID; cvt_pull(C, lds, l * CV_LAYER + CV_E2, CW_DONE + 64 * (pb + 1), G); }
        SEAM(pb + 1);
        if (IN(pb + 2) && EN(2)) for (int _rep = 0; _rep < (((PROBE_MASK >> 2) & 1) ? 2 : 1); ++_rep) { if (_rep) { MKBAR; xcd_barrier(bar); } GRID; unsigned char* const ws = C.ws();
            const bool split = (G >= 256);
            { pg8::RectOrder S; S.init((split ? ML : MT) / 256, D / 256, G, bid, 0, WSP(bf16_t, WS_Z), 256 * DFF * 2, WLP(bf16_t, l, WL_D), 256 * DFF * 2);
              pg8::EpiPlain<false> E{WSP(bf16_t, WS_Y), D, nullptr}; pg8::gemm_phase<pg8::EpiPlain<false>, pg8::RectOrder, true>(lds, DFF, DFF, DFF, S, E); }
            if (split) { const int tile = bid >> 3, part = bid & 7, ks = part < 5 ? 10 * part : 50 + 12 * (part - 5), kn = part < 5 ? 10 : 12;
              pg8::SplitOrder S; S.pm = ML / 256 + (tile >> 3); S.pn = tile & 7; S.part = part; S.have = bid < 256;
              S.A = (const char*)(WSP(bf16_t, WS_Z) + (size_t)S.pm * 256 * DFF + ks * 64); S.B = (const char*)(WLP(bf16_t, l, WL_D) + (size_t)S.pn * 256 * DFF + ks * 64);
              pg8::EpiPartial E{C.out(), ML, (size_t)MC * D}; pg8::gemm_phase<pg8::EpiPartial, pg8::SplitOrder, true>(lds, kn * 64, DFF, DFF, S, E); } }
        SEAM(pb + 2);
        if (IN(pb + 3) && EN(3)) for (int _rep = 0; _rep < (((PROBE_MASK >> 3) & 1) ? 2 : 1); ++_rep) { if (_rep) { MKBAR; xcd_barrier(bar); } GRID; unsigned char* const ws = C.ws(); float* const out = C.out(); float* const XC = WSP(float, WS_XC);
            const float* const modl = WSP(const float, WS_MOD) + (size_t)l * 5 * NMOD;
            if (l == 0) norm_phase<true>(lds, G, bid, MT, C.in(I_X), C.in(I_CTX), WSP(bf16_t, WS_XB), nullptr, true, WSP(const bf16_t, WS_Y), (G >= 256 ? (const float*)C.out() : nullptr), modl, 2, 0.5f, C.in(I_NPOST) + (size_t)l * 3 * D, WSP(bf16_t, WS_H), modl, 3, C.in(I_NPRE) + ((size_t)l * 3 + 1) * D);
            else norm_phase<false>(lds, G, bid, MT, nullptr, nullptr, WSP(bf16_t, WS_XB), nullptr, true, WSP(const bf16_t, WS_Y), (G >= 256 ? (const float*)C.out() : nullptr), modl, 2, 0.5f, C.in(I_NPOST) + (size_t)l * 3 * D, WSP(bf16_t, WS_H), modl, 3, C.in(I_NPRE) + ((size_t)l * 3 + 1) * D); }
        SEAM(pb + 3);
        if (IN(pb + 4) && EN(4)) for (int _rep = 0; _rep < (((PROBE_MASK >> 4) & 1) ? 2 : 1); ++_rep) { if (_rep) { MKBAR; xcd_barrier(bar); } GRID; unsigned char* const ws = C.ws();
            bf16_t* const Z = WSP(bf16_t, WS_Z); bf16_t* const H = WSP(bf16_t, WS_H);
            LAS float* const LTAB = (LAS float*)(lds + LTAB_OFF);
            { const int t_ = fresh_tid(); for (int i = t_; i < 2048; i += 512) LTAB[i] = WSP(const float, WS_TAB)[i]; __syncthreads(); }
            pg8::EpiZ E{Z, WSP(bf16_t, WS_HB), WSP(float, WS_SSP), WLP(const float, l, WL_BZ), LTAB, 0, 0};
            { pg8::RectOrder S; S.init(ML / 256, NZ / 256, G, bid, 0, H, 256 * D * 2, WLP(bf16_t, l, WL_IN), 256 * D * 2);
              pg8::gemm_phase<pg8::EpiZ, pg8::RectOrder, true>(lds, D, D, D, S, E); }
            int used = (ML / 256) * (NZ / 256);
            {
                const int ct0 = last ? 10 : 0, nct = last ? 4 : 14;
                pg8::EpiZ E2{Z, WSP(bf16_t, WS_HB), WSP(float, WS_SSP), WLP(const float, l, WL_BZ), LTAB, ct0, ML};
                pg8::RectOrder S; S.init(MC / 256, nct, G, bid, used, H + (size_t)ML * D, 256 * D * 2, WLP(bf16_t, l, WL_IN) + (size_t)ct0 * 256 * D, 256 * D * 2);
                pg8::gemm_phase<pg8::EpiZ, pg8::RectOrder, true>(lds, D, D, D, S, E2); used += (MC / 256) * nct; }
            {
                pg8::EpiVt<false> E3{WSP(bf16_t, WS_VTD), MT, WLP(const float, l, WL_BZ) + NZ, nullptr};
                pg8::RectOrder S; S.init(1, MT / 256, G, bid, used, WLP(bf16_t, l, WL_IN) + (size_t)NZ * D, 0, H, 256 * D * 2);
                pg8::gemm_phase<pg8::EpiVt<false>, pg8::RectOrder, true>(lds, D, D, D, S, E3); }
        }
        if (IN(pb + 4) && EN(4)) { GRID; cvt_pull(C, lds, l * CV_LAYER + CV_E7, CW_DONE + 64 * (pb + 4), G); }
        SEAM(pb + 4);
        if (IN(pb + 5) && EN(5)) for (int _rep = 0; _rep < (((PROBE_MASK >> 5) & 1) ? 2 : 1); ++_rep) { if (_rep) { MKBAR; xcd_barrier(bar); } GRID;
            const int lm_ = _rep ? PROBE_LOCMASK : LOCMASK;
            const int nch = 2 * ((last ? ML : MT) / 128), ncb = (last ? ML : MT) / 32;
            for (int it = bid; it < nch + ncb; it += G) {
                if (it < nch) { if (lm_ & 1) gmlp_chunk(C, l, lds, (it >> 1) * 128, 2 * (it & 1)); }
                else { const int cb = it - nch; int SR0, SL, p0; if (cb < ML / 32) { SR0 = (cb >> 7) * SEQ; SL = SEQ; p0 = (cb & 127) * 32; } else { const int c2 = cb - ML / 32; SR0 = ML + (c2 >> 3) * CTXL; SL = CTXL; p0 = (c2 & 7) * 32; }
                    if (lm_ & 2) conv_block(C, l, lds, SR0, SL, p0); }
            }
            __syncthreads();
            const int pan_q = (last ? ML : MT) / 256;
            if (!last) { unsigned char* const ws = C.ws();
              LAS float* const LTAB = (LAS float*)(lds + LTAB_OFF);
              pg8::EpiZ E2{WSP(bf16_t, WS_Z), WSP(bf16_t, WS_HB), WSP(float, WS_SSP), WLP(const float, l, WL_BZ), LTAB, 14, ML};
              pg8::RectOrder S; S.init(MC / 256, NZ / 256 - 14, G, bid, G / 2, WSP(bf16_t, WS_H) + (size_t)ML * D, 256 * D * 2, WLP(bf16_t, l, WL_IN) + (size_t)14 * 256 * D, 256 * D * 2);
              pg8::gemm_phase<pg8::EpiZ, pg8::RectOrder, true>(lds, D, D, D, S, E2); }
            if (lm_ & 4) { unsigned char* const ws = C.ws();
              pg8::RectOrder S; S.init(pan_q, 3, G, bid, 0, WSP(bf16_t, WS_Z) + ZC_CQ, 256 * NZ * 2, WLP(bf16_t, l, WL_UQ), 256 * 512 * 2);
              LAS float* const LTAB = (LAS float*)(lds + LTAB_OFF); { const int t_ = fresh_tid(); for (int i = t_; i < 2048; i += 512) LTAB[i] = WSP(const float, WS_TAB)[i]; __syncthreads(); }
              pg8::EpiQ E{WSP(bf16_t, WS_QM), WSP(const float, WS_SSP), LTAB}; pg8::gemm_phase<pg8::EpiQ, pg8::RectOrder, true>(lds, 512, NZ, 512, S, E); }
            if (lm_ & 8) { unsigned char* const ws = C.ws();
              { pg8::RectOrder S; S.init(MT / 256, 2, G, bid, last ? pan_q * 3 : 0, WSP(bf16_t, WS_Z) + ZC_CKV, 256 * NZ * 2, WLP(bf16_t, l, WL_KV), 256 * 256 * 2);
                pg8::EpiPlain<true> E{WSP(bf16_t, WS_KN), 512, WSP(const float, WS_SSP)}; pg8::gemm_phase<pg8::EpiPlain<true>, pg8::RectOrder, true>(lds, 256, NZ, 256, S, E); }
              { pg8::RectOrder S; S.init(2, MT / 256, G, bid, last ? pan_q * 3 + (MT / 256) * 2 : 0, WLP(bf16_t, l, WL_KV) + 512 * 256, 256 * 256 * 2, WSP(bf16_t, WS_Z) + ZC_CKV, 256 * NZ * 2);
                pg8::EpiVt<true> E{WSP(bf16_t, WS_VTM), MT, nullptr, WSP(const float, WS_SSP)}; pg8::gemm_phase<pg8::EpiVt<true>, pg8::RectOrder, true>(lds, 256, 256, NZ, S, E); } }
        }
        SEAM(pb + 5);
        if (IN(pb + 6) && EN(6)) for (int _rep = 0; _rep < (((PROBE_MASK >> 6) & 1) ? 2 : 1); ++_rep) { if (_rep) { MKBAR; xcd_barrier(bar); } GRID; unsigned char* const ws = C.ws();
            bf16_t* const YC = WSP(bf16_t, WS_YBR) + (size_t)2 * MT * 512; bf16_t* const YD = WSP(bf16_t, WS_YBR) + (size_t)3 * MT * 512;
            const bf16_t* const QM = WSP(const bf16_t, WS_QM); const bf16_t* const KN = WSP(const bf16_t, WS_KN); const bf16_t* const Z = WSP(const bf16_t, WS_Z);
            const bf16_t* const VTM = WSP(const bf16_t, WS_VTM); const bf16_t* const VTD = WSP(const bf16_t, WS_VTD);
            const float* const sink = C.in(I_SINK) + l * 8;
            const int tid2 = fresh_tid(), wid = __builtin_amdgcn_readfirstlane(tid2 >> 6);
            int role; { const unsigned simd = (unsigned)__builtin_amdgcn_s_getreg((1 << 11) | (4 << 6) | 4) & 3u; volatile LAS unsigned* sw = (volatile LAS unsigned*)(lds + 122880);
              __syncthreads(); if ((tid2 & 63) == 0) sw[wid] = simd; __syncthreads();
              int cnt = 0;
#pragma unroll
              for (int w = 0; w < 8; ++w) cnt += (w < wid && sw[w] == simd) ? 1 : 0;
              role = __builtin_amdgcn_readfirstlane(cnt & 1); }
#ifdef ROLE_WID
            role = (ROLE_WID == 4) ? (wid >> 2) & 1 : wid & 1;
#endif
#define i16 (fresh_tid() & 15)
            for (int u = bid; u < 256; u += G) { const int bh = (u & 7) + 8 * ((u >> 7) & 1), qb = (u >> 3) & 15, b = bh >> 2, h = bh & 3;
                const int row = b * SEQ + 256 * qb + 32 * wid + i16;
                AttnSrc S{KN + h * 128, 512, Z + ZC_KR, NZ, VTM + (size_t)h * 128 * MT};
                attn_unit<128, 64, 128, false>(lds, S, QM + (size_t)row * 768 + h * 192, QM + (size_t)(row + 16) * 768 + h * 192, YC + (size_t)row * 512 + h * 128, YC + (size_t)(row + 16) * 512 + h * 128,
                                               ML + b * CTXL, 4, b * SEQ, 0, 64, 0, 0, -1e30f, 0.f, role); }
            for (int u = bid; u < 512; u += G) { const int b = u >> 7, kvh = (u >> 6) & 1, qb = u & 63, q0 = 64 * qb, head = 4 * kvh + (wid >> 1);
                const int q = q0 + 32 * (wid & 1) + i16, row = b * SEQ + q;
                int tlo = (128 - q0) / 64; if (tlo < 0) tlo = 0; int thi = (SEQ + 128 - q0) / 64; if (thi > 5) thi = 5;
                const int lp0 = q0 - 128 + 64 * tlo;
                AttnSrc S{Z + ZC_KD + 64 * kvh, NZ, Z, NZ, VTD + (size_t)kvh * 64 * MT};
                attn_unit<64, 0, 64, true>(lds, S, Z + (size_t)row * NZ + ZC_QD + 64 * head, Z + (size_t)(row + 16) * NZ + ZC_QD + 64 * head, YD + (size_t)row * 512 + 64 * head, YD + (size_t)(row + 16) * 512 + 64 * head,
                                           ML + b * CTXL, 4, b * SEQ + lp0, lp0, thi - tlo, q, q + 16, sink[head] * LOG2E, 1.f, role); }
            if (!last) {
                for (int u = bid; u < 16; u += G) { const int b = u >> 2, h = u & 3; const int row = ML + b * CTXL + 32 * wid + i16;
                    AttnSrc S{KN + h * 128, 512, Z + ZC_KR, NZ, VTM + (size_t)h * 128 * MT};
                    attn_unit<128, 64, 128, false>(lds, S, QM + (size_t)row * 768 + h * 192, QM + (size_t)(row + 16) * 768 + h * 192, YC + (size_t)row * 512 + h * 128, YC + (size_t)(row + 16) * 512 + h * 128,
                                                   ML + b * CTXL, 4, 0, 0, 0, 0, 0, -1e30f, 0.f, role); }
                for (int u = bid - 16; u >= 0 && u < 32; u += G) { const int b = u >> 3, kvh = (u >> 2) & 1, qb = u & 3, head = 4 * kvh + (wid >> 1);
                    const int q = 64 * qb + 32 * (wid & 1) + i16, row = ML + b * CTXL + q;
                    AttnSrc S{Z + ZC_KD + 64 * kvh, NZ, Z, NZ, VTD + (size_t)kvh * 64 * MT};
                    attn_unit<64, 0, 64, false>(lds, S, Z + (size_t)row * NZ + ZC_QD + 64 * head, Z + (size_t)(row + 16) * NZ + ZC_QD + 64 * head, YD + (size_t)row * 512 + 64 * head, YD + (size_t)(row + 16) * 512 + 64 * head,
                                                ML + b * CTXL, 4, 0, 0, 0, 0, 0, sink[head] * LOG2E, 1.f, role); }
            }
            __syncthreads();
        }
        SEAM(pb + 6);
#undef i16
        if (IN(pb + 7) && EN(7)) for (int _rep = 0; _rep < (((PROBE_MASK >> 7) & 1) ? 2 : 1); ++_rep) { if (_rep) { MKBAR; xcd_barrier(bar); } GRID; unsigned char* const ws = C.ws();
            pg8::ChainOrder S; S.init((last ? ML : MT) / 256, D / 128, G, bid, 0, WSP(bf16_t, WS_YBR), 256 * 512 * 2, WLP(bf16_t, l, WL_BR), 128 * 512 * 2); S.nsub = MERGE_N; S.map = MERGE_MAP; S.sA = (size_t)MT * 512 * 2; S.sB = (size_t)D * 512 * 2;
            pg8::EpiM1H E{WSP(const bf16_t, WS_Z), WSP(bf16_t, WS_H), S.nsub - 1, S.map}; pg8::gemm_phase<pg8::EpiM1H, pg8::ChainOrder, true, true>(lds, 512, 512, 512, S, E); }
        SEAM(pb + 7);
        if (IN(pb + 8) && EN(8)) for (int _rep = 0; _rep < (((PROBE_MASK >> 8) & 1) ? 2 : 1); ++_rep) { if (_rep) { MKBAR; xcd_barrier(bar); } GRID; unsigned char* const ws = C.ws();
            const bool split = (G >= 256) && !last;
            { pg8::RectOrder S; S.init((last || split ? ML : MT) / 256, D / 256, G, bid, 0, WSP(bf16_t, WS_H), 256 * D * 2, WLP(bf16_t, l, WL_OUT), 256 * D * 2);
              pg8::EpiPlain<false> E{WSP(bf16_t, WS_Y), D, nullptr}; pg8::gemm_phase<pg8::EpiPlain<false>, pg8::RectOrder, true>(lds, D, D, D, S, E); }
            if (split) { const int tile = bid >> 3, part = bid & 7;
              pg8::SplitOrder S; S.pm = ML / 256 + (tile >> 3); S.pn = tile & 7; S.part = part; S.have = bid < 256;
              S.A = (const char*)(WSP(bf16_t, WS_H) + (size_t)S.pm * 256 * D + part * 256); S.B = (const char*)(WLP(bf16_t, l, WL_OUT) + (size_t)S.pn * 256 * D + part * 256);
              pg8::EpiPartial E{C.out(), ML, (size_t)MC * D}; pg8::gemm_phase<pg8::EpiPartial, pg8::SplitOrder, true>(lds, 256, D, D, S, E); } }
        SEAM(pb + 8);
        if (IN(pb + 9) && EN(9)) for (int _rep = 0; _rep < (((PROBE_MASK >> 9) & 1) ? 2 : 1); ++_rep) { if (_rep) { MKBAR; xcd_barrier(bar); } GRID; unsigned char* const ws = C.ws(); float* const out = C.out(); float* const XC = WSP(float, WS_XC);
            norm_phase<false>(lds, G, bid, last ? ML : MT, nullptr, nullptr, WSP(bf16_t, WS_XB), nullptr, true, WSP(const bf16_t, WS_Y), (G >= 256 && !last) ? (const float*)C.out() : nullptr, WSP(const float, WS_MOD) + (size_t)l * 5 * NMOD, 5, 1.0f, C.in(I_NPOST) + ((size_t)l * 3 + 1) * D, WSP(bf16_t, WS_H), WSP(const float, WS_MOD) + (size_t)l * 5 * NMOD, 6, C.in(I_NPRE) + ((size_t)l * 3 + 2) * D); }
        SEAM(pb + 9);
        if (IN(pb + 10) && EN(10)) for (int _rep = 0; _rep < (((PROBE_MASK >> 10) & 1) ? 2 : 1); ++_rep) { if (_rep) { MKBAR; xcd_barrier(bar); } GRID; unsigned char* const ws = C.ws();
            pg8::RectOrder S; S.init((last ? ML : MT) / 256, NGU / 256, G, bid, 0, WSP(bf16_t, WS_H), 256 * D * 2, WLP(bf16_t, l, WL_GU) + (size_t)NGU * D, 256 * D * 2);
            pg8::EpiSwiglu E{WSP(bf16_t, WS_Z)}; pg8::gemm_phase<pg8::EpiSwiglu, pg8::RectOrder, true>(lds, D, D, D, S, E); }
        if (IN(pb + 10) && EN(10)) { GRID; cvt_pull(C, lds, l * CV_LAYER + CV_LAYER + CV_E0, CW_DONE + 64 * (pb + 10), G); }
        SEAM(pb + 10);
        if (IN(pb + 11) && EN(11)) for (int _rep = 0; _rep < (((PROBE_MASK >> 11) & 1) ? 2 : 1); ++_rep) { if (_rep) { MKBAR; xcd_barrier(bar); } GRID; unsigned char* const ws = C.ws();
            const bool split = (G >= 256) && !last;
            { pg8::RectOrder S; S.init((last || split ? ML : MT) / 256, D / 256, G, bid, 0, WSP(bf16_t, WS_Z), 256 * DFF * 2, WLP(bf16_t, l, WL_D) + (size_t)D * DFF, 256 * DFF * 2);
              pg8::EpiPlain<false> E{WSP(bf16_t, WS_Y), D, nullptr}; pg8::gemm_phase<pg8::EpiPlain<false>, pg8::RectOrder, true>(lds, DFF, DFF, DFF, S, E); }
            if (split) { const int tile = bid >> 3, part = bid & 7, ks = part < 5 ? 10 * part : 50 + 12 * (part - 5), kn = part < 5 ? 10 : 12;
              pg8::SplitOrder S; S.pm = ML / 256 + (tile >> 3); S.pn = tile & 7; S.part = part; S.have = bid < 256;
              S.A = (const char*)(WSP(bf16_t, WS_Z) + (size_t)S.pm * 256 * DFF + ks * 64); S.B = (const char*)(WLP(bf16_t, l, WL_D) + (size_t)D * DFF + (size_t)S.pn * 256 * DFF + ks * 64);
              pg8::EpiPartial E{C.out(), ML, (size_t)MC * D}; pg8::gemm_phase<pg8::EpiPartial, pg8::SplitOrder, true>(lds, kn * 64, DFF, DFF, S, E); } }
        SEAM(pb + 11);
    }
    if (IN(NPHASE - 1) && EN(13)) { GRID; unsigned char* const ws = C.ws(); float* const out = C.out(); float* const XC = WSP(float, WS_XC);
        const int l = DEPTH - 1;
        norm_phase<false>(lds, G, bid, ML, nullptr, nullptr, WSP(bf16_t, WS_XB), out, false, WSP(const bf16_t, WS_Y), nullptr, WSP(const float, WS_MOD) + (size_t)l * 5 * NMOD, 8, 0.5f, C.in(I_NPOST) + ((size_t)l * 3 + 2) * D, nullptr, nullptr, 0, nullptr);
    }
#undef IN
#undef SEAM
}


extern "C" void kernel_launch(void* const* d_in, const int* in_sizes, int n_in, void* d_out, int out_size, void* d_ws, size_t ws_size, hipStream_t stream) {
    static int grid = 0;
    if (grid == 0) {
        if (n_in != 28 || out_size != ML * D || ws_size < WS_END) { fprintf(stderr, "kernel_launch: unexpected shapes (n_in %d, out %d, ws %zu < %zu)\n", n_in, out_size, ws_size, (size_t)WS_END); grid = -1; return; }
        int dev = 0, cus = 0, per_cu = 0;
        if (hipGetDevice(&dev) != hipSuccess || hipDeviceGetAttribute(&cus, hipDeviceAttributeMultiprocessorCount, dev) != hipSuccess) { grid = -1; return; }
        if (hipFuncSetAttribute((const void*)mk_fwd, hipFuncAttributeMaxDynamicSharedMemorySize, LDS_BYTES) != hipSuccess) { fprintf(stderr, "kernel_launch: hipFuncSetAttribute failed\n"); grid = -1; return; }
        if (hipOccupancyMaxActiveBlocksPerMultiprocessor(&per_cu, (const void*)mk_fwd, 512, LDS_BYTES) != hipSuccess || per_cu < 1) fprintf(stderr, "kernel_launch: occupancy query says %d\n", per_cu);
        (void)hipGetLastError();
        grid = cus;
    }
    if (grid < 0) return;
    (void)hipMemsetAsync((char*)d_ws + WS_CTL, 0, CTL_ZERO_BYTES, stream);
    Params p{};
    for (int i = 0; i < 28; ++i) p.in[i] = (const float*)d_in[i];
    p.out = (float*)d_out; p.ws = (unsigned char*)d_ws;
#if MK_MULTI
    for (int k = 0; k < NPHASE; ++k) { p.ph_lo = k; p.ph_hi = k + 1; hipLaunchKernelGGL(mk_fwd, dim3(grid), dim3(512), LDS_BYTES, stream, p);
    }
#else
    p.ph_lo = 0; p.ph_hi = NPHASE; hipLaunchKernelGGL(mk_fwd, dim3(grid), dim3(512), LDS_BYTES, stream, p);
#endif
}
```

```cpp
#include <hip/hip_runtime.h>
#include <cstdio>
#include <cstdint>

#define LAS __attribute__((address_space(3)))
#define GAS __attribute__((address_space(1)))
typedef unsigned short bf16_t;
typedef short bf16x8 __attribute__((ext_vector_type(8)));
typedef float f32x4 __attribute__((ext_vector_type(4)));
typedef float f32x2 __attribute__((ext_vector_type(2)));
typedef unsigned u32x4 __attribute__((ext_vector_type(4)));
typedef unsigned u32x2 __attribute__((ext_vector_type(2)));

#ifndef PROBE_MASK
#define PROBE_MASK 0
#endif
#ifndef MK_CHECK_LAYER
#define MK_CHECK_LAYER 1
#endif
#ifndef NORM_NR
#define NORM_NR 4
#endif
#ifndef MERGE_N
#define MERGE_N 4
#define MERGE_MAP 0x3210
#endif
#ifndef PROBE_LOCMASK
#define PROBE_LOCMASK 15
#endif
#ifndef LOCMASK
#define LOCMASK 15
#endif
#ifndef PHMASK
#define PHMASK 0xffff
#endif
#define EN(j) (((PHMASK) >> (j)) & 1)
#ifndef MK_MULTI
#define ROLE_WID 4
#define MK_MULTI 0
#endif

constexpr int D = 2048, NB = 4, SEQ = 4096, DEPTH = 2, CTXL = 256, DFF = 5504;
constexpr int ML = NB * SEQ, MC = NB * CTXL, MT = ML + MC;
constexpr int NMOD = 9 * D, NIN = 11840, NZ = 11776, NZW = 12032, NGU = 2 * DFF;
constexpr int ZC_CQ = 2048, ZC_CKV = 2560, ZC_KR = 2816, ZC_QD = 2880, ZC_KD = 3392, ZC_G = 3584;
constexpr float EPS = 1e-6f;
constexpr float LOG2E = 1.4426950408889634f;

__device__ __forceinline__ unsigned f2bf(float f) { unsigned u = __builtin_bit_cast(unsigned, f); return (u + 0x7fffu + ((u >> 16) & 1u)) >> 16; }
__device__ __forceinline__ unsigned pk2(float lo, float hi) { return f2bf(lo) | (f2bf(hi) << 16); }
__device__ __forceinline__ float bflo(unsigned w) { return __builtin_bit_cast(float, w << 16); }
__device__ __forceinline__ float bfhi(unsigned w) { return __builtin_bit_cast(float, w & 0xffff0000u); }
__device__ __forceinline__ float bf2f(bf16_t h) { return __builtin_bit_cast(float, ((unsigned)h) << 16); }
__device__ __forceinline__ unsigned cvt_pk_bf16(float lo, float hi) { unsigned r; asm volatile("v_cvt_pk_bf16_f32 %0, %1, %2" : "=v"(r) : "v"(lo), "v"(hi)); return r; }
__device__ __forceinline__ float fast_exp2(float x) { return __builtin_amdgcn_exp2f(x); }
__device__ __forceinline__ float vmax(float a, float b) { float r; asm("v_max_f32 %0, %1, %2" : "=v"(r) : "v"(a), "v"(b)); return r; }
__device__ __forceinline__ float vmax3(float a, float b, float c) { float r; asm("v_max3_f32 %0, %1, %2, %3" : "=v"(r) : "v"(a), "v"(b), "v"(c)); return r; }
__device__ __forceinline__ float fast_rcp(float x) { return __builtin_amdgcn_rcpf(x); }
__device__ __forceinline__ float sigmoidf_(float x) { return fast_rcp(1.0f + fast_exp2(-x * LOG2E)); }
__device__ __forceinline__ int fresh_tid() { int t = threadIdx.x; asm volatile("" : "+v"(t)); return t; }
__device__ __forceinline__ float wave_sum(float v) {
#pragma unroll
    for (int o = 1; o < 64; o <<= 1) v += __shfl_xor(v, o);
    return v;
}
__device__ __forceinline__ float gelu1(float v) {
    const float av = __builtin_fabsf(v), t = fast_rcp(av * 0.2316418882f + 1.0f);
    float q = t * 0.5307027145f + (-0.7265760135f); q = q * t + 0.7107068705f; q = q * t + (-0.142248368f); q = q * t + 0.127414796f; q = q * t;
    const float e = fast_exp2((v * v) * (-0.72134752044f));
    const float m = v * (q * e);
    return v < 0.f ? m : v - m;
}

namespace pg8 {
constexpr int BM = 256, BK = 64, HALF = 128, HTB = HALF * BK * 2, STAGE_BYTES = 8 * HTB, NXCD = 8, WGM = 8;
__host__ __device__ __forceinline__ int lds_byte(int r, int c) { const int st = (r >> 4) * 2 + (c >> 5), rr = r & 15, cc = c & 31, ob = rr * 64 + cc * 2; return st * 1024 + (ob ^ (((ob >> 9) & 1) << 5)); }
__host__ __device__ __forceinline__ void stage_rc(int b, int& R, int& C) { const int st = b / 1024, sb = b % 1024, swz = sb ^ (((sb >> 9) & 1) << 5); R = (st >> 1) * 16 + swz / 64; C = (st & 1) * 32 + (swz % 64) / 2; }
__host__ __device__ __forceinline__ int perm32(int rho) { const int n = rho >> 4, i = rho & 15; return 8 * (i >> 2) + 4 * n + (i & 3); }

struct Unit { int pm, pn, sub; };
struct RectOrder {
    int nM, nN, nwg, G, c; const char* A; const char* B; unsigned tA, tB;
    __device__ __forceinline__ void init(int nM_, int nN_, int G_, int c_, int rot, const void* A_, unsigned tA_, const void* B_, unsigned tB_) { nM = nM_; nN = nN_; nwg = nM * nN; G = G_; c = (c_ + G_ - (rot % G_)) % G_; A = (const char*)A_; B = (const char*)B_; tA = tA_; tB = tB_; }
    __device__ __forceinline__ void tile_of(int wgid, Unit& u) const {
        { const int q = nwg / NXCD, r = nwg % NXCD, xcd = wgid % NXCD, off = wgid / NXCD; wgid = (xcd < r ? xcd * (q + 1) : r * (q + 1) + (xcd - r) * q) + off; }
        const int nig = WGM * nN, gid = wgid / nig, fm = gid * WGM, gsz = (nM - fm) < WGM ? (nM - fm) : WGM;
        u.pm = fm + ((wgid % nig) % gsz); u.pn = (wgid % nig) / gsz;
    }
    __device__ __forceinline__ bool next(int i, Unit& u) const { const long L = (long)i * G + c; if (L >= nwg) return false; tile_of((int)L, u); u.sub = 0; return true; }
    __device__ __forceinline__ const char* aptr(const Unit& u) const { return A + (size_t)u.pm * tA; }
    __device__ __forceinline__ const char* bptr(const Unit& u) const { return B + (size_t)u.pn * tB; }
};
struct SplitOrder {
    int pm, pn, part; bool have; const char* A; const char* B;
    __device__ __forceinline__ bool next(int i, Unit& u) const { if (i > 0 || !have) return false; u.pm = pm; u.pn = pn; u.sub = part; return true; }
    __device__ __forceinline__ const char* aptr(const Unit&) const { return A; }
    __device__ __forceinline__ const char* bptr(const Unit&) const { return B; }
};
struct ChainOrder : RectOrder {
    int nsub, map; size_t sA, sB;
    __device__ __forceinline__ bool next(int i, Unit& u) const { const int su = i / nsub; const long L = (long)su * G + c; if (L >= nwg) return false; tile_of((int)L, u); u.sub = i - su * nsub; return true; }
    __device__ __forceinline__ const char* aptr(const Unit& u) const { return A + (size_t)u.pm * tA + (size_t)((map >> (4 * u.sub)) & 15) * sA; }
    __device__ __forceinline__ const char* bptr(const Unit& u) const { return B + (size_t)u.pn * tB + (size_t)((map >> (4 * u.sub)) & 15) * sB; }
};

template <class Epi, class Sched, bool ALIGN_EPI, bool HALFN = false>
__device__ __forceinline__ void gemm_phase(LAS unsigned char* lds, const int K, const int lda, const int ldb, const Sched& S, const Epi& E) {
    const int tid = fresh_tid(), wid = __builtin_amdgcn_readfirstlane(tid >> 6), lane = tid & 63, wr = wid >> 2, wc = wid & 3, fr = lane & 15, fq = lane >> 4;
    const int nt = K / BK;
    unsigned voffA[2], voffB[2];
#pragma unroll
    for (int i = 0; i < 2; ++i) { int R, C; stage_rc(tid * 16 + i * 8192, R, C); const int Rb = Epi::PERM ? ((R & ~31) + perm32(R & 31)) : R;
        voffA[i] = (unsigned)(R * lda + C) * 2u; voffB[i] = (unsigned)(Rb * ldb + C) * 2u; }
    const size_t kstep = (size_t)(BK * 2);
    const size_t hstepA = (size_t)HALF * lda * 2, hstepB = (size_t)HALF * ldb * 2;
    const unsigned ldsw = (unsigned)wid * 1024u;
    const int aoff = lds_byte(wr * 64 + fr, fq * 8), boff = lds_byte(wc * 32 + fr, fq * 8);
#define PG8_SA(b, h) (((b) * 2 + (h)) * HTB)
#define PG8_SB(b, h) ((4 + (b) * 2 + (h)) * HTB)
#define PG8_STAGE(bufoff, gbase, voff) do { _Pragma("unroll") for (int _i = 0; _i < 2; ++_i) \
        __builtin_amdgcn_global_load_lds((const unsigned*)((const char*)(gbase) + (voff)[_i]), (LAS unsigned*)(lds + (bufoff) + ldsw + _i * 8192), 16, 0, 0); } while (0)
#define PG8_LDA(dst, b, h) do { _Pragma("unroll") for (int m = 0; m < 4; ++m) _Pragma("unroll") for (int k = 0; k < 2; ++k) dst[m][k] = *(const LAS bf16x8*)(lds + PG8_SA(b, h) + aoff + m * 2048 + k * 1024); } while (0)
#define PG8_LDB(dst, b, h) do { _Pragma("unroll") for (int n = 0; n < 2; ++n) _Pragma("unroll") for (int k = 0; k < 2; ++k) dst[n][k] = *(const LAS bf16x8*)(lds + PG8_SB(b, h) + boff + n * 2048 + k * 1024); } while (0)
#define PG8_MMA(ai, bj, At, Bt) do { __builtin_amdgcn_s_setprio(1); _Pragma("unroll") for (int m = 0; m < 4; ++m) _Pragma("unroll") for (int n = 0; n < 2; ++n) _Pragma("unroll") for (int k = 0; k < 2; ++k) \
        acc[ai][bj][m][n] = __builtin_amdgcn_mfma_f32_16x16x32_bf16(Bt[n][k], At[m][k], acc[ai][bj][m][n], 0, 0, 0); __builtin_amdgcn_s_setprio(0); } while (0)
#define PG8_WAIT_V(n) asm volatile("s_waitcnt vmcnt(" #n ")" ::: "memory")
#define PG8_WAIT_L(n) asm volatile("s_waitcnt lgkmcnt(" #n ")" ::: "memory")
#define PG8_WAIT_VH do { if constexpr (HALFN) PG8_WAIT_V(6); else PG8_WAIT_V(8); } while (0)
#define PG8_BAR __builtin_amdgcn_s_barrier()
#define PG8_SCHED __builtin_amdgcn_sched_barrier(0)
    Unit cur, nxt; int ui = 0;
    if (!S.next(0, cur)) return;
    f32x4 acc[2][2][4][2];
#pragma unroll
    for (int a = 0; a < 2; ++a)
#pragma unroll
        for (int b = 0; b < 2; ++b)
#pragma unroll
            for (int m = 0; m < 4; ++m)
#pragma unroll
                for (int n = 0; n < 2; ++n) acc[a][b][m][n] = (f32x4){0.f, 0.f, 0.f, 0.f};
    bf16x8 At[4][2], B0[2][2], B1[2][2];
    const char* cA = S.aptr(cur); const char* cB = S.bptr(cur);
    PG8_STAGE(PG8_SB(0, 0), cB, voffB); if constexpr (!HALFN) PG8_STAGE(PG8_SB(0, 1), cB + hstepB, voffB); PG8_STAGE(PG8_SA(0, 0), cA, voffA); PG8_STAGE(PG8_SA(0, 1), cA + hstepA, voffA);
    if (wr == 1) PG8_BAR;
    PG8_WAIT_V(2); PG8_BAR;
    PG8_STAGE(PG8_SB(1, 0), cB + kstep, voffB); PG8_STAGE(PG8_SA(1, 0), cA + kstep, voffA); if constexpr (!HALFN) PG8_STAGE(PG8_SB(1, 1), cB + hstepB + kstep, voffB);
    if constexpr (HALFN) PG8_WAIT_V(4); else PG8_WAIT_V(6);
    PG8_BAR;
    for (;;) {
        const bool has_next = S.next(ui + 1, nxt);
        const char* nA = has_next ? S.aptr(nxt) : cA; const char* nB = has_next ? S.bptr(nxt) : cB;
#pragma unroll 1
        for (int t = 0; t < nt; t += 2) {
            const bool last = (t == nt - 2);
            const char* a1 = cA + (size_t)(t + 1) * kstep;
            const char* a2 = last ? nA : cA + (size_t)(t + 2) * kstep; const char* b2 = last ? nB : cB + (size_t)(t + 2) * kstep;
            const char* a3 = a2 + kstep; const char* b3 = b2 + kstep;
            PG8_LDB(B0, 0, 0); if constexpr (!HALFN) PG8_LDB(B1, 0, 1); PG8_SCHED; PG8_LDA(At, 0, 0); PG8_STAGE(PG8_SA(1, 1), a1 + hstepA, voffA);
            PG8_WAIT_VH; PG8_WAIT_L(0); PG8_BAR; PG8_MMA(0, 0, At, B0); if constexpr (!HALFN) PG8_MMA(0, 1, At, B1); PG8_BAR; PG8_SCHED;
            PG8_LDA(At, 0, 1); PG8_STAGE(PG8_SB(0, 0), b2, voffB); if constexpr (!HALFN) PG8_STAGE(PG8_SB(0, 1), b2 + hstepB, voffB); PG8_STAGE(PG8_SA(0, 0), a2, voffA);
            PG8_WAIT_VH; PG8_WAIT_L(0); PG8_BAR; PG8_MMA(1, 0, At, B0); if constexpr (!HALFN) PG8_MMA(1, 1, At, B1); PG8_BAR; PG8_SCHED;
            PG8_LDB(B0, 1, 0); if constexpr (!HALFN) PG8_LDB(B1, 1, 1); PG8_SCHED; PG8_LDA(At, 1, 0); PG8_STAGE(PG8_SA(0, 1), a2 + hstepA, voffA);
            PG8_WAIT_VH; PG8_WAIT_L(0); PG8_BAR; PG8_MMA(0, 0, At, B0); if constexpr (!HALFN) PG8_MMA(0, 1, At, B1); PG8_BAR; PG8_SCHED;
            PG8_LDA(At, 1, 1); PG8_STAGE(PG8_SB(1, 0), b3, voffB); if constexpr (!HALFN) PG8_STAGE(PG8_SB(1, 1), b3 + hstepB, voffB); PG8_STAGE(PG8_SA(1, 0), a3, voffA);
            PG8_WAIT_VH; PG8_WAIT_L(0); PG8_BAR; PG8_MMA(1, 0, At, B0); if constexpr (!HALFN) PG8_MMA(1, 1, At, B1); PG8_BAR; PG8_SCHED;
        }
        if constexpr (ALIGN_EPI) { if (wr == 0) PG8_BAR; }
        const bool keep = E(acc, cur, wr, wc, fr, fq);
        if (!has_next) break;
        if (!keep) {
#pragma unroll
        for (int a = 0; a < 2; ++a)
#pragma unroll
            for (int b = 0; b < 2; ++b)
#pragma unroll
                for (int m = 0; m < 4; ++m)
#pragma unroll
                    for (int n = 0; n < 2; ++n) acc[a][b][m][n] = (f32x4){0.f, 0.f, 0.f, 0.f};
        }
        cur = nxt; cA = nA; cB = nB; ++ui;
        if constexpr (ALIGN_EPI) { if (wr == 1) PG8_BAR; }
    }
    PG8_WAIT_V(0);
    if constexpr (!ALIGN_EPI) { if (wr == 0) PG8_BAR; }
    PG8_BAR;
#undef PG8_SA
#undef PG8_SB
#undef PG8_STAGE
#undef PG8_LDA
#undef PG8_LDB
#undef PG8_MMA
#undef PG8_WAIT_V
#undef PG8_WAIT_L
#undef PG8_WAIT_VH
#undef PG8_BAR
#undef PG8_SCHED
}
}

constexpr size_t MiB = 1u << 20;
constexpr size_t WS_CTL = 0, CTL_ZERO_BYTES = 1 * MiB;
constexpr size_t WS_MOD = 1 * MiB;
constexpr size_t WS_TAB = 2 * MiB;
constexpr size_t WS_SSP = 2 * MiB + 65536;
constexpr size_t WS_XC = 3 * MiB;
constexpr size_t WS_H = 11 * MiB;
constexpr size_t WS_Y = 79 * MiB;
constexpr size_t WS_HB = 147 * MiB;
constexpr size_t WS_YBR = 164 * MiB;
constexpr size_t WS_QM = 232 * MiB;
constexpr size_t WS_KN = 258 * MiB;
constexpr size_t WS_VTM = 275 * MiB;
constexpr size_t WS_Z = 292 * MiB;
constexpr size_t WS_W = 692 * MiB;
constexpr size_t WL_GU = 0, WL_D = 86 * MiB, WL_IN = 129 * MiB, WL_UQ = 176 * MiB, WL_KV = 177 * MiB, WL_BR = 178 * MiB, WL_OUT = 186 * MiB, WL_GMW = 194 * MiB, WL_BZ = 194 * MiB + 262144, WL_SIZE = 195 * MiB;
constexpr size_t WS_VTD = WS_W + DEPTH * WL_SIZE;
constexpr size_t WS_XB = WS_VTD + 9 * MiB;
constexpr size_t WS_END = WS_XB + 68 * MiB;
static_assert(WS_SSP + (size_t)MT * 12 * 4 <= WS_XC && WS_XC + (size_t)MC * D * 4 <= WS_H && WS_H + (size_t)MT * D * 2 <= WS_Y && WS_Y + (size_t)MT * D * 2 <= WS_HB, "ws map 1");
static_assert(WS_HB + (size_t)MT * 512 * 2 <= WS_YBR && WS_YBR + (size_t)4 * MT * 512 * 2 <= WS_QM && WS_QM + (size_t)MT * 768 * 2 <= WS_KN && WS_KN + (size_t)MT * 512 * 2 <= WS_VTM && WS_VTM + (size_t)512 * MT * 2 <= WS_Z && WS_Z + (size_t)MT * NZ * 2 <= WS_W, "ws map 2");
static_assert((size_t)2 * NGU * D * 2 <= WL_D && WL_D + (size_t)2 * D * DFF * 2 <= WL_IN && WL_IN + (size_t)NZW * D * 2 <= WL_UQ && WL_UQ + 768 * 512 * 2 <= WL_KV && WL_KV + 1024 * 256 * 2 <= WL_BR && WL_BR + (size_t)4 * D * 512 * 2 <= WL_OUT && WL_OUT + (size_t)D * D * 2 <= WL_GMW && WL_GMW + 4 * 128 * 128 * 2 <= WL_BZ && WL_BZ + NZW * 4 <= WL_SIZE, "weight map");
static_assert((size_t)DEPTH * 5 * NMOD * 4 <= 1 * MiB, "mod");
constexpr int CW_BAR = 4096;

constexpr int RING_BYTES = 131072, MISC_OFF = RING_BYTES + 320, LTAB_OFF = RING_BYTES + 2048  , LDS_BYTES = 147456;

#define XB_TMO      128
#define XB_XCNT(j)  (256  + 64 * (j))
#define XB_XSUB(j)  (1280 + 64 * (j))
#define XB_XGEN(j)  (2304 + 64 * (j))
#define XB_TOP      3328
#define XB_TOPGEN   3392
#define XCD_BAR_WORDS 3456
#define XB_SPIN_CAP (1u << 20)
__device__ __forceinline__ unsigned xb_ld(unsigned* p)              { return __hip_atomic_load(p, __ATOMIC_RELAXED, __HIP_MEMORY_SCOPE_AGENT); }
__device__ __forceinline__ unsigned xb_add(unsigned* p, unsigned v) { return __hip_atomic_fetch_add(p, v, __ATOMIC_RELAXED, __HIP_MEMORY_SCOPE_AGENT); }
__device__ __forceinline__ unsigned xb_xcc_id() { return (unsigned)__builtin_amdgcn_s_getreg((3 << 11) | 20) & 0xFu; }
#define XB_SPIN(cond, bar) do { unsigned _sp = 0; while (cond) { __builtin_amdgcn_s_sleep(1); \
    if ((++_sp & 255u) == 0u) { if (xb_ld(&(bar)[XB_TMO])) break; if (_sp > XB_SPIN_CAP) { atomicAdd(&(bar)[XB_TMO], 1u); break; } } } } while (0)
struct XcdBarrier { unsigned* bar; unsigned x; volatile LAS unsigned* st; };
__device__ __forceinline__ XcdBarrier xcd_barrier_post(unsigned* bar, volatile LAS unsigned* st) {
    XcdBarrier b; b.bar = bar; b.x = xb_xcc_id(); b.st = st;
    if (threadIdx.x == 0) (void)xb_add(&bar[XB_XCNT(b.x)], 1u);
    return b;
}
__device__ __forceinline__ void xcd_barrier_complete(unsigned* bar, unsigned x, unsigned& nloc, unsigned& nx) {
    const unsigned G = gridDim.x * gridDim.y * gridDim.z;
    unsigned sum, cnt, mine, sp = 0u;
    for (;;) {
        sum = 0u; cnt = 0u; mine = 0u;
#pragma unroll
        for (unsigned j = 0; j < 16; ++j) { const unsigned c = xb_ld(&bar[XB_XCNT(j)]); sum += c; cnt += (c > 0u) ? 1u : 0u; mine = (j == x) ? c : mine; }
        if (sum == G) break;
        __builtin_amdgcn_s_sleep(1);
        if ((++sp & 255u) == 0u) { if (xb_ld(&bar[XB_TMO])) break; if (sp > XB_SPIN_CAP) { atomicAdd(&bar[XB_TMO], 1u); break; } }
    }
    nloc = mine > 0u ? mine : 1u; nx = cnt > 0u ? cnt : 1u;
}
__device__ __forceinline__ void xcd_barrier(const XcdBarrier& b) {
    asm volatile("s_waitcnt vmcnt(0)" ::: "memory");
    __syncthreads();
    if (threadIdx.x == 0) {
        unsigned* bar = b.bar;
        __builtin_amdgcn_s_waitcnt(0);
        unsigned nloc = b.st[0], nx = b.st[1];
        if (nloc == 0u) { xcd_barrier_complete(bar, b.x, nloc, nx); b.st[0] = nloc; b.st[1] = nx; }
        const unsigned old = xb_add(&bar[XB_XSUB(b.x)], 1u);
        const unsigned gen = old / nloc;
        if (old + 1u == (gen + 1u) * nloc) {
            __builtin_amdgcn_fence(__ATOMIC_RELEASE, "agent");
            asm volatile("s_waitcnt vmcnt(0)" ::: "memory");
            const unsigned og = xb_add(&bar[XB_TOP], 1u);
            const unsigned tg = og / nx;
            if (og + 1u == (tg + 1u) * nx) xb_add(&bar[XB_TOPGEN], 1u);
            else XB_SPIN(xb_ld(&bar[XB_TOPGEN]) == tg, bar);
            __builtin_amdgcn_fence(__ATOMIC_ACQUIRE, "agent");
            xb_add(&bar[XB_XGEN(b.x)], 1u);
            asm volatile("s_waitcnt vmcnt(0)" ::: "memory");
        } else {
            XB_SPIN(xb_ld(&bar[XB_XGEN(b.x)]) == gen, bar);
            __builtin_amdgcn_fence(__ATOMIC_ACQUIRE, "agent");
            asm volatile("s_waitcnt vmcnt(0)" ::: "memory");
        }
    }
    __syncthreads();
}

constexpr int RING_BYTES_C = 131072;
struct Params { const float* in[28]; float* out; unsigned char* ws; int ph_lo, ph_hi; };
enum { I_X = 0, I_C, I_CTX, I_CCTX, I_WMOD, I_BMOD, I_NPRE, I_NPOST, I_WG, I_WU, I_WD, I_WIN, I_BIN, I_GMLNG, I_GMLNB, I_GMWS, I_GMBS, I_CVDW, I_CVDB, I_CVLNG, I_CVLNB, I_QNORM, I_KVNORM, I_WUQ, I_WUKV, I_SINK, I_WBR, I_WOUT };

constexpr int PTAB_OFF = RING_BYTES_C + 1024;
struct Ctx { volatile LAS unsigned* tab;
    __device__ __forceinline__ unsigned long long get(int i) const { const unsigned lo = __builtin_amdgcn_readfirstlane(tab[2 * i]), hi = __builtin_amdgcn_readfirstlane(tab[2 * i + 1]); return ((unsigned long long)hi << 32) | lo; }
    __device__ __forceinline__ const float* in(int i) const { return (const float*)(const GAS float*)get(i); }
    __device__ __forceinline__ float* out() const { return (float*)(GAS float*)get(28); }
    __device__ __forceinline__ unsigned char* ws() const { return (unsigned char*)(GAS unsigned char*)get(29); }
};
#define WSP(T, off) ((T*)(ws + (off)))
#define WLP(T, l, off) ((T*)(ws + WS_W + (size_t)(l) * WL_SIZE + (off)))

namespace pg8 {
struct EpiSwiglu { static constexpr bool PERM = true; bf16_t* O;
    __device__ __forceinline__ bool operator()(f32x4 (&acc)[2][2][4][2], const Unit& u, int wr, int wc, int fr, int fq) const {
        const int row0 = u.pm * BM + wr * 64 + fr, col0 = u.pn * HALF + wc * 32 + 8 * fq;
#pragma unroll
        for (int ai = 0; ai < 2; ++ai)
#pragma unroll
            for (int m = 0; m < 4; ++m) { bf16_t* rowp = O + (size_t)(row0 + ai * HALF + m * 16) * DFF + col0; float v[8];
#pragma unroll
                for (int n = 0; n < 2; ++n)
#pragma unroll
                    for (int i = 0; i < 4; ++i) { const float g = acc[ai][0][m][n][i], up = acc[ai][1][m][n][i]; v[4 * n + i] = g * sigmoidf_(g) * up; }
                u32x4 w; w.x = cvt_pk_bf16(v[0], v[1]); w.y = cvt_pk_bf16(v[2], v[3]); w.z = cvt_pk_bf16(v[4], v[5]); w.w = cvt_pk_bf16(v[6], v[7]);
                *(u32x4*)rowp = w; }
        return false;
    }
};
template <bool RS> struct EpiPlain { static constexpr bool PERM = true; bf16_t* O; int ldc; const float* ssp;
    __device__ __forceinline__ bool operator()(f32x4 (&acc)[2][2][4][2], const Unit& u, int wr, int wc, int fr, int fq) const {
        const int row0 = u.pm * BM + wr * 64 + fr, col0 = u.pn * BM + wc * 32 + 8 * fq;
        f32x4 pr[2][4];
        if (RS) {
#pragma unroll
            for (int ai = 0; ai < 2; ++ai)
#pragma unroll
                for (int m = 0; m < 4; ++m) pr[ai][m] = *(const f32x4*)(ssp + (size_t)(row0 + ai * HALF + m * 16) * 12 + 8);
            __builtin_amdgcn_sched_barrier(0);
        }
#pragma unroll
        for (int ai = 0; ai < 2; ++ai)
#pragma unroll
            for (int m = 0; m < 4; ++m) { const int row = row0 + ai * HALF + m * 16; bf16_t* rowp = O + (size_t)row * ldc + col0; float sc = 1.f;
                if (RS) { const f32x4 p = pr[ai][m]; sc = __builtin_amdgcn_rsqf(((p[0] + p[1]) + (p[2] + p[3])) * (1.f / 256.f) + EPS); }
#pragma unroll
                for (int bj = 0; bj < 2; ++bj) { const f32x4 v0 = acc[ai][bj][m][0] * sc, v1 = acc[ai][bj][m][1] * sc;
                    u32x4 w; w.x = cvt_pk_bf16(v0[0], v0[1]); w.y = cvt_pk_bf16(v0[2], v0[3]); w.z = cvt_pk_bf16(v1[0], v1[1]); w.w = cvt_pk_bf16(v1[2], v1[3]);
                    *(u32x4*)(rowp + bj * HALF) = w; } }
        return false;
    }
};
struct EpiPartial { static constexpr bool PERM = false; float* P; int row_base; size_t pstride;
    __device__ __forceinline__ bool operator()(f32x4 (&acc)[2][2][4][2], const Unit& u, int wr, int wc, int fr, int fq) const {
        const int row0 = u.pm * BM - row_base + wr * 64 + fr, col0 = u.pn * BM + wc * 32 + 4 * fq; float* base = P + (size_t)u.sub * pstride;
#pragma unroll
        for (int ai = 0; ai < 2; ++ai)
#pragma unroll
            for (int m = 0; m < 4; ++m) { float* rowp = base + (size_t)(row0 + ai * HALF + m * 16) * D + col0;
#pragma unroll
                for (int bj = 0; bj < 2; ++bj)
#pragma unroll
                    for (int n = 0; n < 2; ++n) *(f32x4*)(rowp + bj * HALF + n * 16) = acc[ai][bj][m][n]; }
        return false;
    }
};
__device__ __forceinline__ void rope4(f32x4& v0, f32x4& v1, const LAS float* tab) {
    const f32x4 t0 = *(const LAS f32x4*)tab, t1 = *(const LAS f32x4*)(tab + 4);
    const float c[4] = {t0[0], t0[2], t1[0], t1[2]}, s[4] = {t0[1], t0[3], t1[1], t1[3]};
#pragma unroll
    for (int i = 0; i < 4; ++i) { const float a = v0[i], b = v1[i]; v0[i] = a * c[i] - b * s[i]; v1[i] = b * c[i] + a * s[i]; }
}
struct EpiQ { static constexpr bool PERM = true; bf16_t* O; const float* ssp; const LAS float* tab;
    __device__ __forceinline__ bool operator()(f32x4 (&acc)[2][2][4][2], const Unit& u, int wr, int wc, int fr, int fq) const {
        const int row0 = u.pm * BM + wr * 64 + fr, col0 = u.pn * BM + wc * 32 + 8 * fq;
        const float qs = 0.07216878364870322f * LOG2E;
#pragma unroll
        for (int ai = 0; ai < 2; ++ai) {
        f32x4 pr0[4], pr1[4];
#pragma unroll
        for (int m = 0; m < 4; ++m) { const size_t ro = (size_t)(row0 + ai * HALF + m * 16) * 12; pr0[m] = *(const f32x4*)(ssp + ro); pr1[m] = *(const f32x4*)(ssp + ro + 4); }
        __builtin_amdgcn_sched_barrier(0);
#pragma unroll
            for (int m = 0; m < 4; ++m) { const int row = row0 + ai * HALF + m * 16; bf16_t* rowp = O + (size_t)row * 768 + col0;
                const f32x4 p0 = pr0[m], p1 = pr1[m];
                const float sc = __builtin_amdgcn_rsqf((((p0[0] + p0[1]) + (p0[2] + p0[3])) + ((p1[0] + p1[1]) + (p1[2] + p1[3]))) * (1.f / 512.f) + EPS) * qs;
                const int t = row & (SEQ - 1); const bool lat = row < ML;
#pragma unroll
                for (int bj = 0; bj < 2; ++bj) { const int grp = (u.pn * 8 + bj * 4 + wc) % 6;
                    f32x4 v0 = acc[ai][bj][m][0] * sc, v1 = acc[ai][bj][m][1] * sc;
                    if (grp >= 4 && lat) { const int pos = (grp == 4) ? (t >> 6) : (t & 63); rope4(v0, v1, tab + (pos * 16 + 4 * fq) * 2); }
                    u32x4 w; w.x = cvt_pk_bf16(v0[0], v0[1]); w.y = cvt_pk_bf16(v0[2], v0[3]); w.z = cvt_pk_bf16(v1[0], v1[1]); w.w = cvt_pk_bf16(v1[2], v1[3]);
                    *(u32x4*)(rowp + bj * HALF) = w; } }
        __builtin_amdgcn_sched_barrier(0); }
        return false;
    }
};
struct EpiZ { static constexpr bool PERM = true; bf16_t* Z; bf16_t* HB; float* ssp; const float* bias; const LAS float* tab; int pn_off, row_base;
    __device__ __forceinline__ bool operator()(f32x4 (&acc)[2][2][4][2], const Unit& u, int wr, int wc, int fr, int fq) const {
        const int pn = u.pn + pn_off;
        const int row0 = row_base + u.pm * BM + wr * 64 + fr, col0 = pn * BM + wc * 32 + 8 * fq;
        f32x4 bv[2][2];
#pragma unroll
        for (int bj = 0; bj < 2; ++bj)
#pragma unroll
            for (int n = 0; n < 2; ++n) bv[bj][n] = *(const f32x4*)(bias + col0 + bj * HALF + 4 * n);
        if (pn >= 4 && pn < 8) {
#pragma unroll
            for (int ai = 0; ai < 2; ++ai)
#pragma unroll
                for (int m = 0; m < 4; ++m) { bf16_t* rowp = HB + (size_t)(row0 + ai * HALF + m * 16) * 512 + (pn - 4) * HALF + wc * 32 + 8 * fq; float h[8];
#pragma unroll
                    for (int n = 0; n < 2; ++n) { const f32x4 a = acc[ai][0][m][n] + bv[0][n], gt = acc[ai][1][m][n] + bv[1][n];
#pragma unroll
                        for (int i = 0; i < 4; ++i) h[4 * n + i] = a[i] * sigmoidf_(gt[i]); }
                    u32x4 w; w.x = cvt_pk_bf16(h[0], h[1]); w.y = cvt_pk_bf16(h[2], h[3]); w.z = cvt_pk_bf16(h[4], h[5]); w.w = cvt_pk_bf16(h[6], h[7]); *(u32x4*)rowp = w; }
        } else {
#pragma unroll
        for (int ai = 0; ai < 2; ++ai)
#pragma unroll
            for (int m = 0; m < 4; ++m) { const int row = row0 + ai * HALF + m * 16; bf16_t* rowp = Z + (size_t)row * NZ + col0; float ss = 0.f;
                const int t = row & (SEQ - 1); const bool lat = row < ML;
#pragma unroll
                for (int bj = 0; bj < 2; ++bj) { f32x4 v0 = acc[ai][bj][m][0] + bv[bj][0], v1 = acc[ai][bj][m][1] + bv[bj][1];
                    if (pn < 4) {
#pragma unroll
                        for (int i = 0; i < 4; ++i) { v0[i] = gelu1(v0[i]); v1[i] = gelu1(v1[i]); }
                    } else if (pn < 11) {
#pragma unroll
                        for (int i = 0; i < 4; ++i) ss += v0[i] * v0[i] + v1[i] * v1[i];
                    } else if (pn < 14) { const int grp = pn * 8 + bj * 4 + wc;
                        if (grp >= 88 && grp < 110 && lat) { const int pos = (grp & 1) ? (t & 63) : (t >> 6); rope4(v0, v1, tab + (pos * 16 + 4 * fq) * 2); }
                        if (grp >= 90 && grp < 106) { v0 = v0 * (0.125f * LOG2E); v1 = v1 * (0.125f * LOG2E); }
                    } else {
#pragma unroll
                        for (int i = 0; i < 4; ++i) { v0[i] = sigmoidf_(v0[i]); v1[i] = sigmoidf_(v1[i]); }
                    }
                    u32x4 w; w.x = cvt_pk_bf16(v0[0], v0[1]); w.y = cvt_pk_bf16(v0[2], v0[3]); w.z = cvt_pk_bf16(v1[0], v1[1]); w.w = cvt_pk_bf16(v1[2], v1[3]);
                    *(u32x4*)(rowp + bj * HALF) = w; }
                if (pn >= 8 && pn < 11) { ss += __shfl_xor(ss, 16); ss += __shfl_xor(ss, 32); ssp[(size_t)row * 12 + (pn - 8) * 4 + wc] = ss; } }
        }
        asm volatile("" :: "v"(bv[0][0]), "v"(bv[0][1]), "v"(bv[1][0]), "v"(bv[1][1]));
        return false;
    }
};
template <bool COLSCALE> struct EpiVt { static constexpr bool PERM = true; bf16_t* O; int ldc; const float* rbias; const float* ssp;
    __device__ __forceinline__ bool operator()(f32x4 (&acc)[2][2][4][2], const Unit& u, int wr, int wc, int fr, int fq) const {
        const int row0 = u.pm * BM + wr * 64 + fr, col0 = u.pn * BM + wc * 32 + 8 * fq;
        float sc[2][8];
        if (COLSCALE) {
#pragma unroll
            for (int bj = 0; bj < 2; ++bj) { f32x4 pc[8];
#pragma unroll
                for (int e = 0; e < 8; ++e) pc[e] = *(const f32x4*)(ssp + (size_t)(col0 + bj * HALF + e) * 12 + 8);
                __builtin_amdgcn_sched_barrier(0);
#pragma unroll
                for (int e = 0; e < 8; ++e) { const f32x4 p = pc[e]; sc[bj][e] = __builtin_amdgcn_rsqf(((p[0] + p[1]) + (p[2] + p[3])) * (1.f / 256.f) + EPS); }
                __builtin_amdgcn_sched_barrier(0); }
        } else {
#pragma unroll
            for (int bj = 0; bj < 2; ++bj)
#pragma unroll
                for (int e = 0; e < 8; ++e) sc[bj][e] = 1.f;
        }
        float rbv[2][4];
#pragma unroll
        for (int ai = 0; ai < 2; ++ai)
#pragma unroll
            for (int m = 0; m < 4; ++m) rbv[ai][m] = COLSCALE ? 0.f : rbias[row0 + ai * HALF + m * 16];
        __builtin_amdgcn_sched_barrier(0);
#pragma unroll
        for (int ai = 0; ai < 2; ++ai)
#pragma unroll
            for (int m = 0; m < 4; ++m) { const int row = row0 + ai * HALF + m * 16; bf16_t* rowp = O + (size_t)row * ldc + col0; const float rb = rbv[ai][m];
#pragma unroll
                for (int bj = 0; bj < 2; ++bj) { const f32x4 a0 = acc[ai][bj][m][0] + rb, a1 = acc[ai][bj][m][1] + rb;
                    u32x4 w; w.x = cvt_pk_bf16(a0[0] * sc[bj][0], a0[1] * sc[bj][1]); w.y = cvt_pk_bf16(a0[2] * sc[bj][2], a0[3] * sc[bj][3]); w.z = cvt_pk_bf16(a1[0] * sc[bj][4], a1[1] * sc[bj][5]); w.w = cvt_pk_bf16(a1[2] * sc[bj][6], a1[3] * sc[bj][7]);
                    *(u32x4*)(rowp + bj * HALF) = w; } }
        return false;
    }
};
struct EpiM1 { static constexpr bool PERM = true; const bf16_t* Z; bf16_t* T; int nlast, map;
    __device__ __forceinline__ void loadb(const bf16_t* sp, const bf16_t* sp2, int b, u32x4 (&s)[2][2], u32x4 (&s2)[2][2]) const {
#pragma unroll
        for (int mm = 0; mm < 2; ++mm)
#pragma unroll
            for (int bj = 0; bj < 2; ++bj) { const size_t ro = (size_t)((b >> 1) * HALF + (2 * (b & 1) + mm) * 16) * NZ + bj * HALF; s[mm][bj] = *(const u32x4*)(sp + ro); s2[mm][bj] = *(const u32x4*)(sp2 + ro); }
    }
    __device__ __forceinline__ bool operator()(f32x4 (&acc)[2][2][4][2], const Unit& u, int wr, int wc, int fr, int fq) const {
        const int row0 = u.pm * BM + wr * 64 + fr, col0 = u.pn * BM + wc * 32 + 8 * fq; const int sub = u.sub;
        const int br = (map >> (4 * sub)) & 15, br2 = (map >> (4 * sub + 4)) & 15; const bool mid = sub < nlast;
        const bf16_t* sp = Z + (size_t)row0 * NZ + ZC_G + br * D + col0; const bf16_t* sp2 = Z + (size_t)row0 * NZ + ZC_G + (mid ? br2 : br) * D + col0;
        u32x4 sA[2][2], s2A[2][2], sB[2][2], s2B[2][2];
        loadb(sp, sp2, 0, sA, s2A);
#pragma unroll
        for (int b = 0; b < 4; ++b) {
            if (b + 1 < 4) { if (b & 1) loadb(sp, sp2, b + 1, sA, s2A); else loadb(sp, sp2, b + 1, sB, s2B); }
            __builtin_amdgcn_sched_barrier(0);
            const int ai = b >> 1, mp = b & 1;
#pragma unroll
            for (int mm = 0; mm < 2; ++mm)
#pragma unroll
                for (int bj = 0; bj < 2; ++bj) { const int m = 2 * mp + mm; const u32x4 a = (b & 1) ? sB[mm][bj] : sA[mm][bj], c = (b & 1) ? s2B[mm][bj] : s2A[mm][bj];
                    float g[8] = {bflo(a.x), bfhi(a.x), bflo(a.y), bfhi(a.y), bflo(a.z), bfhi(a.z), bflo(a.w), bfhi(a.w)};
                    if (mid) { const float g2[8] = {bflo(c.x), bfhi(c.x), bflo(c.y), bfhi(c.y), bflo(c.z), bfhi(c.z), bflo(c.w), bfhi(c.w)};
#pragma unroll
                        for (int i = 0; i < 8; ++i) g[i] = g[i] * fast_rcp(__builtin_fmaxf(g2[i], 1e-30f));
#pragma unroll
                        for (int i = 0; i < 4; ++i) { acc[ai][bj][m][0][i] *= g[i]; acc[ai][bj][m][1][i] *= g[4 + i]; }
                    } else { f32x4 v0, v1; asm volatile("" :: "v"(c));
#pragma unroll
                        for (int i = 0; i < 4; ++i) { v0[i] = acc[ai][bj][m][0][i] * g[i]; v1[i] = acc[ai][bj][m][1][i] * g[4 + i]; }
                        u32x4 w; w.x = cvt_pk_bf16(v0[0], v0[1]); w.y = cvt_pk_bf16(v0[2], v0[3]); w.z = cvt_pk_bf16(v1[0], v1[1]); w.w = cvt_pk_bf16(v1[2], v1[3]);
                        *(u32x4*)(T + (size_t)(row0 + ai * HALF + m * 16) * D + col0 + bj * HALF) = w; } }
            __builtin_amdgcn_sched_barrier(0);
        }
        return mid;
    }
};
struct EpiM1H { static constexpr bool PERM = true; const bf16_t* Z; bf16_t* T; int nlast, map;
    __device__ __forceinline__ bool operator()(f32x4 (&acc)[2][2][4][2], const Unit& u, int wr, int wc, int fr, int fq) const {
        const int row0 = u.pm * BM + wr * 64 + fr, col0 = u.pn * HALF + wc * 32 + 8 * fq; const int sub = u.sub; const int br = (map >> (4 * sub)) & 15;
        const bf16_t* sp = Z + (size_t)row0 * NZ + ZC_G + br * D + col0;
        u32x4 s[2][4];
#pragma unroll
        for (int ai = 0; ai < 2; ++ai)
#pragma unroll
            for (int m = 0; m < 4; ++m) s[ai][m] = *(const u32x4*)(sp + (size_t)(ai * HALF + m * 16) * NZ);
        __builtin_amdgcn_sched_barrier(0);
#pragma unroll
        for (int ai = 0; ai < 2; ++ai)
#pragma unroll
            for (int m = 0; m < 4; ++m) { const u32x4 a = s[ai][m];
                const f32x4 g0 = (f32x4){bflo(a.x), bfhi(a.x), bflo(a.y), bfhi(a.y)}, g1 = (f32x4){bflo(a.z), bfhi(a.z), bflo(a.w), bfhi(a.w)};
                acc[ai][1][m][0] += g0 * acc[ai][0][m][0]; acc[ai][1][m][1] += g1 * acc[ai][0][m][1];
                acc[ai][0][m][0] = (f32x4){0.f, 0.f, 0.f, 0.f}; acc[ai][0][m][1] = (f32x4){0.f, 0.f, 0.f, 0.f};
                if (sub == nlast) { const f32x4 v0 = acc[ai][1][m][0], v1 = acc[ai][1][m][1];
                    u32x4 w; w.x = cvt_pk_bf16(v0[0], v0[1]); w.y = cvt_pk_bf16(v0[2], v0[3]); w.z = cvt_pk_bf16(v1[0], v1[1]); w.w = cvt_pk_bf16(v1[2], v1[3]);
                    *(u32x4*)(T + (size_t)(row0 + ai * HALF + m * 16) * D + col0) = w;
                    acc[ai][1][m][0] = (f32x4){0.f, 0.f, 0.f, 0.f}; acc[ai][1][m][1] = (f32x4){0.f, 0.f, 0.f, 0.f}; } }
        return true;
    }
};
}

#define LDS_WAIT() asm volatile("s_waitcnt lgkmcnt(0)" ::: "memory")
__device__ __forceinline__ void cvt_item(const float* W, int ldw, int srccol0, bf16_t* dst, int K, int k0, const float* kscale, LAS float* scr, int lane, bool perm) {
    const int sc8 = perm ? (((lane & 7) >> 1) + 4 * (lane & 1)) : (lane & 7);
    f32x4 v[8];
    float ksv[8];
#pragma unroll
    for (int i = 0; i < 8; ++i) ksv[i] = 1.f;
    if (kscale) {
#pragma unroll
        for (int i = 0; i < 8; ++i) ksv[i] = kscale[k0 + 8 * i + (lane >> 3)];
    }
    const int scc = srccol0 >= 0 ? srccol0 : 0; const float zf = srccol0 >= 0 ? 1.f : 0.f;
#pragma unroll
    for (int i = 0; i < 8; ++i) { const int kk = 8 * i + (lane >> 3);
        v[i] = __builtin_nontemporal_load((const f32x4*)(W + (size_t)(k0 + kk) * ldw + scc + sc8 * 4)); }
#pragma unroll
    for (int i = 0; i < 8; ++i) { const int kk = 8 * i + (lane >> 3); f32x4 x = v[i] * (zf * ksv[i]);
        LAS float* d = scr + kk * 33 + (lane & 7) * 4; d[0] = x[0]; d[1] = x[1]; d[2] = x[2]; d[3] = x[3]; }
    LDS_WAIT(); asm volatile("" ::: "memory");
    const int c = lane & 7;
#pragma unroll
    for (int j = 0; j < 4; ++j) { const int n = (lane >> 3) + 8 * j; const LAS float* s = scr + (8 * c) * 33 + n;
        u32x4 o; o.x = pk2(s[0 * 33], s[1 * 33]); o.y = pk2(s[2 * 33], s[3 * 33]); o.z = pk2(s[4 * 33], s[5 * 33]); o.w = pk2(s[6 * 33], s[7 * 33]);
        __builtin_nontemporal_store(o, (u32x4*)(dst + (size_t)n * K + k0 + 8 * c)); }
    LDS_WAIT(); asm volatile("" ::: "memory");
}
__device__ __forceinline__ int zsrc_col(int n) {
    if (n < 1024) return n;
    if (n < 2048) { const int t = (n - 1024) >> 8, j = (n - 1024) & 255; return j < 128 ? 1024 + 128 * t + j : 1536 + 128 * t + (j - 128); }
    if (n < 3520) return n;
    if (n < 3584) return -1;
    if (n < NZ) return n + 64;
    if (n < NZ + 128) return 3520 + (n - NZ);
    return -1;
}
constexpr int CV_GU = 2 * (NGU / 32) * (D / 64), CV_D = 2 * (D / 32) * (DFF / 64), CV_IN = (NZW / 32) * (D / 64), CV_UQ = (768 / 32) * (512 / 64), CV_KV = (1024 / 32) * (256 / 64),
              CV_BR = 4 * (D / 32) * (512 / 64), CV_OUT = (D / 32) * (D / 64), CV_LAYER = CV_GU + CV_D + CV_IN + CV_UQ + CV_KV + CV_BR + CV_OUT;
constexpr int CV_E0 = CV_GU / 2, CV_E1 = CV_E0 + CV_D / 2, CV_E2 = CV_E1 + CV_IN, CV_E3 = CV_E2 + CV_UQ, CV_E4 = CV_E3 + CV_KV, CV_E5 = CV_E4 + CV_BR, CV_E6 = CV_E5 + CV_OUT, CV_E7 = CV_E6 + CV_GU / 2, CV_E8 = CV_E7 + CV_D / 2;
static_assert(CV_E8 == CV_LAYER, "conversion item count");
constexpr int CW_QHEAD = 2048, CW_DONE = 2112;
__device__ __forceinline__ void cvt_item_idx(const Ctx& C, unsigned char* ws, int it, LAS float* scr, int lane) {
    const int l = it / CV_LAYER; int r = it - l * CV_LAYER;
    const float* W; int ldw, sc0, K, k0; bf16_t* dst; const float* ks = nullptr; bool perm = false;
    if (r < CV_E0 || (r >= CV_E6 && r < CV_E7)) { const int f = r >= CV_E6; if (f) r -= CV_E6; const int kb = r / (NGU / 32), nb = r - kb * (NGU / 32); const int n = nb * 32, tile = n >> 8, j = n & 255;
        W = (j < 128 ? C.in(I_WG) : C.in(I_WU)) + (size_t)(l * 2 + f) * D * DFF; ldw = DFF; sc0 = 128 * tile + (j & 127); dst = WLP(bf16_t, l, WL_GU) + ((size_t)f * NGU + n) * D; K = D; k0 = kb * 64; }
    else if (r < CV_E1 || r >= CV_E7) { const int f = r >= CV_E7; r -= f ? CV_E7 : CV_E0; const int kb = r / (D / 32), nb = r - kb * (D / 32);
        W = C.in(I_WD) + (size_t)(l * 2 + f) * DFF * D; ldw = D; sc0 = nb * 32; dst = WLP(bf16_t, l, WL_D) + ((size_t)f * D + nb * 32) * DFF; K = DFF; k0 = kb * 64; }
    else if (r < CV_E2) { r -= CV_E1; const int kb = r / (NZW / 32), nb = r - kb * (NZW / 32);
        W = C.in(I_WIN) + (size_t)l * D * NIN; ldw = NIN; sc0 = zsrc_col(nb * 32); perm = (nb >= ZC_KR / 32 && nb < 3520 / 32); dst = WLP(bf16_t, l, WL_IN) + (size_t)nb * 32 * D; K = D; k0 = kb * 64; }
    else if (r < CV_E3) { r -= CV_E2; const int kb = r / 24, nb = r - kb * 24;
        W = C.in(I_WUQ) + (size_t)l * 512 * 768; ldw = 768; sc0 = nb * 32; perm = (nb % 6) >= 4; dst = WLP(bf16_t, l, WL_UQ) + (size_t)nb * 32 * 512; K = 512; k0 = kb * 64; ks = C.in(I_QNORM) + l * 512; }
    else if (r < CV_E4) { r -= CV_E3; const int kb = r / 32, nb = r - kb * 32;
        W = C.in(I_WUKV) + (size_t)l * 256 * 1024; ldw = 1024; sc0 = (((nb * 32) & 511) >> 7) * 256 + ((nb * 32) >> 9) * 128 + ((nb * 32) & 127); dst = WLP(bf16_t, l, WL_KV) + (size_t)nb * 32 * 256; K = 256; k0 = kb * 64; ks = C.in(I_KVNORM) + l * 256; }
    else if (r < CV_E5) { r -= CV_E4; const int b = r / (CV_BR / 4); r -= b * (CV_BR / 4); const int kb = r / 64, nb = r - kb * 64;
        W = C.in(I_WBR) + (size_t)(l * 4 + b) * 512 * D; ldw = D; sc0 = nb * 32; dst = WLP(bf16_t, l, WL_BR) + ((size_t)b * D + nb * 32) * 512; K = 512; k0 = kb * 64; }
    else { r -= CV_E5; const int kb = r / 64, nb = r - kb * 64;
        W = C.in(I_WOUT) + (size_t)l * D * D; ldw = D; sc0 = nb * 32; dst = WLP(bf16_t, l, WL_OUT) + (size_t)nb * 32 * D; K = D; k0 = kb * 64; }
    cvt_item(W, ldw, sc0, dst, K, k0, ks, scr, lane, perm);
}
__device__ __forceinline__ void cvt_pull(const Ctx& C, LAS unsigned char* lds, int mand_end, int done_word  , int G) {
    const int tid = fresh_tid(), lane = tid & 63, wid = tid >> 6;
    volatile LAS unsigned* sh = (volatile LAS unsigned*)(lds + 8 * 8448);
    if (done_word && tid == 0) (void)__hip_atomic_fetch_add((unsigned*)(C.ws() + WS_CTL) + done_word, 1u, __ATOMIC_RELAXED, __HIP_MEMORY_SCOPE_AGENT);
    for (;;) {
        __syncthreads();
        if (tid == 0) { unsigned* const ctl = (unsigned*)(C.ws() + WS_CTL); const unsigned h = __hip_atomic_load(ctl + CW_QHEAD, __ATOMIC_RELAXED, __HIP_MEMORY_SCOPE_AGENT); bool go = false;
            if (h < (unsigned)(DEPTH * CV_LAYER)) { if (h < (unsigned)mand_end) go = true; else if (done_word && __hip_atomic_load(ctl + done_word, __ATOMIC_RELAXED, __HIP_MEMORY_SCOPE_AGENT) < (unsigned)G) go = true; }
            sh[0] = go ? __hip_atomic_fetch_add(ctl + CW_QHEAD, 16u, __ATOMIC_RELAXED, __HIP_MEMORY_SCOPE_AGENT) : 0xffffffffu; }
        __syncthreads();
        const unsigned base = sh[0];
        if (base == 0xffffffffu) break;
#pragma unroll 1
        for (int i = 0; i < 2; ++i) { const int it = (int)base + wid * 2 + i; if (it < DEPTH * CV_LAYER) cvt_item_idx(C, C.ws(), it, (LAS float*)(lds + wid * 8448), lane); }
    }
}
__device__ __forceinline__ void prologue_phase(const Ctx& C, LAS unsigned char* lds, int G, int bid) {
    unsigned char* const ws = C.ws();
    const int tid = fresh_tid(), lane = tid & 63, wid = tid >> 6;
    if (bid == 0) { float* tab = WSP(float, WS_TAB);
        for (int i = tid; i < 64 * 16; i += 512) { const int pos = i >> 4, f = i & 15; const float ang = (float)pos * exp2f(-(float)f * (13.287712379549449f / 16.f)); float s, c; sincosf(ang, &s, &c); tab[2 * i] = c; tab[2 * i + 1] = s; } }
    {
        LAS float* SC = (LAS float*)lds; LAS float* PART = (LAS float*)(lds + 40960);
        { const float* const cp = C.in(I_C); const float* const cc = C.in(I_CCTX); float xs[20];
#pragma unroll
          for (int j = 0; j < 20; ++j) { const int i = tid + 512 * j; xs[j] = j < 16 ? cp[i] : cc[i - 4 * D]; }
#pragma unroll
          for (int j = 0; j < 20; ++j) { const float x = xs[j]; SC[tid + 512 * j] = x / (1.f + expf(-x)); } }
        __syncthreads();
        const int kg = tid >> 3, ct = tid & 7;
        for (int it = bid; it < DEPTH * (NMOD / 32); it += G) { const int l = it / (NMOD / 32), ng = it - l * (NMOD / 32);
            const float* wp = C.in(I_WMOD) + ((size_t)l * D + kg * 32) * NMOD + ng * 32 + ct * 4;
            f32x4 a[5];
#pragma unroll
            for (int s = 0; s < 5; ++s) a[s] = (f32x4){0.f, 0.f, 0.f, 0.f};
#pragma unroll 1
            for (int k0 = 0; k0 < 32; k0 += 16) { f32x4 w[16];
#pragma unroll
                for (int kk = 0; kk < 16; ++kk) w[kk] = __builtin_nontemporal_load((const f32x4*)(wp + (size_t)(k0 + kk) * NMOD));
                __builtin_amdgcn_sched_barrier(0);
#pragma unroll
                for (int kk = 0; kk < 16; ++kk)
#pragma unroll
                    for (int s = 0; s < 5; ++s) a[s] += w[kk] * SC[s * D + kg * 32 + k0 + kk]; }
#pragma unroll
            for (int s = 0; s < 5; ++s) *(LAS f32x4*)(PART + (kg * 5 + s) * 32 + ct * 4) = a[s];
            __syncthreads();
            if (tid < 160) { const int s = tid >> 5, cc = tid & 31; float v = C.in(I_BMOD)[(size_t)l * NMOD + ng * 32 + cc];
                for (int k2 = 0; k2 < 64; ++k2) v += PART[(k2 * 5 + s) * 32 + cc];
                WSP(float, WS_MOD)[((size_t)l * 5 + s) * NMOD + ng * 32 + cc] = v; }
            __syncthreads();
        }
    }
    { const int gt = bid * 512 + tid, GT = G * 512;
        for (int i = gt; i < DEPTH * 65536; i += GT) { const int l = i >> 16; WLP(bf16_t, l, WL_GMW)[i & 65535] = (bf16_t)f2bf(C.in(I_GMWS)[i]); }
        for (int i = gt; i < DEPTH * NZW; i += GT) { const int l = i / NZW, n = i - l * NZW; int nn = n; if (n >= ZC_KR && n < 3520) { const int pp = n & 31; nn = (n & ~31) + 4 * (pp >> 3) + (pp & 3) + 16 * ((pp >> 2) & 1); }
            const int sc = zsrc_col(nn); WLP(float, l, WL_BZ)[n] = sc >= 0 ? C.in(I_BIN)[(size_t)l * NIN + sc] : 0.f; } }
    __syncthreads();
    cvt_pull(C, lds, CV_E0, 0, G);
}

struct NormArgs { const float* xin_lat; const float* xin_ctx; bf16_t* XB; float* outf; const bf16_t* Y; const float* part; bf16_t* H; bool store; };
#define NCOL(r, j) (col[j])
template <bool XF32> __device__ __forceinline__ void norm_row_load(const NormArgs& A, int r, const int (&col)[8], f32x4 (&x)[8], u32x2 (&xr)[8], u32x2 (&yr)[8]) {
    if (XF32) { const float* xi = r < ML ? A.xin_lat + (size_t)r * D : A.xin_ctx + (size_t)(r - ML) * D;
#pragma unroll
        for (int j = 0; j < 8; ++j) x[j] = __builtin_nontemporal_load((const f32x4*)(xi + NCOL(r, j)));
    } else {
#pragma unroll
        for (int j = 0; j < 8; ++j) xr[j] = __builtin_nontemporal_load((const u32x2*)(A.XB + (size_t)r * D + NCOL(r, j)));
    }
    if (A.Y && !(A.part && r >= ML)) {
#pragma unroll
        for (int j = 0; j < 8; ++j) yr[j] = __builtin_nontemporal_load((const u32x2*)(A.Y + (size_t)r * D + NCOL(r, j)));
    }
}
template <bool XF32> __device__ __forceinline__ void norm_row_compute(const NormArgs& A, const LAS float* V, int r, const int (&col)[8], const f32x4 (&xf)[8], const u32x2 (&xr)[8], u32x2 (&yr)[8]) {
    float rs = 0.f;
    if (A.Y) {
        if (A.part && r >= ML) {
#pragma unroll
            for (int j = 0; j < 8; ++j) { const float* pp = A.part + (size_t)(r - ML) * D + NCOL(r, j); f32x4 pq[8];
#pragma unroll
                for (int q = 0; q < 8; ++q) pq[q] = __builtin_nontemporal_load((const f32x4*)(pp + (size_t)q * MC * D));
                __builtin_amdgcn_sched_barrier(0);
                const f32x4 a = ((pq[0] + pq[1]) + (pq[2] + pq[3])) + ((pq[4] + pq[5]) + (pq[6] + pq[7]));
                yr[j].x = cvt_pk_bf16(a[0], a[1]); yr[j].y = cvt_pk_bf16(a[2], a[3]); }
        }
        float ss = 0.f;
#pragma unroll
        for (int j = 0; j < 8; ++j) { const float y0 = bflo(yr[j].x), y1 = bfhi(yr[j].x), y2 = bflo(yr[j].y), y3 = bfhi(yr[j].y); ss += (y0 * y0 + y1 * y1) + (y2 * y2 + y3 * y3); }
        rs = __builtin_amdgcn_rsqf(wave_sum(ss) * (1.f / D) + EPS);
    }
#define NORM_X(j) ((XF32 ? xf[j] : (f32x4){bflo(xr[j].x), bfhi(xr[j].x), bflo(xr[j].y), bfhi(xr[j].y)}) + (A.Y ? *(const LAS f32x4*)(V + NCOL(r, j)) * ((f32x4){bflo(yr[j].x), bfhi(yr[j].x), bflo(yr[j].y), bfhi(yr[j].y)} * rs) : (f32x4){0.f, 0.f, 0.f, 0.f}))
    float rx = 0.f;
    if (A.H) { float ss = 0.f;
#pragma unroll
        for (int j = 0; j < 8; ++j) { const f32x4 x = NORM_X(j); ss += (x[0] * x[0] + x[1] * x[1]) + (x[2] * x[2] + x[3] * x[3]); if (j & 1) __builtin_amdgcn_sched_barrier(0); }
        rx = __builtin_amdgcn_rsqf(wave_sum(ss) * (1.f / D) + EPS); }
#pragma unroll
    for (int j = 0; j < 8; ++j) { const f32x4 x = NORM_X(j);
        if (A.outf) __builtin_nontemporal_store(x, (f32x4*)(A.outf + (size_t)r * D + NCOL(r, j)));
        else if (A.store) { u32x2 w; w.x = cvt_pk_bf16(x[0], x[1]); w.y = cvt_pk_bf16(x[2], x[3]); __builtin_nontemporal_store(w, (u32x2*)(A.XB + (size_t)r * D + NCOL(r, j))); }
        if (A.H) { const f32x4 h = (x * rx) * *(const LAS f32x4*)(V + D + NCOL(r, j)) + *(const LAS f32x4*)(V + 2 * D + NCOL(r, j)); u32x2 w; w.x = cvt_pk_bf16(h[0], h[1]); w.y = cvt_pk_bf16(h[2], h[3]);
            *(u32x2*)(A.H + (size_t)r * D + NCOL(r, j)) = w; }
        if (j & 1) __builtin_amdgcn_sched_barrier(0); }
#undef NORM_X
}
template <bool XF32> __device__ __forceinline__ void norm_phase(LAS unsigned char* lds, int G, int bid, int rows, const float* xin_lat, const float* xin_ctx, bf16_t* XB, float* outf, bool store,
                                           const bf16_t* Y, const float* part  , const float* modg  , int kgate, float coef, const float* gpost,
                                           bf16_t* H, const float* modh  , int kshift, const float* gpre) {
    constexpr int NR = XF32 ? 2 : NORM_NR;
    const int tid = fresh_tid(), lane = tid & 63, wid = __builtin_amdgcn_readfirstlane(tid >> 6);
    asm volatile("" : "+s"(bid));
    float zf = 0.f; asm volatile("" : "+v"(zf));
    const NormArgs A{xin_lat, xin_ctx, XB, outf, Y, part, H, store};
    LAS float* V = (LAS float*)lds;
    int s_have = -1;
    for (int r0 = bid * 8 * NR; r0 < rows + (rows > ML ? 0 : 0); r0 += G * 8 * NR) {
        if (r0 >= ML) break;
        const int s = r0 >> 12;
        if (s != s_have) { __syncthreads();
            { const int c = 4 * fresh_tid(); f32x4 gg = (f32x4){zf, zf, zf, zf}, a = gg, b = gg;
              if (Y) gg = *(const f32x4*)(modg + (size_t)s * NMOD + kgate * D + c) * *(const f32x4*)(gpost + c) * coef;
              if (H) { a = *(const f32x4*)(gpre + c) * (*(const f32x4*)(modh + (size_t)s * NMOD + (kshift + 1) * D + c) + 1.f); b = *(const f32x4*)(modh + (size_t)s * NMOD + kshift * D + c); }
              *(LAS f32x4*)(V + c) = gg; *(LAS f32x4*)(V + D + c) = a; *(LAS f32x4*)(V + 2 * D + c) = b; }
            __syncthreads(); s_have = s; }
        int ln = lane; asm volatile("" : "+v"(ln)); int col[8];
_Pragma("unroll")
        for (int j = 0; j < 8; ++j) col[j] = 4 * ln + 256 * ((j + wid) & 7);
        f32x4 xf[XF32 ? NR : 1][8]; u32x2 xr[XF32 ? 1 : NR][8], yr[NR][8];
#pragma unroll
        for (int k = 0; k < NR; ++k)
#pragma unroll
            for (int j = 0; j < 8; ++j) { yr[k][j] = (u32x2){0u, 0u}; if (XF32) xf[k][j] = (f32x4){0.f, 0.f, 0.f, 0.f}; else xr[k][j] = (u32x2){0u, 0u}; }
#pragma unroll
        for (int k = 0; k < NR; ++k) norm_row_load<XF32>(A, r0 + wid + 8 * k, col, xf[XF32 ? k : 0], xr[XF32 ? 0 : k], yr[k]);
        __builtin_amdgcn_sched_barrier(0);
#pragma unroll
        for (int k = 0; k < NR; ++k) { norm_row_compute<XF32>(A, V, r0 + wid + 8 * k, col, xf[XF32 ? k : 0], xr[XF32 ? 0 : k], yr[k]); __builtin_amdgcn_sched_barrier(0); }
    }
    if (rows > ML) {
        for (int r0 = ML + bid * 8; r0 < rows; r0 += G * 8) {
            if (s_have != 4) { __syncthreads();
                { const int c = 4 * fresh_tid(); f32x4 gg = (f32x4){zf, zf, zf, zf}, a = gg, b = gg;
                  if (Y) gg = *(const f32x4*)(modg + (size_t)4 * NMOD + kgate * D + c) * *(const f32x4*)(gpost + c) * coef;
                  if (H) { a = *(const f32x4*)(gpre + c) * (*(const f32x4*)(modh + (size_t)4 * NMOD + (kshift + 1) * D + c) + 1.f); b = *(const f32x4*)(modh + (size_t)4 * NMOD + kshift * D + c); }
                  *(LAS f32x4*)(V + c) = gg; *(LAS f32x4*)(V + D + c) = a; *(LAS f32x4*)(V + 2 * D + c) = b; }
                __syncthreads(); s_have = 4; }
            int ln = lane; asm volatile("" : "+v"(ln)); int col[8];
_Pragma("unroll")
        for (int j = 0; j < 8; ++j) col[j] = 4 * ln + 256 * ((j + wid) & 7);
            f32x4 x[8]; u32x2 xr[8], yr[8];
#pragma unroll
            for (int j = 0; j < 8; ++j) { yr[j] = (u32x2){0u, 0u}; xr[j] = (u32x2){0u, 0u}; x[j] = (f32x4){0.f, 0.f, 0.f, 0.f}; }
            norm_row_load<XF32>(A, r0 + wid, col, x, xr, yr);
            norm_row_compute<XF32>(A, V, r0 + wid, col, x, xr, yr);
        }
    }
    __syncthreads();
}
#undef NCOL

__device__ __forceinline__ f32x4 mfma16(bf16x8 a, bf16x8 b, f32x4 c) { return __builtin_amdgcn_mfma_f32_16x16x32_bf16(a, b, c, 0, 0, 0); }
__device__ __forceinline__ void gmlp_chunk(const Ctx& C, int l, LAS unsigned char* lds, int R0, int g_lo) {
    unsigned char* const ws = C.ws();
    const bf16_t* Z = WSP(const bf16_t, WS_Z); bf16_t* YA = WSP(bf16_t, WS_YBR);
    const float* lng = C.in(I_GMLNG) + l * 512; const float* lnb = C.in(I_GMLNB) + l * 512; const float* bs = C.in(I_GMBS) + l * 512; const bf16_t* WS = WLP(const bf16_t, l, WL_GMW);
    LAS float* stats = (LAS float*)lds; LAS bf16_t* vnT = (LAS bf16_t*)(lds + 1024);
    const int tid = fresh_tid(), lane = tid & 63, wid = tid >> 6, i16 = lane & 15, g4 = lane >> 4;
    for (int rr = 0; rr < 16; ++rr) { const int q = 16 * wid + rr; const u32x4 w = *(const u32x4*)(Z + (size_t)(R0 + q) * NZ + 512 + 8 * lane);
        const float v[8] = {bflo(w.x), bfhi(w.x), bflo(w.y), bfhi(w.y), bflo(w.z), bfhi(w.z), bflo(w.w), bfhi(w.w)};
        float s = 0.f;
#pragma unroll
        for (int e = 0; e < 8; ++e) s += v[e];
        const float mean = wave_sum(s) * (1.f / 512.f); float q2 = 0.f;
#pragma unroll
        for (int e = 0; e < 8; ++e) { const float d = v[e] - mean; q2 += d * d; }
        const float rstd = __builtin_amdgcn_rsqf(wave_sum(q2) * (1.f / 512.f) + EPS);
        if (lane == 0) { stats[2 * q] = mean; stats[2 * q + 1] = rstd; } }
    __syncthreads();
    for (int g = g_lo; g < g_lo + 2; ++g) {
        u32x4 wj[4];
#pragma unroll
        for (int j = 0; j < 4; ++j) { const int id = tid + 512 * j, q = id >> 4, cc = id & 15; wj[j] = *(const u32x4*)(Z + (size_t)(R0 + q) * NZ + 512 + g * 128 + 8 * cc); }
        __builtin_amdgcn_sched_barrier(0);
#pragma unroll
        for (int j = 0; j < 4; ++j) { const int id = tid + 512 * j, q = id >> 4, cc = id & 15; const u32x4 w = wj[j];
            const float v[8] = {bflo(w.x), bfhi(w.x), bflo(w.y), bfhi(w.y), bflo(w.z), bfhi(w.z), bflo(w.w), bfhi(w.w)};
            const float mean = stats[2 * q], rstd = stats[2 * q + 1];
            const f32x4 g0 = *(const f32x4*)(lng + g * 128 + 8 * cc), g1 = *(const f32x4*)(lng + g * 128 + 8 * cc + 4), b0 = *(const f32x4*)(lnb + g * 128 + 8 * cc), b1 = *(const f32x4*)(lnb + g * 128 + 8 * cc + 4);
            const float gg[8] = {g0[0], g0[1], g0[2], g0[3], g1[0], g1[1], g1[2], g1[3]}, bb[8] = {b0[0], b0[1], b0[2], b0[3], b1[0], b1[1], b1[2], b1[3]};
#pragma unroll
            for (int e = 0; e < 8; ++e) vnT[(8 * cc + e) * 136 + q] = (bf16_t)f2bf((v[e] - mean) * rstd * gg[e] + bb[e]); }
        __syncthreads();
        bf16x8 bw[4];
#pragma unroll
        for (int ks = 0; ks < 4; ++ks) bw[ks] = *(const bf16x8*)(WS + (size_t)(g * 128 + 16 * wid + i16) * 128 + 32 * ks + 8 * g4);
        f32x4 acc[8];
#pragma unroll
        for (int ct = 0; ct < 8; ++ct) { acc[ct] = (f32x4){0.f, 0.f, 0.f, 0.f};
#pragma unroll
            for (int ks = 0; ks < 4; ++ks) { const bf16x8 a = *(const LAS bf16x8*)(vnT + (16 * ct + i16) * 136 + 32 * ks + 8 * g4); acc[ct] = mfma16(a, bw[ks], acc[ct]); } }
        const int prow = R0 + 16 * wid + i16; const float bsv = bs[g * 128 + 16 * wid + i16];
        u32x2 uwv[8];
#pragma unroll
        for (int ct = 0; ct < 8; ++ct) uwv[ct] = *(const u32x2*)(Z + (size_t)prow * NZ + g * 128 + 16 * ct + 4 * g4);
        __builtin_amdgcn_sched_barrier(0);
#pragma unroll
        for (int ct = 0; ct < 8; ++ct) { const int c4 = g * 128 + 16 * ct + 4 * g4; const u32x2 uw = uwv[ct];
            u32x2 o; o.x = cvt_pk_bf16(bflo(uw.x) * (acc[ct][0] + bsv), bfhi(uw.x) * (acc[ct][1] + bsv)); o.y = cvt_pk_bf16(bflo(uw.y) * (acc[ct][2] + bsv), bfhi(uw.y) * (acc[ct][3] + bsv));
            *(u32x2*)(YA + (size_t)prow * 512 + c4) = o; }
        __syncthreads();
    }
}
__device__ __forceinline__ void conv_block(const Ctx& C, int l, LAS unsigned char* lds, int SR0, int SL, int p0) {
    unsigned char* const ws = C.ws();
    const bf16_t* HB = WSP(const bf16_t, WS_HB); bf16_t* YB = WSP(bf16_t, WS_YBR) + (size_t)MT * 512;
    const float* lng = C.in(I_CVLNG) + l * 512; const float* lnb = C.in(I_CVLNB) + l * 512;
    LAS float* tile = (LAS float*)lds;
    const int tid = fresh_tid(), lane = tid & 63, wid = tid >> 6;
    float dw[31]; const float db = C.in(I_CVDB)[l * 512 + tid]; const float* const dwp = C.in(I_CVDW) + (size_t)l * 31 * 512 + tid;
#pragma unroll
    for (int j = 0; j < 31; ++j) dw[j] = dwp[j * 512];
    __builtin_amdgcn_sched_barrier(0);
    float hv[62]; unsigned raw[62];
#pragma unroll
    for (int j = 0; j < 62; ++j) { const int p = p0 - 15 + j; const int pc = p < 0 ? 0 : (p >= SL ? SL - 1 : p);
        raw[j] = HB[(size_t)(SR0 + pc) * 512 + tid]; }
    __builtin_amdgcn_sched_barrier(0);
#pragma unroll
    for (int j = 0; j < 62; ++j) { const int p = p0 - 15 + j; hv[j] = (p >= 0 && p < SL) ? __builtin_bit_cast(float, raw[j] << 16) : 0.f; }
#pragma unroll
    for (int o = 0; o < 32; ++o) { float s = db;
#pragma unroll
        for (int j = 0; j < 31; ++j) s += dw[j] * hv[o + j];
        tile[o * 512 + tid] = s; }
    __syncthreads();
    const f32x4 lga = *(const f32x4*)(lng + 4 * lane), lgb = *(const f32x4*)(lng + 256 + 4 * lane), lba = *(const f32x4*)(lnb + 4 * lane), lbb = *(const f32x4*)(lnb + 256 + 4 * lane);
#pragma unroll
    for (int rr = 0; rr < 4; ++rr) { const int o = 4 * wid + rr; f32x4 a = *(const LAS f32x4*)(tile + o * 512 + 4 * lane), b = *(const LAS f32x4*)(tile + o * 512 + 256 + 4 * lane);
        const float mean = wave_sum((a[0] + a[1]) + (a[2] + a[3]) + (b[0] + b[1]) + (b[2] + b[3])) * (1.f / 512.f);
        a = a - mean; b = b - mean;
        const float rstd = __builtin_amdgcn_rsqf(wave_sum((a[0] * a[0] + a[1] * a[1]) + (a[2] * a[2] + a[3] * a[3]) + (b[0] * b[0] + b[1] * b[1]) + (b[2] * b[2] + b[3] * b[3])) * (1.f / 512.f) + EPS);
        const f32x4 ya = a * rstd * lga + lba, yb = b * rstd * lgb + lbb;
        u32x2 wa, wb; wa.x = cvt_pk_bf16(ya[0] * sigmoidf_(ya[0]), ya[1] * sigmoidf_(ya[1])); wa.y = cvt_pk_bf16(ya[2] * sigmoidf_(ya[2]), ya[3] * sigmoidf_(ya[3]));
        wb.x = cvt_pk_bf16(yb[0] * sigmoidf_(yb[0]), yb[1] * sigmoidf_(yb[1])); wb.y = cvt_pk_bf16(yb[2] * sigmoidf_(yb[2]), yb[3] * sigmoidf_(yb[3]));
        bf16_t* op = YB + (size_t)(SR0 + p0 + o) * 512; *(u32x2*)(op + 4 * lane) = wa; *(u32x2*)(op + 256 + 4 * lane) = wb; }
    __syncthreads();
}

struct AttnSrc { const bf16_t* k1; int k1ld; const bf16_t* k2; int k2ld; const bf16_t* vt; };
template <int DK1, int DK2, int DV> struct AttnGeo {
    static constexpr int DK = DK1 + DK2, KS = DK / 32, DT = DV / 16, KROW = DK + 8, VROW = 72, KC = DK / 8, NKC = 64 * KC / 512, NVC = DV * 8 / 512, KBYTES = 64 * KROW * 2, VBYTES = DV * VROW * 2, VBASE = 2 * KBYTES  ;
    static_assert((64 * KC) % 512 == 0 && (DV * 8) % 512 == 0, "staging geometry");
};
template <int DK1, int DK2, int DV>
__device__ __forceinline__ void attn_load(const AttnSrc& S, int row0, int tid, u32x4 (&kr)[AttnGeo<DK1, DK2, DV>::NKC], u32x4 (&vr)[AttnGeo<DK1, DK2, DV>::NVC]) {
    typedef AttnGeo<DK1, DK2, DV> Gm;
#pragma unroll
    for (int i = 0; i < Gm::NKC; ++i) { const int c = tid + 512 * i, key = c / Gm::KC, part = c - key * Gm::KC;
        const bf16_t* src = (part < DK1 / 8) ? S.k1 + (size_t)(row0 + key) * S.k1ld + part * 8 : S.k2 + (size_t)(row0 + key) * S.k2ld + (part - DK1 / 8) * 8; kr[i] = *(const u32x4*)src; }
#pragma unroll
    for (int i = 0; i < Gm::NVC; ++i) { const int c = tid + 512 * i, d = c >> 3, c8 = c & 7; vr[i] = *(const u32x4*)(S.vt + (size_t)d * MT + row0 + 8 * c8); }
}
template <int DK1, int DK2, int DV>
__device__ __forceinline__ void attn_store(LAS unsigned char* kbuf, LAS unsigned char* vbuf, int tid, const u32x4 (&kr)[AttnGeo<DK1, DK2, DV>::NKC], const u32x4 (&vr)[AttnGeo<DK1, DK2, DV>::NVC]) {
    typedef AttnGeo<DK1, DK2, DV> Gm; LAS bf16_t* Ks = (LAS bf16_t*)kbuf; LAS bf16_t* Vt = (LAS bf16_t*)vbuf;
#pragma unroll
    for (int i = 0; i < Gm::NKC; ++i) { const int c = tid + 512 * i, key = c / Gm::KC, part = c - key * Gm::KC;
        const int rho = (key & 32) + 16 * ((key >> 2) & 1) + 4 * ((key >> 3) & 3) + (key & 3);
        *(LAS u32x4*)(Ks + rho * Gm::KROW + part * 8) = kr[i]; }
#pragma unroll
    for (int i = 0; i < Gm::NVC; ++i) { const int c = tid + 512 * i, d = c >> 3, c8 = c & 7; *(LAS u32x4*)(Vt + d * Gm::VROW + 8 * c8) = vr[i]; }
}
template <int DT, bool MASK>
__device__ __forceinline__ void attn_softmax(f32x4 (&st)[2], float& m, float& l, f32x4 (&ot)[DT], bf16x8& pf, int kp0  , bool masked) {
    if (MASK && masked) {
#pragma unroll
        for (int t2 = 0; t2 < 2; ++t2)
#pragma unroll
            for (int r = 0; r < 4; ++r) if ((unsigned)(kp0 + 4 * t2 + r) > 256u) st[t2][r] = -1e30f;
    }
    float mx = __builtin_fmaxf(__builtin_fmaxf(__builtin_fmaxf(__builtin_fmaxf(st[0][0], st[0][1]), st[0][2]), __builtin_fmaxf(__builtin_fmaxf(st[0][3], st[1][0]), st[1][1])), __builtin_fmaxf(st[1][2], st[1][3]));
    { auto r16 = __builtin_amdgcn_permlane16_swap(__builtin_bit_cast(unsigned, mx), __builtin_bit_cast(unsigned, mx), false, false);
      mx = vmax(__builtin_bit_cast(float, r16[0]), __builtin_bit_cast(float, r16[1]));
      auto r32 = __builtin_amdgcn_permlane32_swap(__builtin_bit_cast(unsigned, mx), __builtin_bit_cast(unsigned, mx), false, false);
      mx = vmax(__builtin_bit_cast(float, r32[0]), __builtin_bit_cast(float, r32[1])); }
    if (__any(mx > m + 8.f)) { const float mt = vmax(m, mx); const float alpha = fast_exp2(m - mt); l *= alpha; m = mt;
#pragma unroll
        for (int dt = 0; dt < DT; ++dt) ot[dt] = ot[dt] * alpha; }
    const float mn = m;
    { const float nmn = -mn; const f32x4 d0 = st[0] + nmn, d1 = st[1] + nmn;
      st[0] = (f32x4){fast_exp2(d0[0]), fast_exp2(d0[1]), fast_exp2(d0[2]), fast_exp2(d0[3])}; st[1] = (f32x4){fast_exp2(d1[0]), fast_exp2(d1[1]), fast_exp2(d1[2]), fast_exp2(d1[3])};
      const f32x4 es = st[0] + st[1]; const f32x2 e2 = (f32x2){es[0], es[1]} + (f32x2){es[2], es[3]};
      l += e2[0] + e2[1]; }
    union { u32x4 u; bf16x8 b; } q; q.u.x = cvt_pk_bf16(st[0][0], st[0][1]); q.u.y = cvt_pk_bf16(st[0][2], st[0][3]); q.u.z = cvt_pk_bf16(st[1][0], st[1][1]); q.u.w = cvt_pk_bf16(st[1][2], st[1][3]);
    pf = q.b;
}
template <int DK1, int DK2, int DV, bool MASK>
__device__ __forceinline__ void attn_unit(LAS unsigned char* lds, const AttnSrc& S, const bf16_t* q0p, const bf16_t* q1p, bf16_t* o0p, bf16_t* o1p,
                                          int ctx_row0, int nctx, int loc_row0, int loc_pos0, int nloc, int qpos0, int qpos1, float m0, float l0, int role) {
    typedef AttnGeo<DK1, DK2, DV> Gm; constexpr int KS = Gm::KS, DT = Gm::DT, KROW = Gm::KROW, VROW = Gm::VROW;
    const int tid = fresh_tid(), lane = tid & 63, i16 = lane & 15, g4 = lane >> 4;
    bf16x8 qf0[KS], qf1[KS];
#pragma unroll
    for (int ks = 0; ks < KS; ++ks) { qf0[ks] = *(const bf16x8*)(q0p + 32 * ks + 8 * g4); qf1[ks] = *(const bf16x8*)(q1p + 32 * ks + 8 * g4); }
    f32x4 ot0[DT], ot1[DT];
#pragma unroll
    for (int dt = 0; dt < DT; ++dt) { ot0[dt] = (f32x4){0.f, 0.f, 0.f, 0.f}; ot1[dt] = (f32x4){0.f, 0.f, 0.f, 0.f}; }
    float ma = m0, mb = m0, la = (g4 == 0) ? l0 : 0.f, lb = la;
    const int NT = nctx + nloc;
    u32x4 kr[Gm::NKC], vr[Gm::NVC];
#define TROW(t) ((t) < nctx ? ctx_row0 + 64 * (t) : loc_row0 + 64 * ((t) - nctx))
    attn_load<DK1, DK2, DV>(S, TROW(0), tid, kr, vr);
    __syncthreads();
    attn_store<DK1, DK2, DV>(lds, lds + Gm::VBASE, tid, kr, vr);
    __syncthreads();
    if (NT > 1) attn_load<DK1, DK2, DV>(S, TROW(1), tid, kr, vr);
    int vs = 0;
    for (int tt = 0; tt < NT; ++tt) {
        const LAS bf16_t* Ks = (const LAS bf16_t*)(lds + (tt & 1) * Gm::KBYTES); const LAS bf16_t* Vt = (const LAS bf16_t*)(lds + Gm::VBASE + vs * Gm::VBYTES);
        const bool masked = MASK && tt >= nctx; const int kpb = loc_pos0 + 64 * (tt - nctx) + 8 * g4 + 128;
        f32x4 sa[2], sb[2];
#define AT_X(hh) do { _Pragma("unroll") for (int t2 = 0; t2 < 2; ++t2) { sa[t2] = (f32x4){0.f, 0.f, 0.f, 0.f}; sb[t2] = (f32x4){0.f, 0.f, 0.f, 0.f}; bf16x8 kf[KS]; \
            _Pragma("unroll") for (int ks = 0; ks < KS; ++ks) kf[ks] = *(const LAS bf16x8*)(Ks + (32 * (hh) + 16 * t2 + i16) * KROW + 32 * ks + 8 * g4); \
            __builtin_amdgcn_sched_barrier(0); \
            _Pragma("unroll") for (int ks = 0; ks < KS; ++ks) { sa[t2] = mfma16(kf[ks], qf0[ks], sa[t2]); sb[t2] = mfma16(kf[ks], qf1[ks], sb[t2]); } \
            __builtin_amdgcn_sched_barrier(0); } } while (0)
#define AT_Y(hh) do { bf16x8 pa, pb; \
            attn_softmax<DT, MASK>(sa, ma, la, ot0, pa, kpb + 32 * (hh) - qpos0, masked); \
            attn_softmax<DT, MASK>(sb, mb, lb, ot1, pb, kpb + 32 * (hh) - qpos1, masked); \
            __builtin_amdgcn_sched_barrier(0); \
            _Pragma("unroll") for (int d4 = 0; d4 < DT; d4 += 4) { bf16x8 vf[4]; \
                _Pragma("unroll") for (int dd = 0; dd < 4; ++dd) vf[dd] = *(const LAS bf16x8*)(Vt + (16 * (d4 + dd) + i16) * VROW + 32 * (hh) + 8 * g4); \
                __builtin_amdgcn_sched_barrier(0); \
                _Pragma("unroll") for (int dd = 0; dd < 4; ++dd) { ot0[d4 + dd] = mfma16(vf[dd], pa, ot0[d4 + dd]); ot1[d4 + dd] = mfma16(vf[dd], pb, ot1[d4 + dd]); } \
                __builtin_amdgcn_sched_barrier(0); } } while (0)
        AT_X(0); AT_Y(0); AT_X(1);
        if (role == 0) AT_Y(1);
        const int vn = vs == 2 ? 0 : vs + 1;
        if (tt + 1 < NT) attn_store<DK1, DK2, DV>(lds + ((tt + 1) & 1) * Gm::KBYTES, lds + Gm::VBASE + vn * Gm::VBYTES, tid, kr, vr);
        __syncthreads();
        if (tt + 2 < NT) attn_load<DK1, DK2, DV>(S, TROW(tt + 2), tid, kr, vr);
        if (role != 0) AT_Y(1);
        vs = vn;
#undef AT_X
#undef AT_Y
    }
#undef TROW
    float lt = la + __shfl_xor(la, 16); lt += __shfl_xor(lt, 32); const float ia = 1.f / lt;
    lt = lb + __shfl_xor(lb, 16); lt += __shfl_xor(lt, 32); const float ib = 1.f / lt;
#pragma unroll
    for (int dt = 0; dt < DT; ++dt) { u32x2 w; w.x = cvt_pk_bf16(ot0[dt][0] * ia, ot0[dt][1] * ia); w.y = cvt_pk_bf16(ot0[dt][2] * ia, ot0[dt][3] * ia); *(u32x2*)(o0p + 16 * dt + 4 * g4) = w;
        w.x = cvt_pk_bf16(ot1[dt][0] * ib, ot1[dt][1] * ib); w.y = cvt_pk_bf16(ot1[dt][2] * ib, ot1[dt][3] * ib); *(u32x2*)(o1p + 16 * dt + 4 * g4) = w; }
}

constexpr int NPHASE = 2 + 12 * DEPTH;
__global__ void __launch_bounds__(512, 2) mk_fwd(Params P) {
    extern __shared__ __attribute__((aligned(16))) unsigned char lds_raw[];
    LAS unsigned char* lds = (LAS unsigned char*)lds_raw;
    const int tid = fresh_tid();
    volatile LAS unsigned* MISC = (volatile LAS unsigned*)(lds + MISC_OFF);
    for (int u = tid; u < (LDS_BYTES - RING_BYTES) / 4; u += 512) ((LAS unsigned*)(lds + RING_BYTES))[u] = 0u;
    __syncthreads();
    Ctx C; C.tab = (volatile LAS unsigned*)(lds + PTAB_OFF);
    if (tid == 0) {
#pragma unroll
        for (int i = 0; i < 28; ++i) { const unsigned long long v = (unsigned long long)P.in[i]; C.tab[2 * i] = (unsigned)v; C.tab[2 * i + 1] = (unsigned)(v >> 32); }
        { const unsigned long long v = (unsigned long long)P.out; C.tab[56] = (unsigned)v; C.tab[57] = (unsigned)(v >> 32); }
        { const unsigned long long v = (unsigned long long)P.ws; C.tab[58] = (unsigned)v; C.tab[59] = (unsigned)(v >> 32); }
        C.tab[60] = (unsigned)P.ph_lo; C.tab[61] = (unsigned)P.ph_hi;
    }
    __syncthreads();
    if (!MK_MULTI) (void)xcd_barrier_post((unsigned*)(C.ws() + WS_CTL) + CW_BAR, MISC + 8);
    auto tabw = [&](unsigned off) -> int { asm volatile("" : "+s"(off)); return (int)__builtin_amdgcn_readfirstlane(*(volatile LAS unsigned*)(lds + off)); };
#define LO tabw(PTAB_OFF + 240)
#define HI tabw(PTAB_OFF + 244)
#define IN(k) (LO <= (k) && (k) < HI)
#define MKBAR XcdBarrier bar; bar.bar = (unsigned*)(C.ws() + WS_CTL) + CW_BAR; bar.x = xb_xcc_id(); bar.st = (volatile LAS unsigned*)(lds + MISC_OFF) + 8
#define SEAM(k) do { if (!MK_MULTI && IN(k) && IN((k) + 1)) { MKBAR; xcd_barrier(bar); } } while (0)
#define GRID const int G = gridDim.x, bid = blockIdx.x

    if (IN(0) && EN(12)) for (int _rep = 0; _rep < (((PROBE_MASK >> 12) & 1) ? 2 : 1); ++_rep) { if (_rep) { MKBAR; xcd_barrier(bar); } GRID; prologue_phase(C, lds, G, bid); }
    SEAM(0);

    for (int l = 0; l < DEPTH; ++l) {
        const int pb = 1 + 12 * l; const bool last = (l == DEPTH - 1);
        if (IN(pb + 0) && EN(0)) for (int _rep = 0; _rep < (((PROBE_MASK >> 0) & 1) ? 2 : 1); ++_rep) { if (_rep) { MKBAR; xcd_barrier(bar); } GRID; unsigned char* const ws = C.ws(); float* const out = C.out(); float* const XC = WSP(float, WS_XC);
            const float* modl = WSP(const float, WS_MOD) + (size_t)l * 5 * NMOD; const float* npre = C.in(I_NPRE) + (size_t)l * 3 * D; const float* npost = C.in(I_NPOST) + (size_t)l * 3 * D;
            if (l == 0) norm_phase<true>(lds, G, bid, MT, C.in(I_X), C.in(I_CTX), WSP(bf16_t, WS_XB), nullptr, false  , nullptr, nullptr, modl, 0, 0.f, nullptr, WSP(bf16_t, WS_H), modl, 0, npre);
            else norm_phase<false>(lds, G, bid, MT, nullptr, nullptr, WSP(bf16_t, WS_XB), nullptr, true, WSP(const bf16_t, WS_Y), (G >= 256 ? (const float*)C.out() : nullptr), modl - (size_t)5 * NMOD, 8, 0.5f, npost - D, WSP(bf16_t, WS_H), modl, 0, npre);
        }
        SEAM(pb + 0);
        if (IN(pb + 1) && EN(1)) for (int _rep = 0; _rep < (((PROBE_MASK >> 1) & 1) ? 2 : 1); ++_rep) { if (_rep) { MKBAR; xcd_barrier(bar); } GRID; unsigned char* const ws = C.ws();
            pg8::RectOrder S; S.init(MT / 256, NGU / 256, G, bid, 0, WSP(bf16_t, WS_H), 256 * D * 2, WLP(bf16_t, l, WL_GU), 256 * D * 2);
            pg8::EpiSwiglu E{WSP(bf16_t, WS_Z)}; pg8::gemm_phase<pg8::EpiSwiglu, pg8::RectOrder, true>(lds, D, D, D, S, E); }
        if (IN(pb + 1) && EN(1)) { GRID; cvt_pull(C, lds, l * CV_LAYER + CV_E2, CW_DONE + 64 * (pb + 1), G); }
        SEAM(pb + 1);
        if (IN(pb + 2) && EN(2)) for (int _rep = 0; _rep < (((PROBE_MASK >> 2) & 1) ? 2 : 1); ++_rep) { if (_rep) { MKBAR; xcd_barrier(bar); } GRID; unsigned char* const ws = C.ws();
            const bool split = (G >= 256);
            { pg8::RectOrder S; S.init((split ? ML : MT) / 256, D / 256, G, bid, 0, WSP(bf16_t, WS_Z), 256 * DFF * 2, WLP(bf16_t, l, WL_D), 256 * DFF * 2);
              pg8::EpiPlain<false> E{WSP(bf16_t, WS_Y), D, nullptr}; pg8::gemm_phase<pg8::EpiPlain<false>, pg8::RectOrder, true>(lds, DFF, DFF, DFF, S, E); }
            if (split) { const int tile = bid >> 3, part = bid & 7, ks = part < 5 ? 10 * part : 50 + 12 * (part - 5), kn = part < 5 ? 10 : 12;
              pg8::SplitOrder S; S.pm = ML / 256 + (tile >> 3); S.pn = tile & 7; S.part = part; S.have = bid < 256;
              S.A = (const char*)(WSP(bf16_t, WS_Z) + (size_t)S.pm * 256 * DFF + ks * 64); S.B = (const char*)(WLP(bf16_t, l, WL_D) + (size_t)S.pn * 256 * DFF + ks * 64);
              pg8::EpiPartial E{C.out(), ML, (size_t)MC * D}; pg8::gemm_phase<pg8::EpiPartial, pg8::SplitOrder, true>(lds, kn * 64, DFF, DFF, S, E); } }
        SEAM(pb + 2);
        if (IN(pb + 3) && EN(3)) for (int _rep = 0; _rep < (((PROBE_MASK >> 3) & 1) ? 2 : 1); ++_rep) { if (_rep) { MKBAR; xcd_barrier(bar); } GRID; unsigned char* const ws = C.ws(); float* const out = C.out(); float* const XC = WSP(float, WS_XC);
            const float* const modl = WSP(const float, WS_MOD) + (size_t)l * 5 * NMOD;
            if (l == 0) norm_phase<true>(lds, G, bid, MT, C.in(I_X), C.in(I_CTX), WSP(bf16_t, WS_XB), nullptr, true, WSP(const bf16_t, WS_Y), (G >= 256 ? (const float*)C.out() : nullptr), modl, 2, 0.5f, C.in(I_NPOST) + (size_t)l * 3 * D, WSP(bf16_t, WS_H), modl, 3, C.in(I_NPRE) + ((size_t)l * 3 + 1) * D);
            else norm_phase<false>(lds, G, bid, MT, nullptr, nullptr, WSP(bf16_t, WS_XB), nullptr, true, WSP(const bf16_t, WS_Y), (G >= 256 ? (const float*)C.out() : nullptr), modl, 2, 0.5f, C.in(I_NPOST) + (size_t)l * 3 * D, WSP(bf16_t, WS_H), modl, 3, C.in(I_NPRE) + ((size_t)l * 3 + 1) * D); }
        SEAM(pb + 3);
        if (IN(pb + 4) && EN(4)) for (int _rep = 0; _rep < (((PROBE_MASK >> 4) & 1) ? 2 : 1); ++_rep) { if (_rep) { MKBAR; xcd_barrier(bar); } GRID; unsigned char* const ws = C.ws();
            bf16_t* const Z = WSP(bf16_t, WS_Z); bf16_t* const H = WSP(bf16_t, WS_H);
            LAS float* const LTAB = (LAS float*)(lds + LTAB_OFF);
            { const int t_ = fresh_tid(); for (int i = t_; i < 2048; i += 512) LTAB[i] = WSP(const float, WS_TAB)[i]; __syncthreads(); }
            pg8::EpiZ E{Z, WSP(bf16_t, WS_HB), WSP(float, WS_SSP), WLP(const float, l, WL_BZ), LTAB, 0, 0};
            { pg8::RectOrder S; S.init(ML / 256, NZ / 256, G, bid, 0, H, 256 * D * 2, WLP(bf16_t, l, WL_IN), 256 * D * 2);
              pg8::gemm_phase<pg8::EpiZ, pg8::RectOrder, true>(lds, D, D, D, S, E); }
            int used = (ML / 256) * (NZ / 256);
            {
                const int ct0 = last ? 10 : 0, nct = last ? 4 : 14;
                pg8::EpiZ E2{Z, WSP(bf16_t, WS_HB), WSP(float, WS_SSP), WLP(const float, l, WL_BZ), LTAB, ct0, ML};
                pg8::RectOrder S; S.init(MC / 256, nct, G, bid, used, H + (size_t)ML * D, 256 * D * 2, WLP(bf16_t, l, WL_IN) + (size_t)ct0 * 256 * D, 256 * D * 2);
                pg8::gemm_phase<pg8::EpiZ, pg8::RectOrder, true>(lds, D, D, D, S, E2); used += (MC / 256) * nct; }
            {
                pg8::EpiVt<false> E3{WSP(bf16_t, WS_VTD), MT, WLP(const float, l, WL_BZ) + NZ, nullptr};
                pg8::RectOrder S; S.init(1, MT / 256, G, bid, used, WLP(bf16_t, l, WL_IN) + (size_t)NZ * D, 0, H, 256 * D * 2);
                pg8::gemm_phase<pg8::EpiVt<false>, pg8::RectOrder, true>(lds, D, D, D, S, E3); }
        }
        if (IN(pb + 4) && EN(4)) { GRID; cvt_pull(C, lds, l * CV_LAYER + CV_E7, CW_DONE + 64 * (pb + 4), G); }
        SEAM(pb + 4);
        if (IN(pb + 5) && EN(5)) for (int _rep = 0; _rep < (((PROBE_MASK >> 5) & 1) ? 2 : 1); ++_rep) { if (_rep) { MKBAR; xcd_barrier(bar); } GRID;
            const int lm_ = _rep ? PROBE_LOCMASK : LOCMASK;
            const int nch = 2 * ((last ? ML : MT) / 128), ncb = (last ? ML : MT) / 32;
            for (int it = bid; it < nch + ncb; it += G) {
                if (it < nch) { if (lm_ & 1) gmlp_chunk(C, l, lds, (it >> 1) * 128, 2 * (it & 1)); }
                else { const int cb = it - nch; int SR0, SL, p0; if (cb < ML / 32) { SR0 = (cb >> 7) * SEQ; SL = SEQ; p0 = (cb & 127) * 32; } else { const int c2 = cb - ML / 32; SR0 = ML + (c2 >> 3) * CTXL; SL = CTXL; p0 = (c2 & 7) * 32; }
                    if (lm_ & 2) conv_block(C, l, lds, SR0, SL, p0); }
            }
            __syncthreads();
            const int pan_q = (last ? ML : MT) / 256;
            if (!last) { unsigned char* const ws = C.ws();
              LAS float* const LTAB = (LAS float*)(lds + LTAB_OFF);
              pg8::EpiZ E2{WSP(bf16_t, WS_Z), WSP(bf16_t, WS_HB), WSP(float, WS_SSP), WLP(const float, l, WL_BZ), LTAB, 14, ML};
              pg8::RectOrder S; S.init(MC / 256, NZ / 256 - 14, G, bid, G / 2, WSP(bf16_t, WS_H) + (size_t)ML * D, 256 * D * 2, WLP(bf16_t, l, WL_IN) + (size_t)14 * 256 * D, 256 * D * 2);
              pg8::gemm_phase<pg8::EpiZ, pg8::RectOrder, true>(lds, D, D, D, S, E2); }
            if (lm_ & 4) { unsigned char* const ws = C.ws();
              pg8::RectOrder S; S.init(pan_q, 3, G, bid, 0, WSP(bf16_t, WS_Z) + ZC_CQ, 256 * NZ * 2, WLP(bf16_t, l, WL_UQ), 256 * 512 * 2);
              LAS float* const LTAB = (LAS float*)(lds + LTAB_OFF); { const int t_ = fresh_tid(); for (int i = t_; i < 2048; i += 512) LTAB[i] = WSP(const float, WS_TAB)[i]; __syncthreads(); }
              pg8::EpiQ E{WSP(bf16_t, WS_QM), WSP(const float, WS_SSP), LTAB}; pg8::gemm_phase<pg8::EpiQ, pg8::RectOrder, true>(lds, 512, NZ, 512, S, E); }
            if (lm_ & 8) { unsigned char* const ws = C.ws();
              { pg8::RectOrder S; S.init(MT / 256, 2, G, bid, last ? pan_q * 3 : 0, WSP(bf16_t, WS_Z) + ZC_CKV, 256 * NZ * 2, WLP(bf16_t, l, WL_KV), 256 * 256 * 2);
                pg8::EpiPlain<true> E{WSP(bf16_t, WS_KN), 512, WSP(const float, WS_SSP)}; pg8::gemm_phase<pg8::EpiPlain<true>, pg8::RectOrder, true>(lds, 256, NZ, 256, S, E); }
              { pg8::RectOrder S; S.init(2, MT / 256, G, bid, last ? pan_q * 3 + (MT / 256) * 2 : 0, WLP(bf16_t, l, WL_KV) + 512 * 256, 256 * 256 * 2, WSP(bf16_t, WS_Z) + ZC_CKV, 256 * NZ * 2);
                pg8::EpiVt<true> E{WSP(bf16_t, WS_VTM), MT, nullptr, WSP(const float, WS_SSP)}; pg8::gemm_phase<pg8::EpiVt<true>, pg8::RectOrder, true>(lds, 256, 256, NZ, S, E); } }
        }
        SEAM(pb + 5);
        if (IN(pb + 6) && EN(6)) for (int _rep = 0; _rep < (((PROBE_MASK >> 6) & 1) ? 2 : 1); ++_rep) { if (_rep) { MKBAR; xcd_barrier(bar); } GRID; unsigned char* const ws = C.ws();
            bf16_t* const YC = WSP(bf16_t, WS_YBR) + (size_t)2 * MT * 512; bf16_t* const YD = WSP(bf16_t, WS_YBR) + (size_t)3 * MT * 512;
            const bf16_t* const QM = WSP(const bf16_t, WS_QM); const bf16_t* const KN = WSP(const bf16_t, WS_KN); const bf16_t* const Z = WSP(const bf16_t, WS_Z);
            const bf16_t* const VTM = WSP(const bf16_t, WS_VTM); const bf16_t* const VTD = WSP(const bf16_t, WS_VTD);
            const float* const sink = C.in(I_SINK) + l * 8;
            const int tid2 = fresh_tid(), wid = __builtin_amdgcn_readfirstlane(tid2 >> 6);
            int role; { const unsigned simd = (unsigned)__builtin_amdgcn_s_getreg((1 << 11) | (4 << 6) | 4) & 3u; volatile LAS unsigned* sw = (volatile LAS unsigned*)(lds + 122880);
              __syncthreads(); if ((tid2 & 63) == 0) sw[wid] = simd; __syncthreads();
              int cnt = 0;
#pragma unroll
              for (int w = 0; w < 8; ++w) cnt += (w < wid && sw[w] == simd) ? 1 : 0;
              role = __builtin_amdgcn_readfirstlane(cnt & 1); }
#ifdef ROLE_WID
            role = (ROLE_WID == 4) ? (wid >> 2) & 1 : wid & 1;
#endif
#define i16 (fresh_tid() & 15)
            for (int u = bid; u < 256; u += G) { const int bh = (u & 7) + 8 * ((u >> 7) & 1), qb = (u >> 3) & 15, b = bh >> 2, h = bh & 3;
                const int row = b * SEQ + 256 * qb + 32 * wid + i16;
                AttnSrc S{KN + h * 128, 512, Z + ZC_KR, NZ, VTM + (size_t)h * 128 * MT};
                attn_unit<128, 64, 128, false>(lds, S, QM + (size_t)row * 768 + h * 192, QM + (size_t)(row + 16) * 768 + h * 192, YC + (size_t)row * 512 + h * 128, YC + (size_t)(row + 16) * 512 + h * 128,
                                               ML + b * CTXL, 4, b * SEQ, 0, 64, 0, 0, -1e30f, 0.f, role); }
            for (int u = bid; u < 512; u += G) { const int b = u >> 7, kvh = (u >> 6) & 1, qb = u & 63, q0 = 64 * qb, head = 4 * kvh + (wid >> 1);
                const int q = q0 + 32 * (wid & 1) + i16, row = b * SEQ + q;
                int tlo = (128 - q0) / 64; if (tlo < 0) tlo = 0; int thi = (SEQ + 128 - q0) / 64; if (thi > 5) thi = 5;
                const int lp0 = q0 - 128 + 64 * tlo;
                AttnSrc S{Z + ZC_KD + 64 * kvh, NZ, Z, NZ, VTD + (size_t)kvh * 64 * MT};
                attn_unit<64, 0, 64, true>(lds, S, Z + (size_t)row * NZ + ZC_QD + 64 * head, Z + (size_t)(row + 16) * NZ + ZC_QD + 64 * head, YD + (size_t)row * 512 + 64 * head, YD + (size_t)(row + 16) * 512 + 64 * head,
                                           ML + b * CTXL, 4, b * SEQ + lp0, lp0, thi - tlo, q, q + 16, sink[head] * LOG2E, 1.f, role); }
            if (!last) {
                for (int u = bid; u < 16; u += G) { const int b = u >> 2, h = u & 3; const int row = ML + b * CTXL + 32 * wid + i16;
                    AttnSrc S{KN + h * 128, 512, Z + ZC_KR, NZ, VTM + (size_t)h * 128 * MT};
                    attn_unit<128, 64, 128, false>(lds, S, QM + (size_t)row * 768 + h * 192, QM + (size_t)(row + 16) * 768 + h * 192, YC + (size_t)row * 512 + h * 128, YC + (size_t)(row + 16) * 512 + h * 128,
                                                   ML + b * CTXL, 4, 0, 0, 0, 0, 0, -1e30f, 0.f, role); }
                for (int u = bid - 16; u >= 0 && u < 32; u += G) { const int b = u >> 3, kvh = (u >> 2) & 1, qb = u & 3, head = 4 * kvh + (wid >> 1);
                    const int q = 64 * qb + 32 * (wid & 1) + i16, row = ML + b * CTXL + q;
                    AttnSrc S{Z + ZC_KD + 64 * kvh, NZ, Z, NZ, VTD + (size_t)kvh * 64 * MT};
                    attn_unit<64, 0, 64, false>(lds, S, Z + (size_t)row * NZ + ZC_QD + 64 * head, Z + (size_t)(row + 16) * NZ + ZC_QD + 64 * head, YD + (size_t)row * 512 + 64 * head, YD + (size_t)(row + 16) * 512 + 64 * head,
                                                ML + b * CTXL, 4, 0, 0, 0, 0, 0, sink[head] * LOG2E, 1.f, role); }
            }
            __syncthreads();
        }
        SEAM(pb + 6);
#undef i16
        if (IN(pb + 7) && EN(7)) for (int _rep = 0; _rep < (((PROBE_MASK >> 7) & 1) ? 2 : 1); ++_rep) { if (_rep) { MKBAR; xcd_barrier(bar); } GRID; unsigned char* const ws = C.ws();
            pg8::ChainOrder S; S.init((last ? ML : MT) / 256, D / 128, G, bid, 0, WSP(bf16_t, WS_YBR), 256 * 512 * 2, WLP(bf16_t, l, WL_BR), 128 * 512 * 2); S.nsub = MERGE_N; S.map = MERGE_MAP; S.sA = (size_t)MT * 512 * 2; S.sB = (size_t)D * 512 * 2;
            pg8::EpiM1H E{WSP(const bf16_t, WS_Z), WSP(bf16_t, WS_H), S.nsub - 1, S.map}; pg8::gemm_phase<pg8::EpiM1H, pg8::ChainOrder, true, true>(lds, 512, 512, 512, S, E); }
        SEAM(pb + 7);
        if (IN(pb + 8) && EN(8)) for (int _rep = 0; _rep < (((PROBE_MASK >> 8) & 1) ? 2 : 1); ++_rep) { if (_rep) { MKBAR; xcd_barrier(bar); } GRID; unsigned char* const ws = C.ws();
            const bool split = (G >= 256) && !last;
            { pg8::RectOrder S; S.init((last || split ? ML : MT) / 256, D / 256, G, bid, 0, WSP(bf16_t, WS_H), 256 * D * 2, WLP(bf16_t, l, WL_OUT), 256 * D * 2);
              pg8::EpiPlain<false> E{WSP(bf16_t, WS_Y), D, nullptr}; pg8::gemm_phase<pg8::EpiPlain<false>, pg8::RectOrder, true>(lds, D, D, D, S, E); }
            if (split) { const int tile = bid >> 3, part = bid & 7;
              pg8::SplitOrder S; S.pm = ML / 256 + (tile >> 3); S.pn = tile & 7; S.part = part; S.have = bid < 256;
              S.A = (const char*)(WSP(bf16_t, WS_H) + (size_t)S.pm * 256 * D + part * 256); S.B = (const char*)(WLP(bf16_t, l, WL_OUT) + (size_t)S.pn * 256 * D + part * 256);
              pg8::EpiPartial E{C.out(), ML, (size_t)MC * D}; pg8::gemm_phase<pg8::EpiPartial, pg8::SplitOrder, true>(lds, 256, D, D, S, E); } }
        SEAM(pb + 8);
        if (IN(pb + 9) && EN(9)) for (int _rep = 0; _rep < (((PROBE_MASK >> 9) & 1) ? 2 : 1); ++_rep) { if (_rep) { MKBAR; xcd_barrier(bar); } GRID; unsigned char* const ws = C.ws(); float* const out = C.out(); float* const XC = WSP(float, WS_XC);
            norm_phase<false>(lds, G, bid, last ? ML : MT, nullptr, nullptr, WSP(bf16_t, WS_XB), nullptr, true, WSP(const bf16_t, WS_Y), (G >= 256 && !last) ? (const float*)C.out() : nullptr, WSP(const float, WS_MOD) + (size_t)l * 5 * NMOD, 5, 1.0f, C.in(I_NPOST) + ((size_t)l * 3 + 1) * D, WSP(bf16_t, WS_H), WSP(const float, WS_MOD) + (size_t)l * 5 * NMOD, 6, C.in(I_NPRE) + ((size_t)l * 3 + 2) * D); }
        SEAM(pb + 9);
        if (IN(pb + 10) && EN(10)) for (int _rep = 0; _rep < (((PROBE_MASK >> 10) & 1) ? 2 : 1); ++_rep) { if (_rep) { MKBAR; xcd_barrier(bar); } GRID; unsigned char* const ws = C.ws();
            pg8::RectOrder S; S.init((last ? ML : MT) / 256, NGU / 256, G, bid, 0, WSP(bf16_t, WS_H), 256 * D * 2, WLP(bf16_t, l, WL_GU) + (size_t)NGU * D, 256 * D * 2);
            pg8::EpiSwiglu E{WSP(bf16_t, WS_Z)}; pg8::gemm_phase<pg8::EpiSwiglu, pg8::RectOrder, true>(lds, D, D, D, S, E); }
        if (IN(pb + 10) && EN(10)) { GRID; cvt_pull(C, lds, l * CV_LAYER + CV_LAYER + CV_E0, CW_DONE + 64 * (pb + 10), G); }
        SEAM(pb + 10);
        if (IN(pb + 11) && EN(11)) for (int _rep = 0; _rep < (((PROBE_MASK >> 11) & 1) ? 2 : 1); ++_rep) { if (_rep) { MKBAR; xcd_barrier(bar); } GRID; unsigned char* const ws = C.ws();
            const bool split = (G >= 256) && !last;
            { pg8::RectOrder S; S.init((last || split ? ML : MT) / 256, D / 256, G, bid, 0, WSP(bf16_t, WS_Z), 256 * DFF * 2, WLP(bf16_t, l, WL_D) + (size_t)D * DFF, 256 * DFF * 2);
              pg8::EpiPlain<false> E{WSP(bf16_t, WS_Y), D, nullptr}; pg8::gemm_phase<pg8::EpiPlain<false>, pg8::RectOrder, true>(lds, DFF, DFF, DFF, S, E); }
            if (split) { const int tile = bid >> 3, part = bid & 7, ks = part < 5 ? 10 * part : 50 + 12 * (part - 5), kn = part < 5 ? 10 : 12;
              pg8::SplitOrder S; S.pm = ML / 256 + (tile >> 3); S.pn = tile & 7; S.part = part; S.have = bid < 256;
              S.A = (const char*)(WSP(bf16_t, WS_Z) + (size_t)S.pm * 256 * DFF + ks * 64); S.B = (const char*)(WLP(bf16_t, l, WL_D) + (size_t)D * DFF + (size_t)S.pn * 256 * DFF + ks * 64);
              pg8::EpiPartial E{C.out(), ML, (size_t)MC * D}; pg8::gemm_phase<pg8::EpiPartial, pg8::SplitOrder, true>(lds, kn * 64, DFF, DFF, S, E); } }
        SEAM(pb + 11);
    }
    if (IN(NPHASE - 1) && EN(13)) { GRID; unsigned char* const ws = C.ws(); float* const out = C.out(); float* const XC = WSP(float, WS_XC);
        const int l = DEPTH - 1;
        norm_phase<false>(lds, G, bid, ML, nullptr, nullptr, WSP(bf16_t, WS_XB), out, false, WSP(const bf16_t, WS_Y), nullptr, WSP(const float, WS_MOD) + (size_t)l * 5 * NMOD, 8, 0.5f, C.in(I_NPOST) + ((size_t)l * 3 + 2) * D, nullptr, nullptr, 0, nullptr);
    }
#undef IN
#undef SEAM
}


extern "C" void kernel_launch(void* const* d_in, const int* in_sizes, int n_in, void* d_out, int out_size, void* d_ws, size_t ws_size, hipStream_t stream) {
    static int grid = 0;
    if (grid == 0) {
        if (n_in != 28 || out_size != ML * D || ws_size < WS_END) { fprintf(stderr, "kernel_launch: unexpected shapes (n_in %d, out %d, ws %zu < %zu)\n", n_in, out_size, ws_size, (size_t)WS_END); grid = -1; return; }
        int dev = 0, cus = 0, per_cu = 0;
        if (hipGetDevice(&dev) != hipSuccess || hipDeviceGetAttribute(&cus, hipDeviceAttributeMultiprocessorCount, dev) != hipSuccess) { grid = -1; return; }
        if (hipFuncSetAttribute((const void*)mk_fwd, hipFuncAttributeMaxDynamicSharedMemorySize, LDS_BYTES) != hipSuccess) { fprintf(stderr, "kernel_launch: hipFuncSetAttribute failed\n"); grid = -1; return; }
        if (hipOccupancyMaxActiveBlocksPerMultiprocessor(&per_cu, (const void*)mk_fwd, 512, LDS_BYTES) != hipSuccess || per_cu < 1) fprintf(stderr, "kernel_launch: occupancy query says %d\n", per_cu);
        (void)hipGetLastError();
        grid = cus;
    }
    if (grid < 0) return;
    (void)hipMemsetAsync((char*)d_ws + WS_CTL, 0, CTL_ZERO_BYTES, stream);
    Params p{};
    for (int i = 0; i < 28; ++i) p.in[i] = (const float*)d_in[i];
    p.out = (float*)d_out; p.ws = (unsigned char*)d_ws;
#if MK_MULTI
    for (int k = 0; k < NPHASE; ++k) { p.ph_lo = k; p.ph_hi = k + 1; hipLaunchKernelGGL(mk_fwd, dim3(grid), dim3(512), LDS_BYTES, stream, p);
    }
#else
    p.ph_lo = 0; p.ph_hi = NPHASE; hipLaunchKernelGGL(mk_fwd, dim3(grid), dim3(512), LDS_BYTES, stream, p);
#endif
}
```

```cpp
#include <hip/hip_runtime.h>
#include <cstdio>
#include <cstdint>

#define LAS __attribute__((address_space(3)))
#define GAS __attribute__((address_space(1)))
typedef unsigned short bf16_t;
typedef short bf16x8 __attribute__((ext_vector_type(8)));
typedef float f32x4 __attribute__((ext_vector_type(4)));
typedef float f32x2 __attribute__((ext_vector_type(2)));
typedef unsigned u32x4 __attribute__((ext_vector_type(4)));
typedef unsigned u32x2 __attribute__((ext_vector_type(2)));

#ifndef PROBE_MASK
#define PROBE_MASK 0
#endif
#ifndef MK_CHECK_LAYER
#define MK_CHECK_LAYER 1
#endif
#ifndef NORM_NR
#define NORM_NR 4
#endif
#ifndef MERGE_N
#define MERGE_N 4
#define MERGE_MAP 0x3210
#endif
#ifndef PROBE_LOCMASK
#define PROBE_LOCMASK 15
#endif
#ifndef LOCMASK
#define LOCMASK 15
#endif
#ifndef PHMASK
#define PHMASK 0xffff
#endif
#define EN(j) (((PHMASK) >> (j)) & 1)
#ifndef MK_MULTI
#define ROLE_WID 4
#define MK_MULTI 0
#endif

constexpr int D = 2048, NB = 4, SEQ = 4096, DEPTH = 2, CTXL = 256, DFF = 5504;
constexpr int ML = NB * SEQ, MC = NB * CTXL, MT = ML + MC;
constexpr int NMOD = 9 * D, NIN = 11840, NZ = 11776, NZW = 12032, NGU = 2 * DFF;
constexpr int ZC_CQ = 2048, ZC_CKV = 2560, ZC_KR = 2816, ZC_QD = 2880, ZC_KD = 3392, ZC_G = 3584;
constexpr float EPS = 1e-6f;
constexpr float LOG2E = 1.4426950408889634f;

__device__ __forceinline__ unsigned f2bf(float f) { unsigned u = __builtin_bit_cast(unsigned, f); return (u + 0x7fffu + ((u >> 16) & 1u)) >> 16; }
__device__ __forceinline__ unsigned pk2(float lo, float hi) { return f2bf(lo) | (f2bf(hi) << 16); }
__device__ __forceinline__ float bflo(unsigned w) { return __builtin_bit_cast(float, w << 16); }
__device__ __forceinline__ float bfhi(unsigned w) { return __builtin_bit_cast(float, w & 0xffff0000u); }
__device__ __forceinline__ float bf2f(bf16_t h) { return __builtin_bit_cast(float, ((unsigned)h) << 16); }
__device__ __forceinline__ unsigned cvt_pk_bf16(float lo, float hi) { unsigned r; asm volatile("v_cvt_pk_bf16_f32 %0, %1, %2" : "=v"(r) : "v"(lo), "v"(hi)); return r; }
__device__ __forceinline__ float fast_exp2(float x) { return __builtin_amdgcn_exp2f(x); }
__device__ __forceinline__ float vmax(float a, float b) { float r; asm("v_max_f32 %0, %1, %2" : "=v"(r) : "v"(a), "v"(b)); return r; }
__device__ __forceinline__ float vmax3(float a, float b, float c) { float r; asm("v_max3_f32 %0, %1, %2, %3" : "=v"(r) : "v"(a), "v"(b), "v"(c)); return r; }
__device__ __forceinline__ float fast_rcp(float x) { return __builtin_amdgcn_rcpf(x); }
__device__ __forceinline__ float sigmoidf_(float x) { return fast_rcp(1.0f + fast_exp2(-x * LOG2E)); }
__device__ __forceinline__ f32x4 sigmoid4(f32x4 x) { const f32x4 t = x * (-LOG2E); const f32x4 e = (f32x4){fast_exp2(t[0]), fast_exp2(t[1]), fast_exp2(t[2]), fast_exp2(t[3])} + 1.0f;
    return (f32x4){fast_rcp(e[0]), fast_rcp(e[1]), fast_rcp(e[2]), fast_rcp(e[3])}; }
__device__ __forceinline__ int fresh_tid() { int t = threadIdx.x; asm volatile("" : "+v"(t)); return t; }
__device__ __forceinline__ float wave_sum(float v) {
#pragma unroll
    for (int o = 1; o < 64; o <<= 1) v += __shfl_xor(v, o);
    return v;
}
__device__ __forceinline__ float gelu1(float v) {
    const float av = __builtin_fabsf(v), t = fast_rcp(av * 0.2316418882f + 1.0f);
    float q = t * 0.5307027145f + (-0.7265760135f); q = q * t + 0.7107068705f; q = q * t + (-0.142248368f); q = q * t + 0.127414796f; q = q * t;
    const float e = fast_exp2((v * v) * (-0.72134752044f));
    const float m = v * (q * e);
    return v < 0.f ? m : v - m;
}

namespace pg8 {
constexpr int BM = 256, BK = 64, HALF = 128, HTB = HALF * BK * 2, STAGE_BYTES = 8 * HTB, NXCD = 8, WGM = 8;
__host__ __device__ __forceinline__ int lds_byte(int r, int c) { const int st = (r >> 4) * 2 + (c >> 5), rr = r & 15, cc = c & 31, ob = rr * 64 + cc * 2; return st * 1024 + (ob ^ (((ob >> 9) & 1) << 5)); }
__host__ __device__ __forceinline__ void stage_rc(int b, int& R, int& C) { const int st = b / 1024, sb = b % 1024, swz = sb ^ (((sb >> 9) & 1) << 5); R = (st >> 1) * 16 + swz / 64; C = (st & 1) * 32 + (swz % 64) / 2; }
__host__ __device__ __forceinline__ int perm32(int rho) { const int n = rho >> 4, i = rho & 15; return 8 * (i >> 2) + 4 * n + (i & 3); }

struct Unit { int pm, pn, sub; };
struct RectOrder {
    int nM, nN, nwg, G, c; const char* A; const char* B; unsigned tA, tB;
    __device__ __forceinline__ void init(int nM_, int nN_, int G_, int c_, int rot, const void* A_, unsigned tA_, const void* B_, unsigned tB_) { nM = nM_; nN = nN_; nwg = nM * nN; G = G_; c = (c_ + G_ - (rot % G_)) % G_; A = (const char*)A_; B = (const char*)B_; tA = tA_; tB = tB_; }
    __device__ __forceinline__ void tile_of(int wgid, Unit& u) const {
        { const int q = nwg / NXCD, r = nwg % NXCD, xcd = wgid % NXCD, off = wgid / NXCD; wgid = (xcd < r ? xcd * (q + 1) : r * (q + 1) + (xcd - r) * q) + off; }
        const int nig = WGM * nN, gid = wgid / nig, fm = gid * WGM, gsz = (nM - fm) < WGM ? (nM - fm) : WGM;
        u.pm = fm + ((wgid % nig) % gsz); u.pn = (wgid % nig) / gsz;
    }
    __device__ __forceinline__ bool next(int i, Unit& u) const { const long L = (long)i * G + c; if (L >= nwg) return false; tile_of((int)L, u); u.sub = 0; return true; }
    __device__ __forceinline__ const char* aptr(const Unit& u) const { return A + (size_t)u.pm * tA; }
    __device__ __forceinline__ const char* bptr(const Unit& u) const { return B + (size_t)u.pn * tB; }
};
struct SplitOrder {
    int pm, pn, part; bool have; const char* A; const char* B;
    __device__ __forceinline__ bool next(int i, Unit& u) const { if (i > 0 || !have) return false; u.pm = pm; u.pn = pn; u.sub = part; return true; }
    __device__ __forceinline__ const char* aptr(const Unit&) const { return A; }
    __device__ __forceinline__ const char* bptr(const Unit&) const { return B; }
};
struct ChainOrder : RectOrder {
    int nsub, map; size_t sA, sB;
    __device__ __forceinline__ bool next(int i, Unit& u) const { const int su = i / nsub; const long L = (long)su * G + c; if (L >= nwg) return false; tile_of((int)L, u); u.sub = i - su * nsub; return true; }
    __device__ __forceinline__ const char* aptr(const Unit& u) const { return A + (size_t)u.pm * tA + (size_t)((map >> (4 * u.sub)) & 15) * sA; }
    __device__ __forceinline__ const char* bptr(const Unit& u) const { return B + (size_t)u.pn * tB + (size_t)((map >> (4 * u.sub)) & 15) * sB; }
};

template <class Epi, class Sched, bool ALIGN_EPI, bool HALFN = false>
__device__ __forceinline__ void gemm_phase(LAS unsigned char* lds, const int K, const int lda, const int ldb, const Sched& S, const Epi& E) {
    const int tid = fresh_tid(), wid = __builtin_amdgcn_readfirstlane(tid >> 6), lane = tid & 63, wr = wid >> 2, wc = wid & 3, fr = lane & 15, fq = lane >> 4;
    const int nt = K / BK;
    unsigned voffA[2], voffB[2];
#pragma unroll
    for (int i = 0; i < 2; ++i) { int R, C; stage_rc(tid * 16 + i * 8192, R, C); const int Rb = Epi::PERM ? ((R & ~31) + perm32(R & 31)) : R;
        voffA[i] = (unsigned)(R * lda + C) * 2u; voffB[i] = (unsigned)(Rb * ldb + C) * 2u; }
    const size_t kstep = (size_t)(BK * 2);
    const size_t hstepA = (size_t)HALF * lda * 2, hstepB = (size_t)HALF * ldb * 2;
    const unsigned ldsw = (unsigned)wid * 1024u;
    const int aoff = lds_byte(wr * 64 + fr, fq * 8), boff = lds_byte(wc * 32 + fr, fq * 8);
#define PG8_SA(b, h) (((b) * 2 + (h)) * HTB)
#define PG8_SB(b, h) ((4 + (b) * 2 + (h)) * HTB)
#define PG8_STAGE(bufoff, gbase, voff) do { _Pragma("unroll") for (int _i = 0; _i < 2; ++_i) \
        __builtin_amdgcn_global_load_lds((const unsigned*)((const char*)(gbase) + (voff)[_i]), (LAS unsigned*)(lds + (bufoff) + ldsw + _i * 8192), 16, 0, 0); } while (0)
#define PG8_LDA(dst, b, h) do { _Pragma("unroll") for (int m = 0; m < 4; ++m) _Pragma("unroll") for (int k = 0; k < 2; ++k) dst[m][k] = *(const LAS bf16x8*)(lds + PG8_SA(b, h) + aoff + m * 2048 + k * 1024); } while (0)
#define PG8_LDB(dst, b, h) do { _Pragma("unroll") for (int n = 0; n < 2; ++n) _Pragma("unroll") for (int k = 0; k < 2; ++k) dst[n][k] = *(const LAS bf16x8*)(lds + PG8_SB(b, h) + boff + n * 2048 + k * 1024); } while (0)
#define PG8_MMA(ai, bj, At, Bt) do { __builtin_amdgcn_s_setprio(1); _Pragma("unroll") for (int m = 0; m < 4; ++m) _Pragma("unroll") for (int n = 0; n < 2; ++n) _Pragma("unroll") for (int k = 0; k < 2; ++k) \
        acc[ai][bj][m][n] = __builtin_amdgcn_mfma_f32_16x16x32_bf16(Bt[n][k], At[m][k], acc[ai][bj][m][n], 0, 0, 0); __builtin_amdgcn_s_setprio(0); } while (0)
#define PG8_WAIT_V(n) asm volatile("s_waitcnt vmcnt(" #n ")" ::: "memory")
#define PG8_WAIT_L(n) asm volatile("s_waitcnt lgkmcnt(" #n ")" ::: "memory")
#define PG8_WAIT_VH do { if constexpr (HALFN) PG8_WAIT_V(6); else PG8_WAIT_V(8); } while (0)
#define PG8_BAR __builtin_amdgcn_s_barrier()
#define PG8_SCHED __builtin_amdgcn_sched_barrier(0)
    Unit cur, nxt; int ui = 0;
    if (!S.next(0, cur)) return;
    f32x4 acc[2][2][4][2];
#pragma unroll
    for (int a = 0; a < 2; ++a)
#pragma unroll
        for (int b = 0; b < 2; ++b)
#pragma unroll
            for (int m = 0; m < 4; ++m)
#pragma unroll
                for (int n = 0; n < 2; ++n) acc[a][b][m][n] = (f32x4){0.f, 0.f, 0.f, 0.f};
    bf16x8 At[4][2], B0[2][2], B1[2][2];
    const char* cA = S.aptr(cur); const char* cB = S.bptr(cur);
    PG8_STAGE(PG8_SB(0, 0), cB, voffB); if constexpr (!HALFN) PG8_STAGE(PG8_SB(0, 1), cB + hstepB, voffB); PG8_STAGE(PG8_SA(0, 0), cA, voffA); PG8_STAGE(PG8_SA(0, 1), cA + hstepA, voffA);
    if (wr == 1) PG8_BAR;
    PG8_WAIT_V(2); PG8_BAR;
    PG8_STAGE(PG8_SB(1, 0), cB + kstep, voffB); PG8_STAGE(PG8_SA(1, 0), cA + kstep, voffA); if constexpr (!HALFN) PG8_STAGE(PG8_SB(1, 1), cB + hstepB + kstep, voffB);
    if constexpr (HALFN) PG8_WAIT_V(4); else PG8_WAIT_V(6);
    PG8_BAR;
    for (;;) {
        const bool has_next = S.next(ui + 1, nxt);
        const char* nA = has_next ? S.aptr(nxt) : cA; const char* nB = has_next ? S.bptr(nxt) : cB;
#pragma unroll 1
        for (int t = 0; t < nt; t += 2) {
            const bool last = (t == nt - 2);
            const char* a1 = cA + (size_t)(t + 1) * kstep;
            const char* a2 = last ? nA : cA + (size_t)(t + 2) * kstep; const char* b2 = last ? nB : cB + (size_t)(t + 2) * kstep;
            const char* a3 = a2 + kstep; const char* b3 = b2 + kstep;
            PG8_LDB(B0, 0, 0); if constexpr (!HALFN) PG8_LDB(B1, 0, 1); PG8_SCHED; PG8_LDA(At, 0, 0); PG8_STAGE(PG8_SA(1, 1), a1 + hstepA, voffA);
            PG8_WAIT_VH; PG8_WAIT_L(0); PG8_BAR; PG8_MMA(0, 0, At, B0); if constexpr (!HALFN) PG8_MMA(0, 1, At, B1); PG8_BAR; PG8_SCHED;
            PG8_LDA(At, 0, 1); PG8_STAGE(PG8_SB(0, 0), b2, voffB); if constexpr (!HALFN) PG8_STAGE(PG8_SB(0, 1), b2 + hstepB, voffB); PG8_STAGE(PG8_SA(0, 0), a2, voffA);
            PG8_WAIT_VH; PG8_WAIT_L(0); PG8_BAR; PG8_MMA(1, 0, At, B0); if constexpr (!HALFN) PG8_MMA(1, 1, At, B1); PG8_BAR; PG8_SCHED;
            PG8_LDB(B0, 1, 0); if constexpr (!HALFN) PG8_LDB(B1, 1, 1); PG8_SCHED; PG8_LDA(At, 1, 0); PG8_STAGE(PG8_SA(0, 1), a2 + hstepA, voffA);
            PG8_WAIT_VH; PG8_WAIT_L(0); PG8_BAR; PG8_MMA(0, 0, At, B0); if constexpr (!HALFN) PG8_MMA(0, 1, At, B1); PG8_BAR; PG8_SCHED;
            PG8_LDA(At, 1, 1); PG8_STAGE(PG8_SB(1, 0), b3, voffB); if constexpr (!HALFN) PG8_STAGE(PG8_SB(1, 1), b3 + hstepB, voffB); PG8_STAGE(PG8_SA(1, 0), a3, voffA);
            PG8_WAIT_VH; PG8_WAIT_L(0); PG8_BAR; PG8_MMA(1, 0, At, B0); if constexpr (!HALFN) PG8_MMA(1, 1, At, B1); PG8_BAR; PG8_SCHED;
        }
        if constexpr (ALIGN_EPI) { if (wr == 0) PG8_BAR; }
        const bool keep = E(acc, cur, wr, wc, fr, fq);
        if (!has_next) break;
        if (!keep) {
#pragma unroll
        for (int a = 0; a < 2; ++a)
#pragma unroll
            for (int b = 0; b < 2; ++b)
#pragma unroll
                for (int m = 0; m < 4; ++m)
#pragma unroll
                    for (int n = 0; n < 2; ++n) acc[a][b][m][n] = (f32x4){0.f, 0.f, 0.f, 0.f};
        }
        cur = nxt; cA = nA; cB = nB; ++ui;
        if constexpr (ALIGN_EPI) { if (wr == 1) PG8_BAR; }
    }
    PG8_WAIT_V(0);
    if constexpr (!ALIGN_EPI) { if (wr == 0) PG8_BAR; }
    PG8_BAR;
#undef PG8_SA
#undef PG8_SB
#undef PG8_STAGE
#undef PG8_LDA
#undef PG8_LDB
#undef PG8_MMA
#undef PG8_WAIT_V
#undef PG8_WAIT_L
#undef PG8_WAIT_VH
#undef PG8_BAR
#undef PG8_SCHED
}
}

constexpr size_t MiB = 1u << 20;
constexpr size_t WS_CTL = 0, CTL_ZERO_BYTES = 1 * MiB;
constexpr size_t WS_MOD = 1 * MiB;
constexpr size_t WS_TAB = 2 * MiB;
constexpr size_t WS_SSP = 2 * MiB + 65536;
constexpr size_t WS_XC = 3 * MiB;
constexpr size_t WS_H = 11 * MiB;
constexpr size_t WS_Y = 79 * MiB;
constexpr size_t WS_HB = 147 * MiB;
constexpr size_t WS_YBR = 164 * MiB;
constexpr size_t WS_QM = 232 * MiB;
constexpr size_t WS_KN = 258 * MiB;
constexpr size_t WS_VTM = 275 * MiB;
constexpr size_t WS_Z = 292 * MiB;
constexpr size_t WS_W = 692 * MiB;
constexpr size_t WL_GU = 0, WL_D = 86 * MiB, WL_IN = 129 * MiB, WL_UQ = 176 * MiB, WL_KV = 177 * MiB, WL_BR = 178 * MiB, WL_OUT = 186 * MiB, WL_GMW = 194 * MiB, WL_BZ = 194 * MiB + 262144, WL_SIZE = 195 * MiB;
constexpr size_t WS_VTD = WS_W + DEPTH * WL_SIZE;
constexpr size_t WS_XB = WS_VTD + 9 * MiB;
constexpr size_t WS_END = WS_XB + 68 * MiB;
static_assert(WS_SSP + (size_t)MT * 12 * 4 <= WS_XC && WS_XC + (size_t)MC * D * 4 <= WS_H && WS_H + (size_t)MT * D * 2 <= WS_Y && WS_Y + (size_t)MT * D * 2 <= WS_HB, "ws map 1");
static_assert(WS_HB + (size_t)MT * 512 * 2 <= WS_YBR && WS_YBR + (size_t)4 * MT * 512 * 2 <= WS_QM && WS_QM + (size_t)MT * 768 * 2 <= WS_KN && WS_KN + (size_t)MT * 512 * 2 <= WS_VTM && WS_VTM + (size_t)512 * MT * 2 <= WS_Z && WS_Z + (size_t)MT * NZ * 2 <= WS_W, "ws map 2");
static_assert((size_t)2 * NGU * D * 2 <= WL_D && WL_D + (size_t)2 * D * DFF * 2 <= WL_IN && WL_IN + (size_t)NZW * D * 2 <= WL_UQ && WL_UQ + 768 * 512 * 2 <= WL_KV && WL_KV + 1024 * 256 * 2 <= WL_BR && WL_BR + (size_t)4 * D * 512 * 2 <= WL_OUT && WL_OUT + (size_t)D * D * 2 <= WL_GMW && WL_GMW + 4 * 128 * 128 * 2 <= WL_BZ && WL_BZ + NZW * 4 <= WL_SIZE, "weight map");
static_assert((size_t)DEPTH * 5 * NMOD * 4 <= 1 * MiB, "mod");
constexpr int CW_BAR = 4096;

constexpr int RING_BYTES = 131072, MISC_OFF = RING_BYTES + 320, LTAB_OFF = RING_BYTES + 2048  , LDS_BYTES = 147456;

#define XB_TMO      128
#define XB_XCNT(j)  (256  + 64 * (j))
#define XB_XSUB(j)  (1280 + 64 * (j))
#define XB_XGEN(j)  (2304 + 64 * (j))
#define XB_TOP      3328
#define XB_TOPGEN   3392
#define XCD_BAR_WORDS 3456
#define XB_SPIN_CAP (1u << 20)
__device__ __forceinline__ unsigned xb_ld(unsigned* p)              { return __hip_atomic_load(p, __ATOMIC_RELAXED, __HIP_MEMORY_SCOPE_AGENT); }
__device__ __forceinline__ unsigned xb_add(unsigned* p, unsigned v) { return __hip_atomic_fetch_add(p, v, __ATOMIC_RELAXED, __HIP_MEMORY_SCOPE_AGENT); }
__device__ __forceinline__ unsigned xb_xcc_id() { return (unsigned)__builtin_amdgcn_s_getreg((3 << 11) | 20) & 0xFu; }
#define XB_SPIN(cond, bar) do { unsigned _sp = 0; while (cond) { __builtin_amdgcn_s_sleep(1); \
    if ((++_sp & 255u) == 0u) { if (xb_ld(&(bar)[XB_TMO])) break; if (_sp > XB_SPIN_CAP) { atomicAdd(&(bar)[XB_TMO], 1u); break; } } } } while (0)
struct XcdBarrier { unsigned* bar; unsigned x; volatile LAS unsigned* st; };
__device__ __forceinline__ XcdBarrier xcd_barrier_post(unsigned* bar, volatile LAS unsigned* st) {
    XcdBarrier b; b.bar = bar; b.x = xb_xcc_id(); b.st = st;
    if (threadIdx.x == 0) (void)xb_add(&bar[XB_XCNT(b.x)], 1u);
    return b;
}
__device__ __forceinline__ void xcd_barrier_complete(unsigned* bar, unsigned x, unsigned& nloc, unsigned& nx) {
    const unsigned G = gridDim.x * gridDim.y * gridDim.z;
    unsigned sum, cnt, mine, sp = 0u;
    for (;;) {
        sum = 0u; cnt = 0u; mine = 0u;
#pragma unroll
        for (unsigned j = 0; j < 16; ++j) { const unsigned c = xb_ld(&bar[XB_XCNT(j)]); sum += c; cnt += (c > 0u) ? 1u : 0u; mine = (j == x) ? c : mine; }
        if (sum == G) break;
        __builtin_amdgcn_s_sleep(1);
        if ((++sp & 255u) == 0u) { if (xb_ld(&bar[XB_TMO])) break; if (sp > XB_SPIN_CAP) { atomicAdd(&bar[XB_TMO], 1u); break; } }
    }
    nloc = mine > 0u ? mine : 1u; nx = cnt > 0u ? cnt : 1u;
}
__device__ __forceinline__ void xcd_barrier(const XcdBarrier& b) {
    asm volatile("s_waitcnt vmcnt(0)" ::: "memory");
    __syncthreads();
    if (threadIdx.x == 0) {
        unsigned* bar = b.bar;
        __builtin_amdgcn_s_waitcnt(0);
        unsigned nloc = b.st[0], nx = b.st[1];
        if (nloc == 0u) { xcd_barrier_complete(bar, b.x, nloc, nx); b.st[0] = nloc; b.st[1] = nx; }
        const unsigned old = xb_add(&bar[XB_XSUB(b.x)], 1u);
        const unsigned gen = old / nloc;
        if (old + 1u == (gen + 1u) * nloc) {
            __builtin_amdgcn_fence(__ATOMIC_RELEASE, "agent");
            asm volatile("s_waitcnt vmcnt(0)" ::: "memory");
            const unsigned og = xb_add(&bar[XB_TOP], 1u);
            const unsigned tg = og / nx;
            if (og + 1u == (tg + 1u) * nx) xb_add(&bar[XB_TOPGEN], 1u);
            else XB_SPIN(xb_ld(&bar[XB_TOPGEN]) == tg, bar);
            __builtin_amdgcn_fence(__ATOMIC_ACQUIRE, "agent");
            xb_add(&bar[XB_XGEN(b.x)], 1u);
            asm volatile("s_waitcnt vmcnt(0)" ::: "memory");
        } else {
            XB_SPIN(xb_ld(&bar[XB_XGEN(b.x)]) == gen, bar);
            __builtin_amdgcn_fence(__ATOMIC_ACQUIRE, "agent");
            asm volatile("s_waitcnt vmcnt(0)" ::: "memory");
        }
    }
    __syncthreads();
}

constexpr int RING_BYTES_C = 131072;
struct Params { const float* in[28]; float* out; unsigned char* ws; int ph_lo, ph_hi; };
enum { I_X = 0, I_C, I_CTX, I_CCTX, I_WMOD, I_BMOD, I_NPRE, I_NPOST, I_WG, I_WU, I_WD, I_WIN, I_BIN, I_GMLNG, I_GMLNB, I_GMWS, I_GMBS, I_CVDW, I_CVDB, I_CVLNG, I_CVLNB, I_QNORM, I_KVNORM, I_WUQ, I_WUKV, I_SINK, I_WBR, I_WOUT };

constexpr int PTAB_OFF = RING_BYTES_C + 1024;
struct Ctx { volatile LAS unsigned* tab;
    __device__ __forceinline__ unsigned long long get(int i) const { const unsigned lo = __builtin_amdgcn_readfirstlane(tab[2 * i]), hi = __builtin_amdgcn_readfirstlane(tab[2 * i + 1]); return ((unsigned long long)hi << 32) | lo; }
    __device__ __forceinline__ const float* in(int i) const { return (const float*)(const GAS float*)get(i); }
    __device__ __forceinline__ float* out() const { return (float*)(GAS float*)get(28); }
    __device__ __forceinline__ unsigned char* ws() const { return (unsigned char*)(GAS unsigned char*)get(29); }
};
#define WSP(T, off) ((T*)(ws + (off)))
#define WLP(T, l, off) ((T*)(ws + WS_W + (size_t)(l) * WL_SIZE + (off)))

namespace pg8 {
struct EpiSwiglu { static constexpr bool PERM = true; bf16_t* O;
    __device__ __forceinline__ bool operator()(f32x4 (&acc)[2][2][4][2], const Unit& u, int wr, int wc, int fr, int fq) const {
        const int row0 = u.pm * BM + wr * 64 + fr, col0 = u.pn * HALF + wc * 32 + 8 * fq;
#pragma unroll
        for (int ai = 0; ai < 2; ++ai)
#pragma unroll
            for (int m = 0; m < 4; ++m) { bf16_t* rowp = O + (size_t)(row0 + ai * HALF + m * 16) * DFF + col0; f32x4 v[2];
#pragma unroll
                for (int n = 0; n < 2; ++n) { const f32x4 g = acc[ai][0][m][n], up = acc[ai][1][m][n];
                    const f32x4 t = g * (-LOG2E); const f32x4 e = (f32x4){fast_exp2(t[0]), fast_exp2(t[1]), fast_exp2(t[2]), fast_exp2(t[3])} + 1.0f;
                    v[n] = (g * up) * (f32x4){fast_rcp(e[0]), fast_rcp(e[1]), fast_rcp(e[2]), fast_rcp(e[3])}; }
                u32x4 w; w.x = cvt_pk_bf16(v[0][0], v[0][1]); w.y = cvt_pk_bf16(v[0][2], v[0][3]); w.z = cvt_pk_bf16(v[1][0], v[1][1]); w.w = cvt_pk_bf16(v[1][2], v[1][3]);
                *(u32x4*)rowp = w; }
        return false;
    }
};
template <bool RS> struct EpiPlain { static constexpr bool PERM = true; bf16_t* O; int ldc; const float* ssp;
    __device__ __forceinline__ bool operator()(f32x4 (&acc)[2][2][4][2], const Unit& u, int wr, int wc, int fr, int fq) const {
        const int row0 = u.pm * BM + wr * 64 + fr, col0 = u.pn * BM + wc * 32 + 8 * fq;
        f32x4 pr[2][4];
        if (RS) {
#pragma unroll
            for (int ai = 0; ai < 2; ++ai)
#pragma unroll
                for (int m = 0; m < 4; ++m) pr[ai][m] = *(const f32x4*)(ssp + (size_t)(row0 + ai * HALF + m * 16) * 12 + 8);
            __builtin_amdgcn_sched_barrier(0);
        }
#pragma unroll
        for (int ai = 0; ai < 2; ++ai)
#pragma unroll
            for (int m = 0; m < 4; ++m) { const int row = row0 + ai * HALF + m * 16; bf16_t* rowp = O + (size_t)row * ldc + col0; float sc = 1.f;
                if (RS) { const f32x4 p = pr[ai][m]; sc = __builtin_amdgcn_rsqf(((p[0] + p[1]) + (p[2] + p[3])) * (1.f / 256.f) + EPS); }
#pragma unroll
                for (int bj = 0; bj < 2; ++bj) { const f32x4 v0 = acc[ai][bj][m][0] * sc, v1 = acc[ai][bj][m][1] * sc;
                    u32x4 w; w.x = cvt_pk_bf16(v0[0], v0[1]); w.y = cvt_pk_bf16(v0[2], v0[3]); w.z = cvt_pk_bf16(v1[0], v1[1]); w.w = cvt_pk_bf16(v1[2], v1[3]);
                    *(u32x4*)(rowp + bj * HALF) = w; } }
        return false;
    }
};
struct EpiPartial { static constexpr bool PERM = false; float* P; int row_base; size_t pstride;
    __device__ __forceinline__ bool operator()(f32x4 (&acc)[2][2][4][2], const Unit& u, int wr, int wc, int fr, int fq) const {
        const int row0 = u.pm * BM - row_base + wr * 64 + fr, col0 = u.pn * BM + wc * 32 + 4 * fq; float* base = P + (size_t)u.sub * pstride;
#pragma unroll
        for (int ai = 0; ai < 2; ++ai)
#pragma unroll
            for (int m = 0; m < 4; ++m) { float* rowp = base + (size_t)(row0 + ai * HALF + m * 16) * D + col0;
#pragma unroll
                for (int bj = 0; bj < 2; ++bj)
#pragma unroll
                    for (int n = 0; n < 2; ++n) *(f32x4*)(rowp + bj * HALF + n * 16) = acc[ai][bj][m][n]; }
        return false;
    }
};
__device__ __forceinline__ void rope4(f32x4& v0, f32x4& v1, const LAS float* tab) {
    const f32x4 t0 = *(const LAS f32x4*)tab, t1 = *(const LAS f32x4*)(tab + 4);
    const float c[4] = {t0[0], t0[2], t1[0], t1[2]}, s[4] = {t0[1], t0[3], t1[1], t1[3]};
#pragma unroll
    for (int i = 0; i < 4; ++i) { const float a = v0[i], b = v1[i]; v0[i] = a * c[i] - b * s[i]; v1[i] = b * c[i] + a * s[i]; }
}
struct EpiQ { static constexpr bool PERM = true; bf16_t* O; const float* ssp; const LAS float* tab;
    __device__ __forceinline__ bool operator()(f32x4 (&acc)[2][2][4][2], const Unit& u, int wr, int wc, int fr, int fq) const {
        const int row0 = u.pm * BM + wr * 64 + fr, col0 = u.pn * BM + wc * 32 + 8 * fq;
        const float qs = 0.07216878364870322f * LOG2E;
#pragma unroll
        for (int ai = 0; ai < 2; ++ai) {
        f32x4 pr0[4], pr1[4];
#pragma unroll
        for (int m = 0; m < 4; ++m) { const size_t ro = (size_t)(row0 + ai * HALF + m * 16) * 12; pr0[m] = *(const f32x4*)(ssp + ro); pr1[m] = *(const f32x4*)(ssp + ro + 4); }
        __builtin_amdgcn_sched_barrier(0);
#pragma unroll
            for (int m = 0; m < 4; ++m) { const int row = row0 + ai * HALF + m * 16; bf16_t* rowp = O + (size_t)row * 768 + col0;
                const f32x4 p0 = pr0[m], p1 = pr1[m];
                const float sc = __builtin_amdgcn_rsqf((((p0[0] + p0[1]) + (p0[2] + p0[3])) + ((p1[0] + p1[1]) + (p1[2] + p1[3]))) * (1.f / 512.f) + EPS) * qs;
                const int t = row & (SEQ - 1); const bool lat = row < ML;
#pragma unroll
                for (int bj = 0; bj < 2; ++bj) { const int grp = (u.pn * 8 + bj * 4 + wc) % 6;
                    f32x4 v0 = acc[ai][bj][m][0] * sc, v1 = acc[ai][bj][m][1] * sc;
                    if (grp >= 4 && lat) { const int pos = (grp == 4) ? (t >> 6) : (t & 63); rope4(v0, v1, tab + (pos * 16 + 4 * fq) * 2); }
                    u32x4 w; w.x = cvt_pk_bf16(v0[0], v0[1]); w.y = cvt_pk_bf16(v0[2], v0[3]); w.z = cvt_pk_bf16(v1[0], v1[1]); w.w = cvt_pk_bf16(v1[2], v1[3]);
                    *(u32x4*)(rowp + bj * HALF) = w; } }
        __builtin_amdgcn_sched_barrier(0); }
        return false;
    }
};
struct EpiZ { static constexpr bool PERM = true; bf16_t* Z; bf16_t* HB; float* ssp; const float* bias; const LAS float* tab; int pn_off, row_base;
    __device__ __forceinline__ bool operator()(f32x4 (&acc)[2][2][4][2], const Unit& u, int wr, int wc, int fr, int fq) const {
        const int pn = u.pn + pn_off;
        const int row0 = row_base + u.pm * BM + wr * 64 + fr, col0 = pn * BM + wc * 32 + 8 * fq;
        f32x4 bv[2][2];
#pragma unroll
        for (int bj = 0; bj < 2; ++bj)
#pragma unroll
            for (int n = 0; n < 2; ++n) bv[bj][n] = *(const f32x4*)(bias + col0 + bj * HALF + 4 * n);
        if (pn >= 4 && pn < 8) {
#pragma unroll
            for (int ai = 0; ai < 2; ++ai)
#pragma unroll
                for (int m = 0; m < 4; ++m) { bf16_t* rowp = HB + (size_t)(row0 + ai * HALF + m * 16) * 512 + (pn - 4) * HALF + wc * 32 + 8 * fq; float h[8];
#pragma unroll
                    for (int n = 0; n < 2; ++n) { const f32x4 a = acc[ai][0][m][n] + bv[0][n], gt = acc[ai][1][m][n] + bv[1][n];
                        const f32x4 hv = a * sigmoid4(gt); h[4 * n] = hv[0]; h[4 * n + 1] = hv[1]; h[4 * n + 2] = hv[2]; h[4 * n + 3] = hv[3]; }
                    u32x4 w; w.x = cvt_pk_bf16(h[0], h[1]); w.y = cvt_pk_bf16(h[2], h[3]); w.z = cvt_pk_bf16(h[4], h[5]); w.w = cvt_pk_bf16(h[6], h[7]); *(u32x4*)rowp = w; }
        } else {
#pragma unroll
        for (int ai = 0; ai < 2; ++ai)
#pragma unroll
            for (int m = 0; m < 4; ++m) { const int row = row0 + ai * HALF + m * 16; bf16_t* rowp = Z + (size_t)row * NZ + col0; float ss = 0.f;
                const int t = row & (SEQ - 1); const bool lat = row < ML;
#pragma unroll
                for (int bj = 0; bj < 2; ++bj) { f32x4 v0 = acc[ai][bj][m][0] + bv[bj][0], v1 = acc[ai][bj][m][1] + bv[bj][1];
                    if (pn < 4) {
#pragma unroll
                        for (int i = 0; i < 4; ++i) { v0[i] = gelu1(v0[i]); v1[i] = gelu1(v1[i]); }
                    } else if (pn < 11) {
#pragma unroll
                        for (int i = 0; i < 4; ++i) ss += v0[i] * v0[i] + v1[i] * v1[i];
                    } else if (pn < 14) { const int grp = pn * 8 + bj * 4 + wc;
                        if (grp >= 88 && grp < 110 && lat) { const int pos = (grp & 1) ? (t & 63) : (t >> 6); rope4(v0, v1, tab + (pos * 16 + 4 * fq) * 2); }
                        if (grp >= 90 && grp < 106) { v0 = v0 * (0.125f * LOG2E); v1 = v1 * (0.125f * LOG2E); }
                    } else {
                        v0 = sigmoid4(v0); v1 = sigmoid4(v1);
                    }
                    u32x4 w; w.x = cvt_pk_bf16(v0[0], v0[1]); w.y = cvt_pk_bf16(v0[2], v0[3]); w.z = cvt_pk_bf16(v1[0], v1[1]); w.w = cvt_pk_bf16(v1[2], v1[3]);
                    *(u32x4*)(rowp + bj * HALF) = w; }
                if (pn >= 8 && pn < 11) { ss += __shfl_xor(ss, 16); ss += __shfl_xor(ss, 32); ssp[(size_t)row * 12 + (pn - 8) * 4 + wc] = ss; } }
        }
        asm volatile("" :: "v"(bv[0][0]), "v"(bv[0][1]), "v"(bv[1][0]), "v"(bv[1][1]));
        return false;
    }
};
template <bool COLSCALE> struct EpiVt { static constexpr bool PERM = true; bf16_t* O; int ldc; const float* rbias; const float* ssp;
    __device__ __forceinline__ bool operator()(f32x4 (&acc)[2][2][4][2], const Unit& u, int wr, int wc, int fr, int fq) const {
        const int row0 = u.pm * BM + wr * 64 + fr, col0 = u.pn * BM + wc * 32 + 8 * fq;
        float sc[2][8];
        if (COLSCALE) {
#pragma unroll
            for (int bj = 0; bj < 2; ++bj) { f32x4 pc[8];
#pragma unroll
                for (int e = 0; e < 8; ++e) pc[e] = *(const f32x4*)(ssp + (size_t)(col0 + bj * HALF + e) * 12 + 8);
                __builtin_amdgcn_sched_barrier(0);
#pragma unroll
                for (int e = 0; e < 8; ++e) { const f32x4 p = pc[e]; sc[bj][e] = __builtin_amdgcn_rsqf(((p[0] + p[1]) + (p[2] + p[3])) * (1.f / 256.f) + EPS); }
                __builtin_amdgcn_sched_barrier(0); }
        } else {
#pragma unroll
            for (int bj = 0; bj < 2; ++bj)
#pragma unroll
                for (int e = 0; e < 8; ++e) sc[bj][e] = 1.f;
        }
        float rbv[2][4];
#pragma unroll
        for (int ai = 0; ai < 2; ++ai)
#pragma unroll
            for (int m = 0; m < 4; ++m) rbv[ai][m] = COLSCALE ? 0.f : rbias[row0 + ai * HALF + m * 16];
        __builtin_amdgcn_sched_barrier(0);
#pragma unroll
        for (int ai = 0; ai < 2; ++ai)
#pragma unroll
            for (int m = 0; m < 4; ++m) { const int row = row0 + ai * HALF + m * 16; bf16_t* rowp = O + (size_t)row * ldc + col0; const float rb = rbv[ai][m];
#pragma unroll
                for (int bj = 0; bj < 2; ++bj) { const f32x4 a0 = acc[ai][bj][m][0] + rb, a1 = acc[ai][bj][m][1] + rb;
                    u32x4 w; w.x = cvt_pk_bf16(a0[0] * sc[bj][0], a0[1] * sc[bj][1]); w.y = cvt_pk_bf16(a0[2] * sc[bj][2], a0[3] * sc[bj][3]); w.z = cvt_pk_bf16(a1[0] * sc[bj][4], a1[1] * sc[bj][5]); w.w = cvt_pk_bf16(a1[2] * sc[bj][6], a1[3] * sc[bj][7]);
                    *(u32x4*)(rowp + bj * HALF) = w; } }
        return false;
    }
};
struct EpiM1 { static constexpr bool PERM = true; const bf16_t* Z; bf16_t* T; int nlast, map;
    __device__ __forceinline__ void loadb(const bf16_t* sp, const bf16_t* sp2, int b, u32x4 (&s)[2][2], u32x4 (&s2)[2][2]) const {
#pragma unroll
        for (int mm = 0; mm < 2; ++mm)
#pragma unroll
            for (int bj = 0; bj < 2; ++bj) { const size_t ro = (size_t)((b >> 1) * HALF + (2 * (b & 1) + mm) * 16) * NZ + bj * HALF; s[mm][bj] = *(const u32x4*)(sp + ro); s2[mm][bj] = *(const u32x4*)(sp2 + ro); }
    }
    __device__ __forceinline__ bool operator()(f32x4 (&acc)[2][2][4][2], const Unit& u, int wr, int wc, int fr, int fq) const {
        const int row0 = u.pm * BM + wr * 64 + fr, col0 = u.pn * BM + wc * 32 + 8 * fq; const int sub = u.sub;
        const int br = (map >> (4 * sub)) & 15, br2 = (map >> (4 * sub + 4)) & 15; const bool mid = sub < nlast;
        const bf16_t* sp = Z + (size_t)row0 * NZ + ZC_G + br * D + col0; const bf16_t* sp2 = Z + (size_t)row0 * NZ + ZC_G + (mid ? br2 : br) * D + col0;
        u32x4 sA[2][2], s2A[2][2], sB[2][2], s2B[2][2];
        loadb(sp, sp2, 0, sA, s2A);
#pragma unroll
        for (int b = 0; b < 4; ++b) {
            if (b + 1 < 4) { if (b & 1) loadb(sp, sp2, b + 1, sA, s2A); else loadb(sp, sp2, b + 1, sB, s2B); }
            __builtin_amdgcn_sched_barrier(0);
            const int ai = b >> 1, mp = b & 1;
#pragma unroll
            for (int mm = 0; mm < 2; ++mm)
#pragma unroll
                for (int bj = 0; bj < 2; ++bj) { const int m = 2 * mp + mm; const u32x4 a = (b & 1) ? sB[mm][bj] : sA[mm][bj], c = (b & 1) ? s2B[mm][bj] : s2A[mm][bj];
                    float g[8] = {bflo(a.x), bfhi(a.x), bflo(a.y), bfhi(a.y), bflo(a.z), bfhi(a.z), bflo(a.w), bfhi(a.w)};
                    if (mid) { const float g2[8] = {bflo(c.x), bfhi(c.x), bflo(c.y), bfhi(c.y), bflo(c.z), bfhi(c.z), bflo(c.w), bfhi(c.w)};
#pragma unroll
                        for (int i = 0; i < 8; ++i) g[i] = g[i] * fast_rcp(__builtin_fmaxf(g2[i], 1e-30f));
#pragma unroll
                        for (int i = 0; i < 4; ++i) { acc[ai][bj][m][0][i] *= g[i]; acc[ai][bj][m][1][i] *= g[4 + i]; }
                    } else { f32x4 v0, v1; asm volatile("" :: "v"(c));
#pragma unroll
                        for (int i = 0; i < 4; ++i) { v0[i] = acc[ai][bj][m][0][i] * g[i]; v1[i] = acc[ai][bj][m][1][i] * g[4 + i]; }
                        u32x4 w; w.x = cvt_pk_bf16(v0[0], v0[1]); w.y = cvt_pk_bf16(v0[2], v0[3]); w.z = cvt_pk_bf16(v1[0], v1[1]); w.w = cvt_pk_bf16(v1[2], v1[3]);
                        *(u32x4*)(T + (size_t)(row0 + ai * HALF + m * 16) * D + col0 + bj * HALF) = w; } }
            __builtin_amdgcn_sched_barrier(0);
        }
        return mid;
    }
};
struct EpiM1H { static constexpr bool PERM = true; const bf16_t* Z; bf16_t* T; int nlast, map;
    __device__ __forceinline__ bool operator()(f32x4 (&acc)[2][2][4][2], const Unit& u, int wr, int wc, int fr, int fq) const {
        const int row0 = u.pm * BM + wr * 64 + fr, col0 = u.pn * HALF + wc * 32 + 8 * fq; const int sub = u.sub; const int br = (map >> (4 * sub)) & 15;
        const bf16_t* sp = Z + (size_t)row0 * NZ + ZC_G + br * D + col0;
        u32x4 s[2][4];
#pragma unroll
        for (int ai = 0; ai < 2; ++ai)
#pragma unroll
            for (int m = 0; m < 4; ++m) s[ai][m] = *(const u32x4*)(sp + (size_t)(ai * HALF + m * 16) * NZ);
        __builtin_amdgcn_sched_barrier(0);
#pragma unroll
        for (int ai = 0; ai < 2; ++ai)
#pragma unroll
            for (int m = 0; m < 4; ++m) { const u32x4 a = s[ai][m];
                const f32x4 g0 = (f32x4){bflo(a.x), bfhi(a.x), bflo(a.y), bfhi(a.y)}, g1 = (f32x4){bflo(a.z), bfhi(a.z), bflo(a.w), bfhi(a.w)};
                acc[ai][1][m][0] += g0 * acc[ai][0][m][0]; acc[ai][1][m][1] += g1 * acc[ai][0][m][1];
                acc[ai][0][m][0] = (f32x4){0.f, 0.f, 0.f, 0.f}; acc[ai][0][m][1] = (f32x4){0.f, 0.f, 0.f, 0.f};
                if (sub == nlast) { const f32x4 v0 = acc[ai][1][m][0], v1 = acc[ai][1][m][1];
                    u32x4 w; w.x = cvt_pk_bf16(v0[0], v0[1]); w.y = cvt_pk_bf16(v0[2], v0[3]); w.z = cvt_pk_bf16(v1[0], v1[1]); w.w = cvt_pk_bf16(v1[2], v1[3]);
                    *(u32x4*)(T + (size_t)(row0 + ai * HALF + m * 16) * D + col0) = w;
                    acc[ai][1][m][0] = (f32x4){0.f, 0.f, 0.f, 0.f}; acc[ai][1][m][1] = (f32x4){0.f, 0.f, 0.f, 0.f}; } }
        return true;
    }
};
}

#define LDS_WAIT() asm volatile("s_waitcnt lgkmcnt(0)" ::: "memory")
__device__ __forceinline__ void cvt_item(const float* W, int ldw, int srccol0, bf16_t* dst, int K, int k0, const float* kscale, LAS float* scr, int lane, bool perm) {
    const int sc8 = perm ? (((lane & 7) >> 1) + 4 * (lane & 1)) : (lane & 7);
    f32x4 v[8];
    float ksv[8];
#pragma unroll
    for (int i = 0; i < 8; ++i) ksv[i] = 1.f;
    if (kscale) {
#pragma unroll
        for (int i = 0; i < 8; ++i) ksv[i] = kscale[k0 + 8 * i + (lane >> 3)];
    }
    const int scc = srccol0 >= 0 ? srccol0 : 0; const float zf = srccol0 >= 0 ? 1.f : 0.f;
#pragma unroll
    for (int i = 0; i < 8; ++i) { const int kk = 8 * i + (lane >> 3);
        v[i] = __builtin_nontemporal_load((const f32x4*)(W + (size_t)(k0 + kk) * ldw + scc + sc8 * 4)); }
#pragma unroll
    for (int i = 0; i < 8; ++i) { const int kk = 8 * i + (lane >> 3); f32x4 x = v[i] * (zf * ksv[i]);
        LAS float* d = scr + kk * 33 + (lane & 7) * 4; d[0] = x[0]; d[1] = x[1]; d[2] = x[2]; d[3] = x[3]; }
    LDS_WAIT(); asm volatile("" ::: "memory");
    const int c = lane & 7;
#pragma unroll
    for (int j = 0; j < 4; ++j) { const int n = (lane >> 3) + 8 * j; const LAS float* s = scr + (8 * c) * 33 + n;
        u32x4 o; o.x = pk2(s[0 * 33], s[1 * 33]); o.y = pk2(s[2 * 33], s[3 * 33]); o.z = pk2(s[4 * 33], s[5 * 33]); o.w = pk2(s[6 * 33], s[7 * 33]);
        __builtin_nontemporal_store(o, (u32x4*)(dst + (size_t)n * K + k0 + 8 * c)); }
    LDS_WAIT(); asm volatile("" ::: "memory");
}
__device__ __forceinline__ int zsrc_col(int n) {
    if (n < 1024) return n;
    if (n < 2048) { const int t = (n - 1024) >> 8, j = (n - 1024) & 255; return j < 128 ? 1024 + 128 * t + j : 1536 + 128 * t + (j - 128); }
    if (n < 3520) return n;
    if (n < 3584) return -1;
    if (n < NZ) return n + 64;
    if (n < NZ + 128) return 3520 + (n - NZ);
    return -1;
}
constexpr int CV_GU = 2 * (NGU / 32) * (D / 64), CV_D = 2 * (D / 32) * (DFF / 64), CV_IN = (NZW / 32) * (D / 64), CV_UQ = (768 / 32) * (512 / 64), CV_KV = (1024 / 32) * (256 / 64),
              CV_BR = 4 * (D / 32) * (512 / 64), CV_OUT = (D / 32) * (D / 64), CV_LAYER = CV_GU + CV_D + CV_IN + CV_UQ + CV_KV + CV_BR + CV_OUT;
constexpr int CV_E0 = CV_GU / 2, CV_E1 = CV_E0 + CV_D / 2, CV_E2 = CV_E1 + CV_IN, CV_E3 = CV_E2 + CV_UQ, CV_E4 = CV_E3 + CV_KV, CV_E5 = CV_E4 + CV_BR, CV_E6 = CV_E5 + CV_OUT, CV_E7 = CV_E6 + CV_GU / 2, CV_E8 = CV_E7 + CV_D / 2;
static_assert(CV_E8 == CV_LAYER, "conversion item count");
constexpr int CW_QHEAD = 2048, CW_DONE = 2112;
__device__ __forceinline__ void cvt_item_idx(const Ctx& C, unsigned char* ws, int it, LAS float* scr, int lane) {
    const int l = it / CV_LAYER; int r = it - l * CV_LAYER;
    const float* W; int ldw, sc0, K, k0; bf16_t* dst; const float* ks = nullptr; bool perm = false;
    if (r < CV_E0 || (r >= CV_E6 && r < CV_E7)) { const int f = r >= CV_E6; if (f) r -= CV_E6; const int kb = r / (NGU / 32), nb = r - kb * (NGU / 32); const int n = nb * 32, tile = n >> 8, j = n & 255;
        W = (j < 128 ? C.in(I_WG) : C.in(I_WU)) + (size_t)(l * 2 + f) * D * DFF; ldw = DFF; sc0 = 128 * tile + (j & 127); dst = WLP(bf16_t, l, WL_GU) + ((size_t)f * NGU + n) * D; K = D; k0 = kb * 64; }
    else if (r < CV_E1 || r >= CV_E7) { const int f = r >= CV_E7; r -= f ? CV_E7 : CV_E0; const int kb = r / (D / 32), nb = r - kb * (D / 32);
        W = C.in(I_WD) + (size_t)(l * 2 + f) * DFF * D; ldw = D; sc0 = nb * 32; dst = WLP(bf16_t, l, WL_D) + ((size_t)f * D + nb * 32) * DFF; K = DFF; k0 = kb * 64; }
    else if (r < CV_E2) { r -= CV_E1; const int kb = r / (NZW / 32), nb = r - kb * (NZW / 32);
        W = C.in(I_WIN) + (size_t)l * D * NIN; ldw = NIN; sc0 = zsrc_col(nb * 32); perm = (nb >= ZC_KR / 32 && nb < 3520 / 32); dst = WLP(bf16_t, l, WL_IN) + (size_t)nb * 32 * D; K = D; k0 = kb * 64; }
    else if (r < CV_E3) { r -= CV_E2; const int kb = r / 24, nb = r - kb * 24;
        W = C.in(I_WUQ) + (size_t)l * 512 * 768; ldw = 768; sc0 = nb * 32; perm = (nb % 6) >= 4; dst = WLP(bf16_t, l, WL_UQ) + (size_t)nb * 32 * 512; K = 512; k0 = kb * 64; ks = C.in(I_QNORM) + l * 512; }
    else if (r < CV_E4) { r -= CV_E3; const int kb = r / 32, nb = r - kb * 32;
        W = C.in(I_WUKV) + (size_t)l * 256 * 1024; ldw = 1024; sc0 = (((nb * 32) & 511) >> 7) * 256 + ((nb * 32) >> 9) * 128 + ((nb * 32) & 127); dst = WLP(bf16_t, l, WL_KV) + (size_t)nb * 32 * 256; K = 256; k0 = kb * 64; ks = C.in(I_KVNORM) + l * 256; }
    else if (r < CV_E5) { r -= CV_E4; const int b = r / (CV_BR / 4); r -= b * (CV_BR / 4); const int kb = r / 64, nb = r - kb * 64;
        W = C.in(I_WBR) + (size_t)(l * 4 + b) * 512 * D; ldw = D; sc0 = nb * 32; dst = WLP(bf16_t, l, WL_BR) + ((size_t)b * D + nb * 32) * 512; K = 512; k0 = kb * 64; }
    else { r -= CV_E5; const int kb = r / 64, nb = r - kb * 64;
        W = C.in(I_WOUT) + (size_t)l * D * D; ldw = D; sc0 = nb * 32; dst = WLP(bf16_t, l, WL_OUT) + (size_t)nb * 32 * D; K = D; k0 = kb * 64; }
    cvt_item(W, ldw, sc0, dst, K, k0, ks, scr, lane, perm);
}
__device__ __forceinline__ void cvt_pull(const Ctx& C, LAS unsigned char* lds, int mand_end, int done_word  , int G) {
    const int tid = fresh_tid(), lane = tid & 63, wid = tid >> 6;
    volatile LAS unsigned* sh = (volatile LAS unsigned*)(lds + 8 * 8448);
    if (done_word && tid == 0) (void)__hip_atomic_fetch_add((unsigned*)(C.ws() + WS_CTL) + done_word, 1u, __ATOMIC_RELAXED, __HIP_MEMORY_SCOPE_AGENT);
    for (;;) {
        __syncthreads();
        if (tid == 0) { unsigned* const ctl = (unsigned*)(C.ws() + WS_CTL); const unsigned h = __hip_atomic_load(ctl + CW_QHEAD, __ATOMIC_RELAXED, __HIP_MEMORY_SCOPE_AGENT); bool go = false;
            if (h < (unsigned)(DEPTH * CV_LAYER)) { if (h < (unsigned)mand_end) go = true; else if (done_word && __hip_atomic_load(ctl + done_word, __ATOMIC_RELAXED, __HIP_MEMORY_SCOPE_AGENT) < (unsigned)G) go = true; }
            sh[0] = go ? __hip_atomic_fetch_add(ctl + CW_QHEAD, 16u, __ATOMIC_RELAXED, __HIP_MEMORY_SCOPE_AGENT) : 0xffffffffu; }
        __syncthreads();
        const unsigned base = sh[0];
        if (base == 0xffffffffu) break;
#pragma unroll 1
        for (int i = 0; i < 2; ++i) { const int it = (int)base + wid * 2 + i; if (it < DEPTH * CV_LAYER) cvt_item_idx(C, C.ws(), it, (LAS float*)(lds + wid * 8448), lane); }
    }
}
__device__ __forceinline__ void prologue_phase(const Ctx& C, LAS unsigned char* lds, int G, int bid) {
    unsigned char* const ws = C.ws();
    const int tid = fresh_tid(), lane = tid & 63, wid = tid >> 6;
    if (bid == 0) { float* tab = WSP(float, WS_TAB);
        for (int i = tid; i < 64 * 16; i += 512) { const int pos = i >> 4, f = i & 15; const float ang = (float)pos * exp2f(-(float)f * (13.287712379549449f / 16.f)); float s, c; sincosf(ang, &s, &c); tab[2 * i] = c; tab[2 * i + 1] = s; } }
    {
        LAS float* SC = (LAS float*)lds; LAS float* PART = (LAS float*)(lds + 40960);
        { const float* const cp = C.in(I_C); const float* const cc = C.in(I_CCTX); float xs[20];
#pragma unroll
          for (int j = 0; j < 20; ++j) { const int i = tid + 512 * j; xs[j] = j < 16 ? cp[i] : cc[i - 4 * D]; }
#pragma unroll
          for (int j = 0; j < 20; ++j) { const float x = xs[j]; SC[tid + 512 * j] = x / (1.f + expf(-x)); } }
        __syncthreads();
        const int kg = tid >> 3, ct = tid & 7;
        for (int it = bid; it < DEPTH * (NMOD / 32); it += G) { const int l = it / (NMOD / 32), ng = it - l * (NMOD / 32);
            const float* wp = C.in(I_WMOD) + ((size_t)l * D + kg * 32) * NMOD + ng * 32 + ct * 4;
            f32x4 a[5];
#pragma unroll
            for (int s = 0; s < 5; ++s) a[s] = (f32x4){0.f, 0.f, 0.f, 0.f};
#pragma unroll 1
            for (int k0 = 0; k0 < 32; k0 += 16) { f32x4 w[16];
#pragma unroll
                for (int kk = 0; kk < 16; ++kk) w[kk] = __builtin_nontemporal_load((const f32x4*)(wp + (size_t)(k0 + kk) * NMOD));
                __builtin_amdgcn_sched_barrier(0);
#pragma unroll
                for (int kk = 0; kk < 16; ++kk)
#pragma unroll
                    for (int s = 0; s < 5; ++s) a[s] += w[kk] * SC[s * D + kg * 32 + k0 + kk]; }
#pragma unroll
            for (int s = 0; s < 5; ++s) *(LAS f32x4*)(PART + (kg * 5 + s) * 32 + ct * 4) = a[s];
            __syncthreads();
            if (tid < 160) { const int s = tid >> 5, cc = tid & 31; float v = C.in(I_BMOD)[(size_t)l * NMOD + ng * 32 + cc];
                for (int k2 = 0; k2 < 64; ++k2) v += PART[(k2 * 5 + s) * 32 + cc];
                WSP(float, WS_MOD)[((size_t)l * 5 + s) * NMOD + ng * 32 + cc] = v; }
            __syncthreads();
        }
    }
    { const int gt = bid * 512 + tid, GT = G * 512;
        for (int i = gt; i < DEPTH * 65536; i += GT) { const int l = i >> 16; WLP(bf16_t, l, WL_GMW)[i & 65535] = (bf16_t)f2bf(C.in(I_GMWS)[i]); }
        for (int i = gt; i < DEPTH * NZW; i += GT) { const int l = i / NZW, n = i - l * NZW; int nn = n; if (n >= ZC_KR && n < 3520) { const int pp = n & 31; nn = (n & ~31) + 4 * (pp >> 3) + (pp & 3) + 16 * ((pp >> 2) & 1); }
            const int sc = zsrc_col(nn); WLP(float, l, WL_BZ)[n] = sc >= 0 ? C.in(I_BIN)[(size_t)l * NIN + sc] : 0.f; } }
    __syncthreads();
    cvt_pull(C, lds, CV_E0, 0, G);
}

struct NormArgs { const float* xin_lat; const float* xin_ctx; bf16_t* XB; float* outf; const bf16_t* Y; const float* part; bf16_t* H; bool store; };
#define NCOL(r, j) (col[j])
template <bool XF32> __device__ __forceinline__ void norm_row_load(const NormArgs& A, int r, const int (&col)[8], f32x4 (&x)[8], u32x2 (&xr)[8], u32x2 (&yr)[8]) {
    if (XF32) { const float* xi = r < ML ? A.xin_lat + (size_t)r * D : A.xin_ctx + (size_t)(r - ML) * D;
#pragma unroll
        for (int j = 0; j < 8; ++j) x[j] = __builtin_nontemporal_load((const f32x4*)(xi + NCOL(r, j)));
    } else {
#pragma unroll
        for (int j = 0; j < 8; ++j) xr[j] = __builtin_nontemporal_load((const u32x2*)(A.XB + (size_t)r * D + NCOL(r, j)));
    }
    if (A.Y && !(A.part && r >= ML)) {
#pragma unroll
        for (int j = 0; j < 8; ++j) yr[j] = __builtin_nontemporal_load((const u32x2*)(A.Y + (size_t)r * D + NCOL(r, j)));
    }
}
template <bool XF32> __device__ __forceinline__ void norm_row_compute(const NormArgs& A, const LAS float* V, int r, const int (&col)[8], const f32x4 (&xf)[8], const u32x2 (&xr)[8], u32x2 (&yr)[8]) {
    float rs = 0.f;
    if (A.Y) {
        if (A.part && r >= ML) {
#pragma unroll
            for (int j = 0; j < 8; ++j) { const float* pp = A.part + (size_t)(r - ML) * D + NCOL(r, j); f32x4 pq[8];
#pragma unroll
                for (int q = 0; q < 8; ++q) pq[q] = __builtin_nontemporal_load((const f32x4*)(pp + (size_t)q * MC * D));
                __builtin_amdgcn_sched_barrier(0);
                const f32x4 a = ((pq[0] + pq[1]) + (pq[2] + pq[3])) + ((pq[4] + pq[5]) + (pq[6] + pq[7]));
                yr[j].x = cvt_pk_bf16(a[0], a[1]); yr[j].y = cvt_pk_bf16(a[2], a[3]); }
        }
        float ss = 0.f;
#pragma unroll
        for (int j = 0; j < 8; ++j) { const float y0 = bflo(yr[j].x), y1 = bfhi(yr[j].x), y2 = bflo(yr[j].y), y3 = bfhi(yr[j].y); ss += (y0 * y0 + y1 * y1) + (y2 * y2 + y3 * y3); }
        rs = __builtin_amdgcn_rsqf(wave_sum(ss) * (1.f / D) + EPS);
    }
#define NORM_X(j) ((XF32 ? xf[j] : (f32x4){bflo(xr[j].x), bfhi(xr[j].x), bflo(xr[j].y), bfhi(xr[j].y)}) + (A.Y ? *(const LAS f32x4*)(V + NCOL(r, j)) * ((f32x4){bflo(yr[j].x), bfhi(yr[j].x), bflo(yr[j].y), bfhi(yr[j].y)} * rs) : (f32x4){0.f, 0.f, 0.f, 0.f}))
    float rx = 0.f;
    if (A.H) { float ss = 0.f;
#pragma unroll
        for (int j = 0; j < 8; ++j) { const f32x4 x = NORM_X(j); ss += (x[0] * x[0] + x[1] * x[1]) + (x[2] * x[2] + x[3] * x[3]); if (j & 1) __builtin_amdgcn_sched_barrier(0); }
        rx = __builtin_amdgcn_rsqf(wave_sum(ss) * (1.f / D) + EPS); }
#pragma unroll
    for (int j = 0; j < 8; ++j) { const f32x4 x = NORM_X(j);
        if (A.outf) __builtin_nontemporal_store(x, (f32x4*)(A.outf + (size_t)r * D + NCOL(r, j)));
        else if (A.store) { u32x2 w; w.x = cvt_pk_bf16(x[0], x[1]); w.y = cvt_pk_bf16(x[2], x[3]); __builtin_nontemporal_store(w, (u32x2*)(A.XB + (size_t)r * D + NCOL(r, j))); }
        if (A.H) { const f32x4 h = (x * rx) * *(const LAS f32x4*)(V + D + NCOL(r, j)) + *(const LAS f32x4*)(V + 2 * D + NCOL(r, j)); u32x2 w; w.x = cvt_pk_bf16(h[0], h[1]); w.y = cvt_pk_bf16(h[2], h[3]);
            *(u32x2*)(A.H + (size_t)r * D + NCOL(r, j)) = w; }
        if (j & 1) __builtin_amdgcn_sched_barrier(0); }
#undef NORM_X
}
template <bool XF32> __device__ __forceinline__ void norm_phase(LAS unsigned char* lds, int G, int bid, int rows, const float* xin_lat, const float* xin_ctx, bf16_t* XB, float* outf, bool store,
                                           const bf16_t* Y, const float* part  , const float* modg  , int kgate, float coef, const float* gpost,
                                           bf16_t* H, const float* modh  , int kshift, const float* gpre) {
    constexpr int NR = XF32 ? 2 : NORM_NR;
    const int tid = fresh_tid(), lane = tid & 63, wid = __builtin_amdgcn_readfirstlane(tid >> 6);
    asm volatile("" : "+s"(bid));
    float zf = 0.f; asm volatile("" : "+v"(zf));
    const NormArgs A{xin_lat, xin_ctx, XB, outf, Y, part, H, store};
    LAS float* V = (LAS float*)lds;
    int s_have = -1;
    for (int r0 = bid * 8 * NR; r0 < rows + (rows > ML ? 0 : 0); r0 += G * 8 * NR) {
        if (r0 >= ML) break;
        const int s = r0 >> 12;
        if (s != s_have) { __syncthreads();
            { const int c = 4 * fresh_tid(); f32x4 gg = (f32x4){zf, zf, zf, zf}, a = gg, b = gg;
              if (Y) gg = *(const f32x4*)(modg + (size_t)s * NMOD + kgate * D + c) * *(const f32x4*)(gpost + c) * coef;
              if (H) { a = *(const f32x4*)(gpre + c) * (*(const f32x4*)(modh + (size_t)s * NMOD + (kshift + 1) * D + c) + 1.f); b = *(const f32x4*)(modh + (size_t)s * NMOD + kshift * D + c); }
              *(LAS f32x4*)(V + c) = gg; *(LAS f32x4*)(V + D + c) = a; *(LAS f32x4*)(V + 2 * D + c) = b; }
            __syncthreads(); s_have = s; }
        int ln = lane; asm volatile("" : "+v"(ln)); int col[8];
_Pragma("unroll")
        for (int j = 0; j < 8; ++j) col[j] = 4 * ln + 256 * ((j + wid) & 7);
        f32x4 xf[XF32 ? NR : 1][8]; u32x2 xr[XF32 ? 1 : NR][8], yr[NR][8];
#pragma unroll
        for (int k = 0; k < NR; ++k)
#pragma unroll
            for (int j = 0; j < 8; ++j) { yr[k][j] = (u32x2){0u, 0u}; if (XF32) xf[k][j] = (f32x4){0.f, 0.f, 0.f, 0.f}; else xr[k][j] = (u32x2){0u, 0u}; }
#pragma unroll
        for (int k = 0; k < NR; ++k) norm_row_load<XF32>(A, r0 + wid + 8 * k, col, xf[XF32 ? k : 0], xr[XF32 ? 0 : k], yr[k]);
        __builtin_amdgcn_sched_barrier(0);
#pragma unroll
        for (int k = 0; k < NR; ++k) { norm_row_compute<XF32>(A, V, r0 + wid + 8 * k, col, xf[XF32 ? k : 0], xr[XF32 ? 0 : k], yr[k]); __builtin_amdgcn_sched_barrier(0); }
    }
    if (rows > ML) {
        for (int r0 = ML + bid * 8; r0 < rows; r0 += G * 8) {
            if (s_have != 4) { __syncthreads();
                { const int c = 4 * fresh_tid(); f32x4 gg = (f32x4){zf, zf, zf, zf}, a = gg, b = gg;
                  if (Y) gg = *(const f32x4*)(modg + (size_t)4 * NMOD + kgate * D + c) * *(const f32x4*)(gpost + c) * coef;
                  if (H) { a = *(const f32x4*)(gpre + c) * (*(const f32x4*)(modh + (size_t)4 * NMOD + (kshift + 1) * D + c) + 1.f); b = *(const f32x4*)(modh + (size_t)4 * NMOD + kshift * D + c); }
                  *(LAS f32x4*)(V + c) = gg; *(LAS f32x4*)(V + D + c) = a; *(LAS f32x4*)(V + 2 * D + c) = b; }
                __syncthreads(); s_have = 4; }
            int ln = lane; asm volatile("" : "+v"(ln)); int col[8];
_Pragma("unroll")
        for (int j = 0; j < 8; ++j) col[j] = 4 * ln + 256 * ((j + wid) & 7);
            f32x4 x[8]; u32x2 xr[8], yr[8];
#pragma unroll
            for (int j = 0; j < 8; ++j) { yr[j] = (u32x2){0u, 0u}; xr[j] = (u32x2){0u, 0u}; x[j] = (f32x4){0.f, 0.f, 0.f, 0.f}; }
            norm_row_load<XF32>(A, r0 + wid, col, x, xr, yr);
            norm_row_compute<XF32>(A, V, r0 + wid, col, x, xr, yr);
        }
    }
    __syncthreads();
}
#undef NCOL

__device__ __forceinline__ f32x4 mfma16(bf16x8 a, bf16x8 b, f32x4 c) { return __builtin_amdgcn_mfma_f32_16x16x32_bf16(a, b, c, 0, 0, 0); }
__device__ __forceinline__ void gmlp_chunk(const Ctx& C, int l, LAS unsigned char* lds, int R0, int g_lo) {
    unsigned char* const ws = C.ws();
    const bf16_t* Z = WSP(const bf16_t, WS_Z); bf16_t* YA = WSP(bf16_t, WS_YBR);
    const float* lng = C.in(I_GMLNG) + l * 512; const float* lnb = C.in(I_GMLNB) + l * 512; const float* bs = C.in(I_GMBS) + l * 512; const bf16_t* WS = WLP(const bf16_t, l, WL_GMW);
    LAS float* stats = (LAS float*)lds; LAS bf16_t* vnT = (LAS bf16_t*)(lds + 1024);
    const int tid = fresh_tid(), lane = tid & 63, wid = tid >> 6, i16 = lane & 15, g4 = lane >> 4;
    for (int rr = 0; rr < 16; ++rr) { const int q = 16 * wid + rr; const u32x4 w = *(const u32x4*)(Z + (size_t)(R0 + q) * NZ + 512 + 8 * lane);
        const float v[8] = {bflo(w.x), bfhi(w.x), bflo(w.y), bfhi(w.y), bflo(w.z), bfhi(w.z), bflo(w.w), bfhi(w.w)};
        float s = 0.f;
#pragma unroll
        for (int e = 0; e < 8; ++e) s += v[e];
        const float mean = wave_sum(s) * (1.f / 512.f); float q2 = 0.f;
#pragma unroll
        for (int e = 0; e < 8; ++e) { const float d = v[e] - mean; q2 += d * d; }
        const float rstd = __builtin_amdgcn_rsqf(wave_sum(q2) * (1.f / 512.f) + EPS);
        if (lane == 0) { stats[2 * q] = mean; stats[2 * q + 1] = rstd; } }
    __syncthreads();
    for (int g = g_lo; g < g_lo + 2; ++g) {
        u32x4 wj[4];
#pragma unroll
        for (int j = 0; j < 4; ++j) { const int id = tid + 512 * j, q = id >> 4, cc = id & 15; wj[j] = *(const u32x4*)(Z + (size_t)(R0 + q) * NZ + 512 + g * 128 + 8 * cc); }
        __builtin_amdgcn_sched_barrier(0);
#pragma unroll
        for (int j = 0; j < 4; ++j) { const int id = tid + 512 * j, q = id >> 4, cc = id & 15; const u32x4 w = wj[j];
            const float v[8] = {bflo(w.x), bfhi(w.x), bflo(w.y), bfhi(w.y), bflo(w.z), bfhi(w.z), bflo(w.w), bfhi(w.w)};
            const float mean = stats[2 * q], rstd = stats[2 * q + 1];
            const f32x4 g0 = *(const f32x4*)(lng + g * 128 + 8 * cc), g1 = *(const f32x4*)(lng + g * 128 + 8 * cc + 4), b0 = *(const f32x4*)(lnb + g * 128 + 8 * cc), b1 = *(const f32x4*)(lnb + g * 128 + 8 * cc + 4);
            const float gg[8] = {g0[0], g0[1], g0[2], g0[3], g1[0], g1[1], g1[2], g1[3]}, bb[8] = {b0[0], b0[1], b0[2], b0[3], b1[0], b1[1], b1[2], b1[3]};
#pragma unroll
            for (int e = 0; e < 8; ++e) vnT[(8 * cc + e) * 136 + q] = (bf16_t)f2bf((v[e] - mean) * rstd * gg[e] + bb[e]); }
        __syncthreads();
        bf16x8 bw[4];
#pragma unroll
        for (int ks = 0; ks < 4; ++ks) bw[ks] = *(const bf16x8*)(WS + (size_t)(g * 128 + 16 * wid + i16) * 128 + 32 * ks + 8 * g4);
        f32x4 acc[8];
#pragma unroll
        for (int ct = 0; ct < 8; ++ct) { acc[ct] = (f32x4){0.f, 0.f, 0.f, 0.f};
#pragma unroll
            for (int ks = 0; ks < 4; ++ks) { const bf16x8 a = *(const LAS bf16x8*)(vnT + (16 * ct + i16) * 136 + 32 * ks + 8 * g4); acc[ct] = mfma16(a, bw[ks], acc[ct]); } }
        const int prow = R0 + 16 * wid + i16; const float bsv = bs[g * 128 + 16 * wid + i16];
        u32x2 uwv[8];
#pragma unroll
        for (int ct = 0; ct < 8; ++ct) uwv[ct] = *(const u32x2*)(Z + (size_t)prow * NZ + g * 128 + 16 * ct + 4 * g4);
        __builtin_amdgcn_sched_barrier(0);
#pragma unroll
        for (int ct = 0; ct < 8; ++ct) { const int c4 = g * 128 + 16 * ct + 4 * g4; const u32x2 uw = uwv[ct];
            u32x2 o; o.x = cvt_pk_bf16(bflo(uw.x) * (acc[ct][0] + bsv), bfhi(uw.x) * (acc[ct][1] + bsv)); o.y = cvt_pk_bf16(bflo(uw.y) * (acc[ct][2] + bsv), bfhi(uw.y) * (acc[ct][3] + bsv));
            *(u32x2*)(YA + (size_t)prow * 512 + c4) = o; }
        __syncthreads();
    }
}
__device__ __forceinline__ void conv_block(const Ctx& C, int l, LAS unsigned char* lds, int SR0, int SL, int p0) {
    unsigned char* const ws = C.ws();
    const bf16_t* HB = WSP(const bf16_t, WS_HB); bf16_t* YB = WSP(bf16_t, WS_YBR) + (size_t)MT * 512;
    const float* lng = C.in(I_CVLNG) + l * 512; const float* lnb = C.in(I_CVLNB) + l * 512;
    LAS float* tile = (LAS float*)lds;
    const int tid = fresh_tid(), lane = tid & 63, wid = tid >> 6;
    float dw[31]; const float db = C.in(I_CVDB)[l * 512 + tid]; const float* const dwp = C.in(I_CVDW) + (size_t)l * 31 * 512 + tid;
#pragma unroll
    for (int j = 0; j < 31; ++j) dw[j] = dwp[j * 512];
    __builtin_amdgcn_sched_barrier(0);
    float hv[62]; unsigned raw[62];
#pragma unroll
    for (int j = 0; j < 62; ++j) { const int p = p0 - 15 + j; const int pc = p < 0 ? 0 : (p >= SL ? SL - 1 : p);
        raw[j] = HB[(size_t)(SR0 + pc) * 512 + tid]; }
    __builtin_amdgcn_sched_barrier(0);
#pragma unroll
    for (int j = 0; j < 62; ++j) { const int p = p0 - 15 + j; hv[j] = (p >= 0 && p < SL) ? __builtin_bit_cast(float, raw[j] << 16) : 0.f; }
#pragma unroll
    for (int o = 0; o < 32; ++o) { float s = db;
#pragma unroll
        for (int j = 0; j < 31; ++j) s += dw[j] * hv[o + j];
        tile[o * 512 + tid] = s; }
    __syncthreads();
    const f32x4 lga = *(const f32x4*)(lng + 4 * lane), lgb = *(const f32x4*)(lng + 256 + 4 * lane), lba = *(const f32x4*)(lnb + 4 * lane), lbb = *(const f32x4*)(lnb + 256 + 4 * lane);
#pragma unroll
    for (int rr = 0; rr < 4; ++rr) { const int o = 4 * wid + rr; f32x4 a = *(const LAS f32x4*)(tile + o * 512 + 4 * lane), b = *(const LAS f32x4*)(tile + o * 512 + 256 + 4 * lane);
        const float mean = wave_sum((a[0] + a[1]) + (a[2] + a[3]) + (b[0] + b[1]) + (b[2] + b[3])) * (1.f / 512.f);
        a = a - mean; b = b - mean;
        const float rstd = __builtin_amdgcn_rsqf(wave_sum((a[0] * a[0] + a[1] * a[1]) + (a[2] * a[2] + a[3] * a[3]) + (b[0] * b[0] + b[1] * b[1]) + (b[2] * b[2] + b[3] * b[3])) * (1.f / 512.f) + EPS);
        const f32x4 ya = a * rstd * lga + lba, yb = b * rstd * lgb + lbb;
        u32x2 wa, wb; wa.x = cvt_pk_bf16(ya[0] * sigmoidf_(ya[0]), ya[1] * sigmoidf_(ya[1])); wa.y = cvt_pk_bf16(ya[2] * sigmoidf_(ya[2]), ya[3] * sigmoidf_(ya[3]));
        wb.x = cvt_pk_bf16(yb[0] * sigmoidf_(yb[0]), yb[1] * sigmoidf_(yb[1])); wb.y = cvt_pk_bf16(yb[2] * sigmoidf_(yb[2]), yb[3] * sigmoidf_(yb[3]));
        bf16_t* op = YB + (size_t)(SR0 + p0 + o) * 512; *(u32x2*)(op + 4 * lane) = wa; *(u32x2*)(op + 256 + 4 * lane) = wb; }
    __syncthreads();
}

struct AttnSrc { const bf16_t* k1; int k1ld; const bf16_t* k2; int k2ld; const bf16_t* vt; };
template <int DK1, int DK2, int DV> struct AttnGeo {
    static constexpr int DK = DK1 + DK2, KS = DK / 32, DT = DV / 16, KROW = DK + 8, VROW = 72, KC = DK / 8, NKC = 64 * KC / 512, NVC = DV * 8 / 512, KBYTES = 64 * KROW * 2, VBYTES = DV * VROW * 2, VBASE = 2 * KBYTES  ;
    static_assert((64 * KC) % 512 == 0 && (DV * 8) % 512 == 0, "staging geometry");
};
template <int DK1, int DK2, int DV>
__device__ __forceinline__ void attn_load(const AttnSrc& S, int row0, int tid, u32x4 (&kr)[AttnGeo<DK1, DK2, DV>::NKC], u32x4 (&vr)[AttnGeo<DK1, DK2, DV>::NVC]) {
    typedef AttnGeo<DK1, DK2, DV> Gm;
#pragma unroll
    for (int i = 0; i < Gm::NKC; ++i) { const int c = tid + 512 * i, key = c / Gm::KC, part = c - key * Gm::KC;
        const bf16_t* src = (part < DK1 / 8) ? S.k1 + (size_t)(row0 + key) * S.k1ld + part * 8 : S.k2 + (size_t)(row0 + key) * S.k2ld + (part - DK1 / 8) * 8; kr[i] = *(const u32x4*)src; }
#pragma unroll
    for (int i = 0; i < Gm::NVC; ++i) { const int c = tid + 512 * i, d = c >> 3, c8 = c & 7; vr[i] = *(const u32x4*)(S.vt + (size_t)d * MT + row0 + 8 * c8); }
}
template <int DK1, int DK2, int DV>
__device__ __forceinline__ void attn_store(LAS unsigned char* kbuf, LAS unsigned char* vbuf, int tid, const u32x4 (&kr)[AttnGeo<DK1, DK2, DV>::NKC], const u32x4 (&vr)[AttnGeo<DK1, DK2, DV>::NVC]) {
    typedef AttnGeo<DK1, DK2, DV> Gm; LAS bf16_t* Ks = (LAS bf16_t*)kbuf; LAS bf16_t* Vt = (LAS bf16_t*)vbuf;
#pragma unroll
    for (int i = 0; i < Gm::NKC; ++i) { const int c = tid + 512 * i, key = c / Gm::KC, part = c - key * Gm::KC;
        const int rho = (key & 32) + 16 * ((key >> 2) & 1) + 4 * ((key >> 3) & 3) + (key & 3);
        *(LAS u32x4*)(Ks + rho * Gm::KROW + part * 8) = kr[i]; }
#pragma unroll
    for (int i = 0; i < Gm::NVC; ++i) { const int c = tid + 512 * i, d = c >> 3, c8 = c & 7; *(LAS u32x4*)(Vt + d * Gm::VROW + 8 * c8) = vr[i]; }
}
template <int DT, bool MASK>
__device__ __forceinline__ void attn_softmax(f32x4 (&st)[2], float& nbase, float& rel, float& l, f32x4 (&ot)[DT], bf16x8& pf, int kp0  , bool masked) {
    if (MASK && masked) {
#pragma unroll
        for (int t2 = 0; t2 < 2; ++t2)
#pragma unroll
            for (int r = 0; r < 4; ++r) if ((unsigned)(kp0 + 4 * t2 + r) > 256u) st[t2][r] = -1e30f;
    }
    const float lm = __builtin_fmaxf(__builtin_fmaxf(__builtin_fmaxf(__builtin_fmaxf(st[0][0], st[0][1]), st[0][2]), __builtin_fmaxf(__builtin_fmaxf(st[0][3], st[1][0]), st[1][1])), __builtin_fmaxf(st[1][2], st[1][3]));
    if (__any(lm > rel + 8.f)) { float mx = lm;
        { auto r16 = __builtin_amdgcn_permlane16_swap(__builtin_bit_cast(unsigned, mx), __builtin_bit_cast(unsigned, mx), false, false);
          mx = vmax(__builtin_bit_cast(float, r16[0]), __builtin_bit_cast(float, r16[1]));
          auto r32 = __builtin_amdgcn_permlane32_swap(__builtin_bit_cast(unsigned, mx), __builtin_bit_cast(unsigned, mx), false, false);
          mx = vmax(__builtin_bit_cast(float, r32[0]), __builtin_bit_cast(float, r32[1])); }
        const float mt = vmax(rel, mx);
        const float alpha = fast_exp2(rel - mt); l *= alpha; nbase -= mt; rel = 0.f;
        st[0] = st[0] - mt; st[1] = st[1] - mt;
#pragma unroll
        for (int dt = 0; dt < DT; ++dt) ot[dt] = ot[dt] * alpha; }
    { st[0] = (f32x4){fast_exp2(st[0][0]), fast_exp2(st[0][1]), fast_exp2(st[0][2]), fast_exp2(st[0][3])}; st[1] = (f32x4){fast_exp2(st[1][0]), fast_exp2(st[1][1]), fast_exp2(st[1][2]), fast_exp2(st[1][3])};
      const f32x4 es = st[0] + st[1]; const f32x2 e2 = (f32x2){es[0], es[1]} + (f32x2){es[2], es[3]};
      l += e2[0] + e2[1]; }
    union { u32x4 u; bf16x8 b; } q; q.u.x = cvt_pk_bf16(st[0][0], st[0][1]); q.u.y = cvt_pk_bf16(st[0][2], st[0][3]); q.u.z = cvt_pk_bf16(st[1][0], st[1][1]); q.u.w = cvt_pk_bf16(st[1][2], st[1][3]);
    pf = q.b;
}
template <int DK1, int DK2, int DV, bool MASK>
__device__ __forceinline__ void attn_unit(LAS unsigned char* lds, const AttnSrc& S, const bf16_t* q0p, const bf16_t* q1p, bf16_t* o0p, bf16_t* o1p,
                                          int ctx_row0, int nctx, int loc_row0, int loc_pos0, int nloc, int qpos0, int qpos1, float m0, float l0, int role) {
    typedef AttnGeo<DK1, DK2, DV> Gm; constexpr int KS = Gm::KS, DT = Gm::DT, KROW = Gm::KROW, VROW = Gm::VROW;
    const int tid = fresh_tid(), lane = tid & 63, i16 = lane & 15, g4 = lane >> 4;
    bf16x8 qf0[KS], qf1[KS];
#pragma unroll
    for (int ks = 0; ks < KS; ++ks) { qf0[ks] = *(const bf16x8*)(q0p + 32 * ks + 8 * g4); qf1[ks] = *(const bf16x8*)(q1p + 32 * ks + 8 * g4); }
    f32x4 ot0[DT], ot1[DT];
#pragma unroll
    for (int dt = 0; dt < DT; ++dt) { ot0[dt] = (f32x4){0.f, 0.f, 0.f, 0.f}; ot1[dt] = (f32x4){0.f, 0.f, 0.f, 0.f}; }
    const float base0 = m0 < -1e29f ? 0.f : m0;
    float nba = -base0, nbb = -base0, ra = m0 - base0, rb = ra, la = (g4 == 0) ? l0 : 0.f, lb = la;
    const int NT = nctx + nloc;
    u32x4 kr[Gm::NKC], vr[Gm::NVC];
#define TROW(t) ((t) < nctx ? ctx_row0 + 64 * (t) : loc_row0 + 64 * ((t) - nctx))
    attn_load<DK1, DK2, DV>(S, TROW(0), tid, kr, vr);
    __syncthreads();
    attn_store<DK1, DK2, DV>(lds, lds + Gm::VBASE, tid, kr, vr);
    __syncthreads();
    if (NT > 1) attn_load<DK1, DK2, DV>(S, TROW(1), tid, kr, vr);
    int vs = 0;
    for (int tt = 0; tt < NT; ++tt) {
        const LAS bf16_t* Ks = (const LAS bf16_t*)(lds + (tt & 1) * Gm::KBYTES); const LAS bf16_t* Vt = (const LAS bf16_t*)(lds + Gm::VBASE + vs * Gm::VBYTES);
        const bool masked = MASK && tt >= nctx; const int kpb = loc_pos0 + 64 * (tt - nctx) + 8 * g4 + 128;
        f32x4 sa[2], sb[2];
#define AT_X(hh) do { _Pragma("unroll") for (int t2 = 0; t2 < 2; ++t2) { sa[t2] = (f32x4){nba, nba, nba, nba}; sb[t2] = (f32x4){nbb, nbb, nbb, nbb}; bf16x8 kf[KS]; \
            _Pragma("unroll") for (int ks = 0; ks < KS; ++ks) kf[ks] = *(const LAS bf16x8*)(Ks + (32 * (hh) + 16 * t2 + i16) * KROW + 32 * ks + 8 * g4); \
            __builtin_amdgcn_sched_barrier(0); \
            _Pragma("unroll") for (int ks = 0; ks < KS; ++ks) { sa[t2] = mfma16(kf[ks], qf0[ks], sa[t2]); sb[t2] = mfma16(kf[ks], qf1[ks], sb[t2]); } \
            __builtin_amdgcn_sched_barrier(0); } } while (0)
#define AT_Y(hh) do { bf16x8 pa, pb; \
            attn_softmax<DT, MASK>(sa, nba, ra, la, ot0, pa, kpb + 32 * (hh) - qpos0, masked); \
            attn_softmax<DT, MASK>(sb, nbb, rb, lb, ot1, pb, kpb + 32 * (hh) - qpos1, masked); \
            __builtin_amdgcn_sched_barrier(0); \
            _Pragma("unroll") for (int d4 = 0; d4 < DT; d4 += 4) { bf16x8 vf[4]; \
                _Pragma("unroll") for (int dd = 0; dd < 4; ++dd) vf[dd] = *(const LAS bf16x8*)(Vt + (16 * (d4 + dd) + i16) * VROW + 32 * (hh) + 8 * g4); \
                __builtin_amdgcn_sched_barrier(0); \
                _Pragma("unroll") for (int dd = 0; dd < 4; ++dd) { ot0[d4 + dd] = mfma16(vf[dd], pa, ot0[d4 + dd]); ot1[d4 + dd] = mfma16(vf[dd], pb, ot1[d4 + dd]); } \
                __builtin_amdgcn_sched_barrier(0); } } while (0)
        AT_X(0); AT_Y(0); AT_X(1);
        if (role == 0) AT_Y(1);
        const int vn = vs == 2 ? 0 : vs + 1;
        if (tt + 1 < NT) attn_store<DK1, DK2, DV>(lds + ((tt + 1) & 1) * Gm::KBYTES, lds + Gm::VBASE + vn * Gm::VBYTES, tid, kr, vr);
        __syncthreads();
        if (tt + 2 < NT) attn_load<DK1, DK2, DV>(S, TROW(tt + 2), tid, kr, vr);
        if (role != 0) AT_Y(1);
        vs = vn;
#undef AT_X
#undef AT_Y
    }
#undef TROW
    float lt = la + __shfl_xor(la, 16); lt += __shfl_xor(lt, 32); const float ia = 1.f / lt;
    lt = lb + __shfl_xor(lb, 16); lt += __shfl_xor(lt, 32); const float ib = 1.f / lt;
#pragma unroll
    for (int dt = 0; dt < DT; ++dt) { u32x2 w; w.x = cvt_pk_bf16(ot0[dt][0] * ia, ot0[dt][1] * ia); w.y = cvt_pk_bf16(ot0[dt][2] * ia, ot0[dt][3] * ia); *(u32x2*)(o0p + 16 * dt + 4 * g4) = w;
        w.x = cvt_pk_bf16(ot1[dt][0] * ib, ot1[dt][1] * ib); w.y = cvt_pk_bf16(ot1[dt][2] * ib, ot1[dt][3] * ib); *(u32x2*)(o1p + 16 * dt + 4 * g4) = w; }
}

constexpr int NPHASE = 2 + 12 * DEPTH;
__global__ void __launch_bounds__(512, 2) mk_fwd(Params P) {
    extern __shared__ __attribute__((aligned(16))) unsigned char lds_raw[];
    LAS unsigned char* lds = (LAS unsigned char*)lds_raw;
    const int tid = fresh_tid();
    volatile LAS unsigned* MISC = (volatile LAS unsigned*)(lds + MISC_OFF);
    for (int u = tid; u < (LDS_BYTES - RING_BYTES) / 4; u += 512) ((LAS unsigned*)(lds + RING_BYTES))[u] = 0u;
    __syncthreads();
    Ctx C; C.tab = (volatile LAS unsigned*)(lds + PTAB_OFF);
    if (tid == 0) {
#pragma unroll
        for (int i = 0; i < 28; ++i) { const unsigned long long v = (unsigned long long)P.in[i]; C.tab[2 * i] = (unsigned)v; C.tab[2 * i + 1] = (unsigned)(v >> 32); }
        { const unsigned long long v = (unsigned long long)P.out; C.tab[56] = (unsigned)v; C.tab[57] = (unsigned)(v >> 32); }
        { const unsigned long long v = (unsigned long long)P.ws; C.tab[58] = (unsigned)v; C.tab[59] = (unsigned)(v >> 32); }
        C.tab[60] = (unsigned)P.ph_lo; C.tab[61] = (unsigned)P.ph_hi;
    }
    __syncthreads();
    if (!MK_MULTI) (void)xcd_barrier_post((unsigned*)(C.ws() + WS_CTL) + CW_BAR, MISC + 8);
    auto tabw = [&](unsigned off) -> int { asm volatile("" : "+s"(off)); return (int)__builtin_amdgcn_readfirstlane(*(volatile LAS unsigned*)(lds + off)); };
#define LO tabw(PTAB_OFF + 240)
#define HI tabw(PTAB_OFF + 244)
#define IN(k) (LO <= (k) && (k) < HI)
#define MKBAR XcdBarrier bar; bar.bar = (unsigned*)(C.ws() + WS_CTL) + CW_BAR; bar.x = xb_xcc_id(); bar.st = (volatile LAS unsigned*)(lds + MISC_OFF) + 8
#define SEAM(k) do { if (!MK_MULTI && IN(k) && IN((k) + 1)) { MKBAR; xcd_barrier(bar); } } while (0)
#define GRID const int G = gridDim.x, bid = blockIdx.x

    if (IN(0) && EN(12)) for (int _rep = 0; _rep < (((PROBE_MASK >> 12) & 1) ? 2 : 1); ++_rep) { if (_rep) { MKBAR; xcd_barrier(bar); } GRID; prologue_phase(C, lds, G, bid); }
    SEAM(0);

    for (int l = 0; l < DEPTH; ++l) {
        const int pb = 1 + 12 * l; const bool last = (l == DEPTH - 1);
        if (IN(pb + 0) && EN(0)) for (int _rep = 0; _rep < (((PROBE_MASK >> 0) & 1) ? 2 : 1); ++_rep) { if (_rep) { MKBAR; xcd_barrier(bar); } GRID; unsigned char* const ws = C.ws(); float* const out = C.out(); float* const XC = WSP(float, WS_XC);
            const float* modl = WSP(const float, WS_MOD) + (size_t)l * 5 * NMOD; const float* npre = C.in(I_NPRE) + (size_t)l * 3 * D; const float* npost = C.in(I_NPOST) + (size_t)l * 3 * D;
            if (l == 0) norm_phase<true>(lds, G, bid, MT, C.in(I_X), C.in(I_CTX), WSP(bf16_t, WS_XB), nullptr, false  , nullptr, nullptr, modl, 0, 0.f, nullptr, WSP(bf16_t, WS_H), modl, 0, npre);
            else norm_phase<false>(lds, G, bid, MT, nullptr, nullptr, WSP(bf16_t, WS_XB), nullptr, true, WSP(const bf16_t, WS_Y), (G >= 256 ? (const float*)C.out() : nullptr), modl - (size_t)5 * NMOD, 8, 0.5f, npost - D, WSP(bf16_t, WS_H), modl, 0, npre);
        }
        SEAM(pb + 0);
        if (IN(pb + 1) && EN(1)) for (int _rep = 0; _rep < (((PROBE_MASK >> 1) & 1) ? 2 : 1); ++_rep) { if (_rep) { MKBAR; xcd_barrier(bar); } GRID; unsigned char* const ws = C.ws();
            pg8::RectOrder S; S.init(MT / 256, NGU / 256, G, bid, 0, WSP(bf16_t, WS_H), 256 * D * 2, WLP(bf16_t, l, WL_GU), 256 * D * 2);
            pg8::EpiSwiglu E{WSP(bf16_t, WS_Z)}; pg8::gemm_phase<pg8::EpiSwiglu, pg8::RectOrder, true>(lds, D, D, D, S, E); }
        if (IN(pb + 1) && EN(1)) { GRID; cvt_pull(C, lds, l * CV_LAYER + CV_E2, CW_DONE + 64 * (pb + 1), G); }
        SEAM(pb + 1);
        if (IN(pb + 2) && EN(2)) for (int _rep = 0; _rep < (((PROBE_MASK >> 2) & 1) ? 2 : 1); ++_rep) { if (_rep) { MKBAR; xcd_barrier(bar); } GRID; unsigned char* const ws = C.ws();
            const bool split = (G >= 256);
            { pg8::RectOrder S; S.init((split ? ML : MT) / 256, D / 256, G, bid, 0, WSP(bf16_t, WS_Z), 256 * DFF * 2, WLP(bf16_t, l, WL_D), 256 * DFF * 2);
              pg8::EpiPlain<false> E{WSP(bf16_t, WS_Y), D, nullptr}; pg8::gemm_phase<pg8::EpiPlain<false>, pg8::RectOrder, true>(lds, DFF, DFF, DFF, S, E); }
            if (split) { const int tile = bid >> 3, part = bid & 7, ks = part < 5 ? 10 * part : 50 + 12 * (part - 5), kn = part < 5 ? 10 : 12;
              pg8::SplitOrder S; S.pm = ML / 256 + (tile >> 3); S.pn = tile & 7; S.part = part; S.have = bid < 256;
              S.A = (const char*)(WSP(bf16_t, WS_Z) + (size_t)S.pm * 256 * DFF + ks * 64); S.B = (const char*)(WLP(bf16_t, l, WL_D) + (size_t)S.pn * 256 * DFF + ks * 64);
              pg8::EpiPartial E{C.out(), ML, (size_t)MC * D}; pg8::gemm_phase<pg8::EpiPartial, pg8::SplitOrder, true>(lds, kn * 64, DFF, DFF, S, E); } }
        SEAM(pb + 2);
        if (IN(pb + 3) && EN(3)) for (int _rep = 0; _rep < (((PROBE_MASK >> 3) & 1) ? 2 : 1); ++_rep) { if (_rep) { MKBAR; xcd_barrier(bar); } GRID; unsigned char* const ws = C.ws(); float* const out = C.out(); float* const XC = WSP(float, WS_XC);
            const float* const modl = WSP(const float, WS_MOD) + (size_t)l * 5 * NMOD;
            if (l == 0) norm_phase<true>(lds, G, bid, MT, C.in(I_X), C.in(I_CTX), WSP(bf16_t, WS_XB), nullptr, true, WSP(const bf16_t, WS_Y), (G >= 256 ? (const float*)C.out() : nullptr), modl, 2, 0.5f, C.in(I_NPOST) + (size_t)l * 3 * D, WSP(bf16_t, WS_H), modl, 3, C.in(I_NPRE) + ((size_t)l * 3 + 1) * D);
            else norm_phase<false>(lds, G, bid, MT, nullptr, nullptr, WSP(bf16_t, WS_XB), nullptr, true, WSP(const bf16_t, WS_Y), (G >= 256 ? (const float*)C.out() : nullptr), modl, 2, 0.5f, C.in(I_NPOST) + (size_t)l * 3 * D, WSP(bf16_t, WS_H), modl, 3, C.in(I_NPRE) + ((size_t)l * 3 + 1) * D); }
        SEAM(pb + 3);
        if (IN(pb + 4) && EN(4)) for (int _rep = 0; _rep < (((PROBE_MASK >> 4) & 1) ? 2 : 1); ++_rep) { if (_rep) { MKBAR; xcd_barrier(bar); } GRID; unsigned char* const ws = C.ws();
            bf16_t* const Z = WSP(bf16_t, WS_Z); bf16_t* const H = WSP(bf16_t, WS_H);
            LAS float* const LTAB = (LAS float*)(lds + LTAB_OFF);
            { const int t_ = fresh_tid(); for (int i = t_; i < 2048; i += 512) LTAB[i] = WSP(const float, WS_TAB)[i]; __syncthreads(); }
            pg8::EpiZ E{Z, WSP(bf16_t, WS_HB), WSP(float, WS_SSP), WLP(const float, l, WL_BZ), LTAB, 0, 0};
            { pg8::RectOrder S; S.init(ML / 256, NZ / 256, G, bid, 0, H, 256 * D * 2, WLP(bf16_t, l, WL_IN), 256 * D * 2);
              pg8::gemm_phase<pg8::EpiZ, pg8::RectOrder, true>(lds, D, D, D, S, E); }
            int used = (ML / 256) * (NZ / 256);
            {
                const int ct0 = last ? 10 : 0, nct = last ? 4 : 14;
                pg8::EpiZ E2{Z, WSP(bf16_t, WS_HB), WSP(float, WS_SSP), WLP(const float, l, WL_BZ), LTAB, ct0, ML};
                pg8::RectOrder S; S.init(MC / 256, nct, G, bid, used, H + (size_t)ML * D, 256 * D * 2, WLP(bf16_t, l, WL_IN) + (size_t)ct0 * 256 * D, 256 * D * 2);
                pg8::gemm_phase<pg8::EpiZ, pg8::RectOrder, true>(lds, D, D, D, S, E2); used += (MC / 256) * nct; }
            {
                pg8::EpiVt<false> E3{WSP(bf16_t, WS_VTD), MT, WLP(const float, l, WL_BZ) + NZ, nullptr};
                pg8::RectOrder S; S.init(1, MT / 256, G, bid, used, WLP(bf16_t, l, WL_IN) + (size_t)NZ * D, 0, H, 256 * D * 2);
                pg8::gemm_phase<pg8::EpiVt<false>, pg8::RectOrder, true>(lds, D, D, D, S, E3); }
        }
        if (IN(pb + 4) && EN(4)) { GRID; cvt_pull(C, lds, l * CV_LAYER + CV_E7, CW_DONE + 64 * (pb + 4), G); }
        SEAM(pb + 4);
        if (IN(pb + 5) && EN(5)) for (int _rep = 0; _rep < (((PROBE_MASK >> 5) & 1) ? 2 : 1); ++_rep) { if (_rep) { MKBAR; xcd_barrier(bar); } GRID;
            const int lm_ = _rep ? PROBE_LOCMASK : LOCMASK;
            const int nch = 2 * ((last ? ML : MT) / 128), ncb = (last ? ML : MT) / 32;
            for (int it = bid; it < nch + ncb; it += G) {
                if (it < nch) { if (lm_ & 1) gmlp_chunk(C, l, lds, (it >> 1) * 128, 2 * (it & 1)); }
                else { const int cb = it - nch; int SR0, SL, p0; if (cb < ML / 32) { SR0 = (cb >> 7) * SEQ; SL = SEQ; p0 = (cb & 127) * 32; } else { const int c2 = cb - ML / 32; SR0 = ML + (c2 >> 3) * CTXL; SL = CTXL; p0 = (c2 & 7) * 32; }
                    if (lm_ & 2) conv_block(C, l, lds, SR0, SL, p0); }
            }
            __syncthreads();
            const int pan_q = (last ? ML : MT) / 256;
            if (!last) { unsigned char* const ws = C.ws();
              LAS float* const LTAB = (LAS float*)(lds + LTAB_OFF);
              pg8::EpiZ E2{WSP(bf16_t, WS_Z), WSP(bf16_t, WS_HB), WSP(float, WS_SSP), WLP(const float, l, WL_BZ), LTAB, 14, ML};
              pg8::RectOrder S; S.init(MC / 256, NZ / 256 - 14, G, bid, G / 2, WSP(bf16_t, WS_H) + (size_t)ML * D, 256 * D * 2, WLP(bf16_t, l, WL_IN) + (size_t)14 * 256 * D, 256 * D * 2);
              pg8::gemm_phase<pg8::EpiZ, pg8::RectOrder, true>(lds, D, D, D, S, E2); }
            if (lm_ & 4) { unsigned char* const ws = C.ws();
              pg8::RectOrder S; S.init(pan_q, 3, G, bid, 0, WSP(bf16_t, WS_Z) + ZC_CQ, 256 * NZ * 2, WLP(bf16_t, l, WL_UQ), 256 * 512 * 2);
              LAS float* const LTAB = (LAS float*)(lds + LTAB_OFF); { const int t_ = fresh_tid(); for (int i = t_; i < 2048; i += 512) LTAB[i] = WSP(const float, WS_TAB)[i]; __syncthreads(); }
              pg8::EpiQ E{WSP(bf16_t, WS_QM), WSP(const float, WS_SSP), LTAB}; pg8::gemm_phase<pg8::EpiQ, pg8::RectOrder, true>(lds, 512, NZ, 512, S, E); }
            if (lm_ & 8) { unsigned char* const ws = C.ws();
              { pg8::RectOrder S; S.init(MT / 256, 2, G, bid, last ? pan_q * 3 : 0, WSP(bf16_t, WS_Z) + ZC_CKV, 256 * NZ * 2, WLP(bf16_t, l, WL_KV), 256 * 256 * 2);
                pg8::EpiPlain<true> E{WSP(bf16_t, WS_KN), 512, WSP(const float, WS_SSP)}; pg8::gemm_phase<pg8::EpiPlain<true>, pg8::RectOrder, true>(lds, 256, NZ, 256, S, E); }
              { pg8::RectOrder S; S.init(2, MT / 256, G, bid, last ? pan_q * 3 + (MT / 256) * 2 : 0, WLP(bf16_t, l, WL_KV) + 512 * 256, 256 * 256 * 2, WSP(bf16_t, WS_Z) + ZC_CKV, 256 * NZ * 2);
                pg8::EpiVt<true> E{WSP(bf16_t, WS_VTM), MT, nullptr, WSP(const float, WS_SSP)}; pg8::gemm_phase<pg8::EpiVt<true>, pg8::RectOrder, true>(lds, 256, 256, NZ, S, E); } }
        }
        SEAM(pb + 5);
        if (IN(pb + 6) && EN(6)) for (int _rep = 0; _rep < (((PROBE_MASK >> 6) & 1) ? 2 : 1); ++_rep) { if (_rep) { MKBAR; xcd_barrier(bar); } GRID; unsigned char* const ws = C.ws();
            bf16_t* const YC = WSP(bf16_t, WS_YBR) + (size_t)2 * MT * 512; bf16_t* const YD = WSP(bf16_t, WS_YBR) + (size_t)3 * MT * 512;
            const bf16_t* const QM = WSP(const bf16_t, WS_QM); const bf16_t* const KN = WSP(const bf16_t, WS_KN); const bf16_t* const Z = WSP(const bf16_t, WS_Z);
            const bf16_t* const VTM = WSP(const bf16_t, WS_VTM); const bf16_t* const VTD = WSP(const bf16_t, WS_VTD);
            const float* const sink = C.in(I_SINK) + l * 8;
            const int tid2 = fresh_tid(), wid = __builtin_amdgcn_readfirstlane(tid2 >> 6);
            int role; { const unsigned simd = (unsigned)__builtin_amdgcn_s_getreg((1 << 11) | (4 << 6) | 4) & 3u; volatile LAS unsigned* sw = (volatile LAS unsigned*)(lds + 122880);
              __syncthreads(); if ((tid2 & 63) == 0) sw[wid] = simd; __syncthreads();
              int cnt = 0;
#pragma unroll
              for (int w = 0; w < 8; ++w) cnt += (w < wid && sw[w] == simd) ? 1 : 0;
              role = __builtin_amdgcn_readfirstlane(cnt & 1); }
#ifdef ROLE_WID
            role = (ROLE_WID == 4) ? (wid >> 2) & 1 : wid & 1;
#endif
#define i16 (fresh_tid() & 15)
            for (int u = bid; u < 256; u += G) { const int bh = (u & 7) + 8 * ((u >> 7) & 1), qb = (u >> 3) & 15, b = bh >> 2, h = bh & 3;
                const int row = b * SEQ + 256 * qb + 32 * wid + i16;
                AttnSrc S{KN + h * 128, 512, Z + ZC_KR, NZ, VTM + (size_t)h * 128 * MT};
                attn_unit<128, 64, 128, false>(lds, S, QM + (size_t)row * 768 + h * 192, QM + (size_t)(row + 16) * 768 + h * 192, YC + (size_t)row * 512 + h * 128, YC + (size_t)(row + 16) * 512 + h * 128,
                                               ML + b * CTXL, 4, b * SEQ, 0, 64, 0, 0, -1e30f, 0.f, role); }
            for (int u = bid; u < 512; u += G) { const int b = u >> 7, kvh = (u >> 6) & 1, qb = u & 63, q0 = 64 * qb, head = 4 * kvh + (wid >> 1);
                const int q = q0 + 32 * (wid & 1) + i16, row = b * SEQ + q;
                int tlo = (128 - q0) / 64; if (tlo < 0) tlo = 0; int thi = (SEQ + 128 - q0) / 64; if (thi > 5) thi = 5;
                const int lp0 = q0 - 128 + 64 * tlo;
                AttnSrc S{Z + ZC_KD + 64 * kvh, NZ, Z, NZ, VTD + (size_t)kvh * 64 * MT};
                attn_unit<64, 0, 64, true>(lds, S, Z + (size_t)row * NZ + ZC_QD + 64 * head, Z + (size_t)(row + 16) * NZ + ZC_QD + 64 * head, YD + (size_t)row * 512 + 64 * head, YD + (size_t)(row + 16) * 512 + 64 * head,
                                           ML + b * CTXL, 4, b * SEQ + lp0, lp0, thi - tlo, q, q + 16, sink[head] * LOG2E, 1.f, role); }
            if (!last) {
                for (int u = bid; u < 16; u += G) { const int b = u >> 2, h = u & 3; const int row = ML + b * CTXL + 32 * wid + i16;
                    AttnSrc S{KN + h * 128, 512, Z + ZC_KR, NZ, VTM + (size_t)h * 128 * MT};
                    attn_unit<128, 64, 128, false>(lds, S, QM + (size_t)row * 768 + h * 192, QM + (size_t)(row + 16) * 768 + h * 192, YC + (size_t)row * 512 + h * 128, YC + (size_t)(row + 16) * 512 + h * 128,
                                                   ML + b * CTXL, 4, 0, 0, 0, 0, 0, -1e30f, 0.f, role); }
                for (int u = bid - 16; u >= 0 && u < 32; u += G) { const int b = u >> 3, kvh = (u >> 2) & 1, qb = u & 3, head = 4 * kvh + (wid >> 1);
                    const int q = 64 * qb + 32 * (wid & 1) + i16, row = ML + b * CTXL + q;
                    AttnSrc S{Z + ZC_KD + 64 * kvh, NZ, Z, NZ, VTD + (size_t)kvh * 64 * MT};
                    attn_unit<64, 0, 64, false>(lds, S, Z + (size_t)row * NZ + ZC_QD + 64 * head, Z + (size_t)(row + 16) * NZ + ZC_QD + 64 * head, YD + (size_t)row * 512 + 64 * head, YD + (size_t)(row + 16) * 512 + 64 * head,
                                                ML + b * CTXL, 4, 0, 0, 0, 0, 0, sink[head] * LOG2E, 1.f, role); }
            }
            __syncthreads();
        }
        SEAM(pb + 6);
#undef i16
        if (IN(pb + 7) && EN(7)) for (int _rep = 0; _rep < (((PROBE_MASK >> 7) & 1) ? 2 : 1); ++_rep) { if (_rep) { MKBAR; xcd_barrier(bar); } GRID; unsigned char* const ws = C.ws();
            pg8::ChainOrder S; S.init((last ? ML : MT) / 256, D / 128, G, bid, 0, WSP(bf16_t, WS_YBR), 256 * 512 * 2, WLP(bf16_t, l, WL_BR), 128 * 512 * 2); S.nsub = MERGE_N; S.map = MERGE_MAP; S.sA = (size_t)MT * 512 * 2; S.sB = (size_t)D * 512 * 2;
            pg8::EpiM1H E{WSP(const bf16_t, WS_Z), WSP(bf16_t, WS_H), S.nsub - 1, S.map}; pg8::gemm_phase<pg8::EpiM1H, pg8::ChainOrder, true, true>(lds, 512, 512, 512, S, E); }
        SEAM(pb + 7);
        if (IN(pb + 8) && EN(8)) for (int _rep = 0; _rep < (((PROBE_MASK >> 8) & 1) ? 2 : 1); ++_rep) { if (_rep) { MKBAR; xcd_barrier(bar); } GRID; unsigned char* const ws = C.ws();
            const bool split = (G >= 256) && !last;
            { pg8::RectOrder S; S.init((last || split ? ML : MT) / 256, D / 256, G, bid, 0, WSP(bf16_t, WS_H), 256 * D * 2, WLP(bf16_t, l, WL_OUT), 256 * D * 2);
              pg8::EpiPlain<false> E{WSP(bf16_t, WS_Y), D, nullptr}; pg8::gemm_phase<pg8::EpiPlain<false>, pg8::RectOrder, true>(lds, D, D, D, S, E); }
            if (split) { const int tile = bid >> 3, part = bid & 7;
              pg8::SplitOrder S; S.pm = ML / 256 + (tile >> 3); S.pn = tile & 7; S.part = part; S.have = bid < 256;
              S.A = (const char*)(WSP(bf16_t, WS_H) + (size_t)S.pm * 256 * D + part * 256); S.B = (const char*)(WLP(bf16_t, l, WL_OUT) + (size_t)S.pn * 256 * D + part * 256);
              pg8::EpiPartial E{C.out(), ML, (size_t)MC * D}; pg8::gemm_phase<pg8::EpiPartial, pg8::SplitOrder, true>(lds, 256, D, D, S, E); } }
        SEAM(pb + 8);
        if (IN(pb + 9) && EN(9)) for (int _rep = 0; _rep < (((PROBE_MASK >> 9) & 1) ? 2 : 1); ++_rep) { if (_rep) { MKBAR; xcd_barrier(bar); } GRID; unsigned char* const ws = C.ws(); float* const out = C.out(); float* const XC = WSP(float, WS_XC);
            norm_phase<false>(lds, G, bid, last ? ML : MT, nullptr, nullptr, WSP(bf16_t, WS_XB), nullptr, true, WSP(const bf16_t, WS_Y), (G >= 256 && !last) ? (const float*)C.out() : nullptr, WSP(const float, WS_MOD) + (size_t)l * 5 * NMOD, 5, 1.0f, C.in(I_NPOST) + ((size_t)l * 3 + 1) * D, WSP(bf16_t, WS_H), WSP(const float, WS_MOD) + (size_t)l * 5 * NMOD, 6, C.in(I_NPRE) + ((size_t)l * 3 + 2) * D); }
        SEAM(pb + 9);
        if (IN(pb + 10) && EN(10)) for (int _rep = 0; _rep < (((PROBE_MASK >> 10) & 1) ? 2 : 1); ++_rep) { if (_rep) { MKBAR; xcd_barrier(bar); } GRID; unsigned char* const ws = C.ws();
            pg8::RectOrder S; S.init((last ? ML : MT) / 256, NGU / 256, G, bid, 0, WSP(bf16_t, WS_H), 256 * D * 2, WLP(bf16_t, l, WL_GU) + (size_t)NGU * D, 256 * D * 2);
            pg8::EpiSwiglu E{WSP(bf16_t, WS_Z)}; pg8::gemm_phase<pg8::EpiSwiglu, pg8::RectOrder, true>(lds, D, D, D, S, E); }
        if (IN(pb + 10) && EN(10)) { GRID; cvt_pull(C, lds, l * CV_LAYER + CV_LAYER + CV_E0, CW_DONE + 64 * (pb + 10), G); }
        SEAM(pb + 10);
        if (IN(pb + 11) && EN(11)) for (int _rep = 0; _rep < (((PROBE_MASK >> 11) & 1) ? 2 : 1); ++_rep) { if (_rep) { MKBAR; xcd_barrier(bar); } GRID; unsigned char* const ws = C.ws();
            const bool split = (G >= 256) && !last;
            { pg8::RectOrder S; S.init((last || split ? ML : MT) / 256, D / 256, G, bid, 0, WSP(bf16_t, WS_Z), 256 * DFF * 2, WLP(bf16_t, l, WL_D) + (size_t)D * DFF, 256 * DFF * 2);
              pg8::EpiPlain<false> E{WSP(bf16_t, WS_Y), D, nullptr}; pg8::gemm_phase<pg8::EpiPlain<false>, pg8::RectOrder, true>(lds, DFF, DFF, DFF, S, E); }
            if (split) { const int tile = bid >> 3, part = bid & 7, ks = part < 5 ? 10 * part : 50 + 12 * (part - 5), kn = part < 5 ? 10 : 12;
              pg8::SplitOrder S; S.pm = ML / 256 + (tile >> 3); S.pn = tile & 7; S.part = part; S.have = bid < 256;
              S.A = (const char*)(WSP(bf16_t, WS_Z) + (size_t)S.pm * 256 * DFF + ks * 64); S.B = (const char*)(WLP(bf16_t, l, WL_D) + (size_t)D * DFF + (size_t)S.pn * 256 * DFF + ks * 64);
              pg8::EpiPartial E{C.out(), ML, (size_t)MC * D}; pg8::gemm_phase<pg8::EpiPartial, pg8::SplitOrder, true>(lds, kn * 64, DFF, DFF, S, E); } }
        SEAM(pb + 11);
    }
    if (IN(NPHASE - 1) && EN(13)) { GRID; unsigned char* const ws = C.ws(); float* const out = C.out(); float* const XC = WSP(float, WS_XC);
        const int l = DEPTH - 1;
        norm_phase<false>(lds, G, bid, ML, nullptr, nullptr, WSP(bf16_t, WS_XB), out, false, WSP(const bf16_t, WS_Y), nullptr, WSP(const float, WS_MOD) + (size_t)l * 5 * NMOD, 8, 0.5f, C.in(I_NPOST) + ((size_t)l * 3 + 2) * D, nullptr, nullptr, 0, nullptr);
    }
#undef IN
#undef SEAM
}


extern "C" void kernel_launch(void* const* d_in, const int* in_sizes, int n_in, void* d_out, int out_size, void* d_ws, size_t ws_size, hipStream_t stream) {
    static int grid = 0;
    if (grid == 0) {
        if (n_in != 28 || out_size != ML * D || ws_size < WS_END) { fprintf(stderr, "kernel_launch: unexpected shapes (n_in %d, out %d, ws %zu < %zu)\n", n_in, out_size, ws_size, (size_t)WS_END); grid = -1; return; }
        int dev = 0, cus = 0, per_cu = 0;
        if (hipGetDevice(&dev) != hipSuccess || hipDeviceGetAttribute(&cus, hipDeviceAttributeMultiprocessorCount, dev) != hipSuccess) { grid = -1; return; }
        if (hipFuncSetAttribute((const void*)mk_fwd, hipFuncAttributeMaxDynamicSharedMemorySize, LDS_BYTES) != hipSuccess) { fprintf(stderr, "kernel_launch: hipFuncSetAttribute failed\n"); grid = -1; return; }
        if (hipOccupancyMaxActiveBlocksPerMultiprocessor(&per_cu, (const void*)mk_fwd, 512, LDS_BYTES) != hipSuccess || per_cu < 1) fprintf(stderr, "kernel_launch: occupancy query says %d\n", per_cu);
        (void)hipGetLastError();
        grid = cus;
    }
    if (grid < 0) return;
    (void)hipMemsetAsync((char*)d_ws + WS_CTL, 0, CTL_ZERO_BYTES, stream);
    Params p{};
    for (int i = 0; i < 28; ++i) p.in[i] = (const float*)d_in[i];
    p.out = (float*)d_out; p.ws = (unsigned char*)d_ws;
#if MK_MULTI
    for (int k = 0; k < NPHASE; ++k) { p.ph_lo = k; p.ph_hi = k + 1; hipLaunchKernelGGL(mk_fwd, dim3(grid), dim3(512), LDS_BYTES, stream, p);
    }
#else
    p.ph_lo = 0; p.ph_hi = NPHASE; hipLaunchKernelGGL(mk_fwd, dim3(grid), dim3(512), LDS_BYTES, stream, p);
#endif
}
```

```cpp
#include <hip/hip_runtime.h>
#include <cstdio>
#include <cstdint>

#define LAS __attribute__((address_space(3)))
#define GAS __attribute__((address_space(1)))
typedef unsigned short bf16_t;
typedef short bf16x8 __attribute__((ext_vector_type(8)));
typedef float f32x4 __attribute__((ext_vector_type(4)));
typedef float f32x2 __attribute__((ext_vector_type(2)));
typedef unsigned u32x4 __attribute__((ext_vector_type(4)));
typedef unsigned u32x2 __attribute__((ext_vector_type(2)));

#ifndef PROBE_MASK
#define PROBE_MASK 0
#endif
#ifndef MK_CHECK_LAYER
#define MK_CHECK_LAYER 1
#endif
#ifndef NORM_NR
#define NORM_NR 4
#endif
#ifndef MERGE_N
#define MERGE_N 4
#define MERGE_MAP 0x3210
#endif
#ifndef PROBE_LOCMASK
#define PROBE_LOCMASK 15
#endif
#ifndef LOCMASK
#define LOCMASK 15
#endif
#ifndef PHMASK
#define PHMASK 0xffff
#endif
#define EN(j) (((PHMASK) >> (j)) & 1)
#ifndef MK_MULTI
#define ROLE_WID 0
#define MK_MULTI 0
#endif

constexpr int D = 2048, NB = 4, SEQ = 4096, DEPTH = 2, CTXL = 256, DFF = 5504;
constexpr int ML = NB * SEQ, MC = NB * CTXL, MT = ML + MC;
constexpr int NMOD = 9 * D, NIN = 11840, NZ = 11776, NZW = 12032, NGU = 2 * DFF;
constexpr int ZC_CQ = 2048, ZC_CKV = 2560, ZC_KR = 2816, ZC_QD = 2880, ZC_KD = 3392, ZC_G = 3584;
constexpr float EPS = 1e-6f;
constexpr float LOG2E = 1.4426950408889634f;

__device__ __forceinline__ unsigned f2bf(float f) { unsigned u = __builtin_bit_cast(unsigned, f); return (u + 0x7fffu + ((u >> 16) & 1u)) >> 16; }
__device__ __forceinline__ unsigned pk2(float lo, float hi) { return f2bf(lo) | (f2bf(hi) << 16); }
__device__ __forceinline__ float bflo(unsigned w) { return __builtin_bit_cast(float, w << 16); }
__device__ __forceinline__ float bfhi(unsigned w) { return __builtin_bit_cast(float, w & 0xffff0000u); }
__device__ __forceinline__ float bf2f(bf16_t h) { return __builtin_bit_cast(float, ((unsigned)h) << 16); }
__device__ __forceinline__ unsigned cvt_pk_bf16(float lo, float hi) { unsigned r; asm volatile("v_cvt_pk_bf16_f32 %0, %1, %2" : "=v"(r) : "v"(lo), "v"(hi)); return r; }
__device__ __forceinline__ float fast_exp2(float x) { return __builtin_amdgcn_exp2f(x); }
__device__ __forceinline__ float vmax(float a, float b) { float r; asm("v_max_f32 %0, %1, %2" : "=v"(r) : "v"(a), "v"(b)); return r; }
__device__ __forceinline__ float vmax3(float a, float b, float c) { float r; asm("v_max3_f32 %0, %1, %2, %3" : "=v"(r) : "v"(a), "v"(b), "v"(c)); return r; }
__device__ __forceinline__ float fast_rcp(float x) { return __builtin_amdgcn_rcpf(x); }
__device__ __forceinline__ float sigmoidf_(float x) { return fast_rcp(1.0f + fast_exp2(-x * LOG2E)); }
__device__ __forceinline__ f32x4 sigmoid4(f32x4 x) { const f32x4 t = x * (-LOG2E); const f32x4 e = (f32x4){fast_exp2(t[0]), fast_exp2(t[1]), fast_exp2(t[2]), fast_exp2(t[3])} + 1.0f;
    return (f32x4){fast_rcp(e[0]), fast_rcp(e[1]), fast_rcp(e[2]), fast_rcp(e[3])}; }
__device__ __forceinline__ int fresh_tid() { int t = threadIdx.x; asm volatile("" : "+v"(t)); return t; }
__device__ __forceinline__ float wave_sum(float v) {
#pragma unroll
    for (int o = 1; o < 64; o <<= 1) v += __shfl_xor(v, o);
    return v;
}
__device__ __forceinline__ float gelu1(float v) {
    const float av = __builtin_fabsf(v), t = fast_rcp(av * 0.2316418882f + 1.0f);
    float q = t * 0.5307027145f + (-0.7265760135f); q = q * t + 0.7107068705f; q = q * t + (-0.142248368f); q = q * t + 0.127414796f; q = q * t;
    const float e = fast_exp2((v * v) * (-0.72134752044f));
    const float m = v * (q * e);
    return v < 0.f ? m : v - m;
}

namespace pg8 {
constexpr int BM = 256, BK = 64, HALF = 128, HTB = HALF * BK * 2, STAGE_BYTES = 8 * HTB, NXCD = 8, WGM = 8;
__host__ __device__ __forceinline__ int lds_byte(int r, int c) { const int st = (r >> 4) * 2 + (c >> 5), rr = r & 15, cc = c & 31, ob = rr * 64 + cc * 2; return st * 1024 + (ob ^ (((ob >> 9) & 1) << 5)); }
__host__ __device__ __forceinline__ void stage_rc(int b, int& R, int& C) { const int st = b / 1024, sb = b % 1024, swz = sb ^ (((sb >> 9) & 1) << 5); R = (st >> 1) * 16 + swz / 64; C = (st & 1) * 32 + (swz % 64) / 2; }
__host__ __device__ __forceinline__ int perm32(int rho) { const int n = rho >> 4, i = rho & 15; return 8 * (i >> 2) + 4 * n + (i & 3); }

struct Unit { int pm, pn, sub; };
struct RectOrder {
    int nM, nN, nwg, G, c; const char* A; const char* B; unsigned tA, tB;
    __device__ __forceinline__ void init(int nM_, int nN_, int G_, int c_, int rot, const void* A_, unsigned tA_, const void* B_, unsigned tB_) { nM = nM_; nN = nN_; nwg = nM * nN; G = G_; c = (c_ + G_ - (rot % G_)) % G_; A = (const char*)A_; B = (const char*)B_; tA = tA_; tB = tB_; }
    __device__ __forceinline__ void tile_of(int wgid, Unit& u) const {
        { const int q = nwg / NXCD, r = nwg % NXCD, xcd = wgid % NXCD, off = wgid / NXCD; wgid = (xcd < r ? xcd * (q + 1) : r * (q + 1) + (xcd - r) * q) + off; }
        const int nig = WGM * nN, gid = wgid / nig, fm = gid * WGM, gsz = (nM - fm) < WGM ? (nM - fm) : WGM;
        u.pm = fm + ((wgid % nig) % gsz); u.pn = (wgid % nig) / gsz;
    }
    __device__ __forceinline__ bool next(int i, Unit& u) const { const long L = (long)i * G + c; if (L >= nwg) return false; tile_of((int)L, u); u.sub = 0; return true; }
    __device__ __forceinline__ const char* aptr(const Unit& u) const { return A + (size_t)u.pm * tA; }
    __device__ __forceinline__ const char* bptr(const Unit& u) const { return B + (size_t)u.pn * tB; }
};
struct SplitOrder {
    int pm, pn, part; bool have; const char* A; const char* B;
    __device__ __forceinline__ bool next(int i, Unit& u) const { if (i > 0 || !have) return false; u.pm = pm; u.pn = pn; u.sub = part; return true; }
    __device__ __forceinline__ const char* aptr(const Unit&) const { return A; }
    __device__ __forceinline__ const char* bptr(const Unit&) const { return B; }
};
struct ChainOrder : RectOrder {
    int nsub, map; size_t sA, sB;
    __device__ __forceinline__ bool next(int i, Unit& u) const { const int su = i / nsub; const long L = (long)su * G + c; if (L >= nwg) return false; tile_of((int)L, u); u.sub = i - su * nsub; return true; }
    __device__ __forceinline__ const char* aptr(const Unit& u) const { return A + (size_t)u.pm * tA + (size_t)((map >> (4 * u.sub)) & 15) * sA; }
    __device__ __forceinline__ const char* bptr(const Unit& u) const { return B + (size_t)u.pn * tB + (size_t)((map >> (4 * u.sub)) & 15) * sB; }
};

template <class Epi, class Sched, bool ALIGN_EPI, bool HALFN = false>
__device__ __forceinline__ void gemm_phase(LAS unsigned char* lds, const int K, const int lda, const int ldb, const Sched& S, const Epi& E) {
    const int tid = fresh_tid(), wid = __builtin_amdgcn_readfirstlane(tid >> 6), lane = tid & 63, wr = wid >> 2, wc = wid & 3, fr = lane & 15, fq = lane >> 4;
    const int nt = K / BK;
    unsigned voffA[2], voffB[2];
#pragma unroll
    for (int i = 0; i < 2; ++i) { int R, C; stage_rc(tid * 16 + i * 8192, R, C); const int Rb = Epi::PERM ? ((R & ~31) + perm32(R & 31)) : R;
        voffA[i] = (unsigned)(R * lda + C) * 2u; voffB[i] = (unsigned)(Rb * ldb + C) * 2u; }
    const size_t kstep = (size_t)(BK * 2);
    const size_t hstepA = (size_t)HALF * lda * 2, hstepB = (size_t)HALF * ldb * 2;
    const unsigned ldsw = (unsigned)wid * 1024u;
    const int aoff = lds_byte(wr * 64 + fr, fq * 8), boff = lds_byte(wc * 32 + fr, fq * 8);
#define PG8_SA(b, h) (((b) * 2 + (h)) * HTB)
#define PG8_SB(b, h) ((4 + (b) * 2 + (h)) * HTB)
#define PG8_STAGE(bufoff, gbase, voff) do { _Pragma("unroll") for (int _i = 0; _i < 2; ++_i) \
        __builtin_amdgcn_global_load_lds((const unsigned*)((const char*)(gbase) + (voff)[_i]), (LAS unsigned*)(lds + (bufoff) + ldsw + _i * 8192), 16, 0, 0); } while (0)
#define PG8_LDA(dst, b, h) do { _Pragma("unroll") for (int m = 0; m < 4; ++m) _Pragma("unroll") for (int k = 0; k < 2; ++k) dst[m][k] = *(const LAS bf16x8*)(lds + PG8_SA(b, h) + aoff + m * 2048 + k * 1024); } while (0)
#define PG8_LDB(dst, b, h) do { _Pragma("unroll") for (int n = 0; n < 2; ++n) _Pragma("unroll") for (int k = 0; k < 2; ++k) dst[n][k] = *(const LAS bf16x8*)(lds + PG8_SB(b, h) + boff + n * 2048 + k * 1024); } while (0)
#define PG8_MMA(ai, bj, At, Bt) do { __builtin_amdgcn_s_setprio(1); _Pragma("unroll") for (int m = 0; m < 4; ++m) _Pragma("unroll") for (int n = 0; n < 2; ++n) _Pragma("unroll") for (int k = 0; k < 2; ++k) \
        acc[ai][bj][m][n] = __builtin_amdgcn_mfma_f32_16x16x32_bf16(Bt[n][k], At[m][k], acc[ai][bj][m][n], 0, 0, 0); __builtin_amdgcn_s_setprio(0); } while (0)
#define PG8_WAIT_V(n) asm volatile("s_waitcnt vmcnt(" #n ")" ::: "memory")
#define PG8_WAIT_L(n) asm volatile("s_waitcnt lgkmcnt(" #n ")" ::: "memory")
#define PG8_WAIT_VH do { if constexpr (HALFN) PG8_WAIT_V(6); else PG8_WAIT_V(8); } while (0)
#define PG8_BAR __builtin_amdgcn_s_barrier()
#define PG8_SCHED __builtin_amdgcn_sched_barrier(0)
    Unit cur, nxt; int ui = 0;
    if (!S.next(0, cur)) return;
    f32x4 acc[2][2][4][2];
#pragma unroll
    for (int a = 0; a < 2; ++a)
#pragma unroll
        for (int b = 0; b < 2; ++b)
#pragma unroll
            for (int m = 0; m < 4; ++m)
#pragma unroll
                for (int n = 0; n < 2; ++n) acc[a][b][m][n] = (f32x4){0.f, 0.f, 0.f, 0.f};
    bf16x8 At[4][2], B0[2][2], B1[2][2];
    const char* cA = S.aptr(cur); const char* cB = S.bptr(cur);
    PG8_STAGE(PG8_SB(0, 0), cB, voffB); if constexpr (!HALFN) PG8_STAGE(PG8_SB(0, 1), cB + hstepB, voffB); PG8_STAGE(PG8_SA(0, 0), cA, voffA); PG8_STAGE(PG8_SA(0, 1), cA + hstepA, voffA);
    if (wr == 1) PG8_BAR;
    PG8_WAIT_V(2); PG8_BAR;
    PG8_STAGE(PG8_SB(1, 0), cB + kstep, voffB); PG8_STAGE(PG8_SA(1, 0), cA + kstep, voffA); if constexpr (!HALFN) PG8_STAGE(PG8_SB(1, 1), cB + hstepB + kstep, voffB);
    if constexpr (HALFN) PG8_WAIT_V(4); else PG8_WAIT_V(6);
    PG8_BAR;
    for (;;) {
        const bool has_next = S.next(ui + 1, nxt);
        const char* nA = has_next ? S.aptr(nxt) : cA; const char* nB = has_next ? S.bptr(nxt) : cB;
#pragma unroll 1
        for (int t = 0; t < nt; t += 2) {
            const bool last = (t == nt - 2);
            const char* a1 = cA + (size_t)(t + 1) * kstep;
            const char* a2 = last ? nA : cA + (size_t)(t + 2) * kstep; const char* b2 = last ? nB : cB + (size_t)(t + 2) * kstep;
            const char* a3 = a2 + kstep; const char* b3 = b2 + kstep;
            PG8_LDB(B0, 0, 0); if constexpr (!HALFN) PG8_LDB(B1, 0, 1); PG8_SCHED; PG8_LDA(At, 0, 0); PG8_STAGE(PG8_SA(1, 1), a1 + hstepA, voffA);
            PG8_WAIT_VH; PG8_WAIT_L(0); PG8_BAR; PG8_MMA(0, 0, At, B0); if constexpr (!HALFN) PG8_MMA(0, 1, At, B1); PG8_BAR; PG8_SCHED;
            PG8_LDA(At, 0, 1); PG8_STAGE(PG8_SB(0, 0), b2, voffB); if constexpr (!HALFN) PG8_STAGE(PG8_SB(0, 1), b2 + hstepB, voffB); PG8_STAGE(PG8_SA(0, 0), a2, voffA);
            PG8_WAIT_VH; PG8_WAIT_L(0); PG8_BAR; PG8_MMA(1, 0, At, B0); if constexpr (!HALFN) PG8_MMA(1, 1, At, B1); PG8_BAR; PG8_SCHED;
            PG8_LDB(B0, 1, 0); if constexpr (!HALFN) PG8_LDB(B1, 1, 1); PG8_SCHED; PG8_LDA(At, 1, 0); PG8_STAGE(PG8_SA(0, 1), a2 + hstepA, voffA);
            PG8_WAIT_VH; PG8_WAIT_L(0); PG8_BAR; PG8_MMA(0, 0, At, B0); if constexpr (!HALFN) PG8_MMA(0, 1, At, B1); PG8_BAR; PG8_SCHED;
            PG8_LDA(At, 1, 1); PG8_STAGE(PG8_SB(1, 0), b3, voffB); if constexpr (!HALFN) PG8_STAGE(PG8_SB(1, 1), b3 + hstepB, voffB); PG8_STAGE(PG8_SA(1, 0), a3, voffA);
            PG8_WAIT_VH; PG8_WAIT_L(0); PG8_BAR; PG8_MMA(1, 0, At, B0); if constexpr (!HALFN) PG8_MMA(1, 1, At, B1); PG8_BAR; PG8_SCHED;
        }
        if constexpr (ALIGN_EPI) { if (wr == 0) PG8_BAR; }
        const bool keep = E(acc, cur, wr, wc, fr, fq);
        if (!has_next) break;
        if (!keep) {
#pragma unroll
        for (int a = 0; a < 2; ++a)
#pragma unroll
            for (int b = 0; b < 2; ++b)
#pragma unroll
                for (int m = 0; m < 4; ++m)
#pragma unroll
                    for (int n = 0; n < 2; ++n) acc[a][b][m][n] = (f32x4){0.f, 0.f, 0.f, 0.f};
        }
        cur = nxt; cA = nA; cB = nB; ++ui;
        if constexpr (ALIGN_EPI) { if (wr == 1) PG8_BAR; }
    }
    PG8_WAIT_V(0);
    if constexpr (!ALIGN_EPI) { if (wr == 0) PG8_BAR; }
    PG8_BAR;
#undef PG8_SA
#undef PG8_SB
#undef PG8_STAGE
#undef PG8_LDA
#undef PG8_LDB
#undef PG8_MMA
#undef PG8_WAIT_V
#undef PG8_WAIT_L
#undef PG8_WAIT_VH
#undef PG8_BAR
#undef PG8_SCHED
}
}

constexpr size_t MiB = 1u << 20;
constexpr size_t WS_CTL = 0, CTL_ZERO_BYTES = 1 * MiB;
constexpr size_t WS_MOD = 1 * MiB;
constexpr size_t WS_TAB = 2 * MiB;
constexpr size_t WS_SSP = 2 * MiB + 65536;
constexpr size_t WS_XC = 3 * MiB;
constexpr size_t WS_H = 11 * MiB;
constexpr size_t WS_Y = 79 * MiB;
constexpr size_t WS_HB = 147 * MiB;
constexpr size_t WS_YBR = 164 * MiB;
constexpr size_t WS_QM = 232 * MiB;
constexpr size_t WS_KN = 258 * MiB;
constexpr size_t WS_VTM = 275 * MiB;
constexpr size_t WS_Z = 292 * MiB;
constexpr size_t WS_W = 692 * MiB;
constexpr size_t WL_GU = 0, WL_D = 86 * MiB, WL_IN = 129 * MiB, WL_UQ = 176 * MiB, WL_KV = 177 * MiB, WL_BR = 178 * MiB, WL_OUT = 186 * MiB, WL_GMW = 194 * MiB, WL_BZ = 194 * MiB + 262144, WL_SIZE = 195 * MiB;
constexpr size_t WS_VTD = WS_W + DEPTH * WL_SIZE;
constexpr size_t WS_XB = WS_VTD + 9 * MiB;
constexpr size_t WS_END = WS_XB + 68 * MiB;
static_assert(WS_SSP + (size_t)MT * 12 * 4 <= WS_XC && WS_XC + (size_t)MC * D * 4 <= WS_H && WS_H + (size_t)MT * D * 2 <= WS_Y && WS_Y + (size_t)MT * D * 2 <= WS_HB, "ws map 1");
static_assert(WS_HB + (size_t)MT * 512 * 2 <= WS_YBR && WS_YBR + (size_t)4 * MT * 512 * 2 <= WS_QM && WS_QM + (size_t)MT * 768 * 2 <= WS_KN && WS_KN + (size_t)MT * 512 * 2 <= WS_VTM && WS_VTM + (size_t)512 * MT * 2 <= WS_Z && WS_Z + (size_t)MT * NZ * 2 <= WS_W, "ws map 2");
static_assert((size_t)2 * NGU * D * 2 <= WL_D && WL_D + (size_t)2 * D * DFF * 2 <= WL_IN && WL_IN + (size_t)NZW * D * 2 <= WL_UQ && WL_UQ + 768 * 512 * 2 <= WL_KV && WL_KV + 1024 * 256 * 2 <= WL_BR && WL_BR + (size_t)4 * D * 512 * 2 <= WL_OUT && WL_OUT + (size_t)D * D * 2 <= WL_GMW && WL_GMW + 4 * 128 * 128 * 2 <= WL_BZ && WL_BZ + NZW * 4 <= WL_SIZE, "weight map");
static_assert((size_t)DEPTH * 5 * NMOD * 4 <= 1 * MiB, "mod");
constexpr int CW_BAR = 4096;

constexpr int RING_BYTES = 131072, MISC_OFF = RING_BYTES + 320, LTAB_OFF = RING_BYTES + 2048  , LDS_BYTES = 147456;

#define XB_TMO      128
#define XB_XCNT(j)  (256  + 64 * (j))
#define XB_XSUB(j)  (1280 + 64 * (j))
#define XB_XGEN(j)  (2304 + 64 * (j))
#define XB_TOP      3328
#define XB_TOPGEN   3392
#define XCD_BAR_WORDS 3456
#define XB_SPIN_CAP (1u << 20)
__device__ __forceinline__ unsigned xb_ld(unsigned* p)              { return __hip_atomic_load(p, __ATOMIC_RELAXED, __HIP_MEMORY_SCOPE_AGENT); }
__device__ __forceinline__ unsigned xb_add(unsigned* p, unsigned v) { return __hip_atomic_fetch_add(p, v, __ATOMIC_RELAXED, __HIP_MEMORY_SCOPE_AGENT); }
__device__ __forceinline__ unsigned xb_xcc_id() { return (unsigned)__builtin_amdgcn_s_getreg((3 << 11) | 20) & 0xFu; }
#define XB_SPIN(cond, bar) do { unsigned _sp = 0; while (cond) { __builtin_amdgcn_s_sleep(1); \
    if ((++_sp & 255u) == 0u) { if (xb_ld(&(bar)[XB_TMO])) break; if (_sp > XB_SPIN_CAP) { atomicAdd(&(bar)[XB_TMO], 1u); break; } } } } while (0)
struct XcdBarrier { unsigned* bar; unsigned x; volatile LAS unsigned* st; };
__device__ __forceinline__ XcdBarrier xcd_barrier_post(unsigned* bar, volatile LAS unsigned* st) {
    XcdBarrier b; b.bar = bar; b.x = xb_xcc_id(); b.st = st;
    if (threadIdx.x == 0) (void)xb_add(&bar[XB_XCNT(b.x)], 1u);
    return b;
}
__device__ __forceinline__ void xcd_barrier_complete(unsigned* bar, unsigned x, unsigned& nloc, unsigned& nx) {
    const unsigned G = gridDim.x * gridDim.y * gridDim.z;
    unsigned sum, cnt, mine, sp = 0u;
    for (;;) {
        sum = 0u; cnt = 0u; mine = 0u;
#pragma unroll
        for (unsigned j = 0; j < 16; ++j) { const unsigned c = xb_ld(&bar[XB_XCNT(j)]); sum += c; cnt += (c > 0u) ? 1u : 0u; mine = (j == x) ? c : mine; }
        if (sum == G) break;
        __builtin_amdgcn_s_sleep(1);
        if ((++sp & 255u) == 0u) { if (xb_ld(&bar[XB_TMO])) break; if (sp > XB_SPIN_CAP) { atomicAdd(&bar[XB_TMO], 1u); break; } }
    }
    nloc = mine > 0u ? mine : 1u; nx = cnt > 0u ? cnt : 1u;
}
__device__ __forceinline__ void xcd_barrier(const XcdBarrier& b) {
    asm volatile("s_waitcnt vmcnt(0)" ::: "memory");
    __syncthreads();
    if (threadIdx.x == 0) {
        unsigned* bar = b.bar;
        __builtin_amdgcn_s_waitcnt(0);
        unsigned nloc = b.st[0], nx = b.st[1];
        if (nloc == 0u) { xcd_barrier_complete(bar, b.x, nloc, nx); b.st[0] = nloc; b.st[1] = nx; }
        const unsigned old = xb_add(&bar[XB_XSUB(b.x)], 1u);
        const unsigned gen = old / nloc;
        if (old + 1u == (gen + 1u) * nloc) {
            __builtin_amdgcn_fence(__ATOMIC_RELEASE, "agent");
            asm volatile("s_waitcnt vmcnt(0)" ::: "memory");
            const unsigned og = xb_add(&bar[XB_TOP], 1u);
            const unsigned tg = og / nx;
            if (og + 1u == (tg + 1u) * nx) xb_add(&bar[XB_TOPGEN], 1u);
            else XB_SPIN(xb_ld(&bar[XB_TOPGEN]) == tg, bar);
            __builtin_amdgcn_fence(__ATOMIC_ACQUIRE, "agent");
            xb_add(&bar[XB_XGEN(b.x)], 1u);
            asm volatile("s_waitcnt vmcnt(0)" ::: "memory");
        } else {
            XB_SPIN(xb_ld(&bar[XB_XGEN(b.x)]) == gen, bar);
            __builtin_amdgcn_fence(__ATOMIC_ACQUIRE, "agent");
            asm volatile("s_waitcnt vmcnt(0)" ::: "memory");
        }
    }
    __syncthreads();
}

constexpr int RING_BYTES_C = 131072;
struct Params { const float* in[28]; float* out; unsigned char* ws; int ph_lo, ph_hi; };
enum { I_X = 0, I_C, I_CTX, I_CCTX, I_WMOD, I_BMOD, I_NPRE, I_NPOST, I_WG, I_WU, I_WD, I_WIN, I_BIN, I_GMLNG, I_GMLNB, I_GMWS, I_GMBS, I_CVDW, I_CVDB, I_CVLNG, I_CVLNB, I_QNORM, I_KVNORM, I_WUQ, I_WUKV, I_SINK, I_WBR, I_WOUT };

constexpr int PTAB_OFF = RING_BYTES_C + 1024;
struct Ctx { volatile LAS unsigned* tab;
    __device__ __forceinline__ unsigned long long get(int i) const { const unsigned lo = __builtin_amdgcn_readfirstlane(tab[2 * i]), hi = __builtin_amdgcn_readfirstlane(tab[2 * i + 1]); return ((unsigned long long)hi << 32) | lo; }
    __device__ __forceinline__ const float* in(int i) const { return (const float*)(const GAS float*)get(i); }
    __device__ __forceinline__ float* out() const { return (float*)(GAS float*)get(28); }
    __device__ __forceinline__ unsigned char* ws() const { return (unsigned char*)(GAS unsigned char*)get(29); }
};
#define WSP(T, off) ((T*)(ws + (off)))
#define WLP(T, l, off) ((T*)(ws + WS_W + (size_t)(l) * WL_SIZE + (off)))

namespace pg8 {
struct EpiSwiglu { static constexpr bool PERM = true; bf16_t* O;
    __device__ __forceinline__ bool operator()(f32x4 (&acc)[2][2][4][2], const Unit& u, int wr, int wc, int fr, int fq) const {
        const int row0 = u.pm * BM + wr * 64 + fr, col0 = u.pn * HALF + wc * 32 + 8 * fq;
#pragma unroll
        for (int ai = 0; ai < 2; ++ai)
#pragma unroll
            for (int m = 0; m < 4; ++m) { bf16_t* rowp = O + (size_t)(row0 + ai * HALF + m * 16) * DFF + col0; f32x4 v[2];
#pragma unroll
                for (int n = 0; n < 2; ++n) { const f32x4 g = acc[ai][0][m][n], up = acc[ai][1][m][n];
                    const f32x4 t = g * (-LOG2E); const f32x4 e = (f32x4){fast_exp2(t[0]), fast_exp2(t[1]), fast_exp2(t[2]), fast_exp2(t[3])} + 1.0f;
                    v[n] = (g * up) * (f32x4){fast_rcp(e[0]), fast_rcp(e[1]), fast_rcp(e[2]), fast_rcp(e[3])}; }
                u32x4 w; w.x = cvt_pk_bf16(v[0][0], v[0][1]); w.y = cvt_pk_bf16(v[0][2], v[0][3]); w.z = cvt_pk_bf16(v[1][0], v[1][1]); w.w = cvt_pk_bf16(v[1][2], v[1][3]);
                *(u32x4*)rowp = w; }
        return false;
    }
};
template <bool RS> struct EpiPlain { static constexpr bool PERM = true; bf16_t* O; int ldc; const float* ssp;
    __device__ __forceinline__ bool operator()(f32x4 (&acc)[2][2][4][2], const Unit& u, int wr, int wc, int fr, int fq) const {
        const int row0 = u.pm * BM + wr * 64 + fr, col0 = u.pn * BM + wc * 32 + 8 * fq;
        f32x4 pr[2][4];
        if (RS) {
#pragma unroll
            for (int ai = 0; ai < 2; ++ai)
#pragma unroll
                for (int m = 0; m < 4; ++m) pr[ai][m] = *(const f32x4*)(ssp + (size_t)(row0 + ai * HALF + m * 16) * 12 + 8);
            __builtin_amdgcn_sched_barrier(0);
        }
#pragma unroll
        for (int ai = 0; ai < 2; ++ai)
#pragma unroll
            for (int m = 0; m < 4; ++m) { const int row = row0 + ai * HALF + m * 16; bf16_t* rowp = O + (size_t)row * ldc + col0; float sc = 1.f;
                if (RS) { const f32x4 p = pr[ai][m]; sc = __builtin_amdgcn_rsqf(((p[0] + p[1]) + (p[2] + p[3])) * (1.f / 256.f) + EPS); }
#pragma unroll
                for (int bj = 0; bj < 2; ++bj) { const f32x4 v0 = acc[ai][bj][m][0] * sc, v1 = acc[ai][bj][m][1] * sc;
                    u32x4 w; w.x = cvt_pk_bf16(v0[0], v0[1]); w.y = cvt_pk_bf16(v0[2], v0[3]); w.z = cvt_pk_bf16(v1[0], v1[1]); w.w = cvt_pk_bf16(v1[2], v1[3]);
                    *(u32x4*)(rowp + bj * HALF) = w; } }
        return false;
    }
};
struct EpiPartial { static constexpr bool PERM = false; float* P; int row_base; size_t pstride;
    __device__ __forceinline__ bool operator()(f32x4 (&acc)[2][2][4][2], const Unit& u, int wr, int wc, int fr, int fq) const {
        const int row0 = u.pm * BM - row_base + wr * 64 + fr, col0 = u.pn * BM + wc * 32 + 4 * fq; float* base = P + (size_t)u.sub * pstride;
#pragma unroll
        for (int ai = 0; ai < 2; ++ai)
#pragma unroll
            for (int m = 0; m < 4; ++m) { float* rowp = base + (size_t)(row0 + ai * HALF + m * 16) * D + col0;
#pragma unroll
                for (int bj = 0; bj < 2; ++bj)
#pragma unroll
                    for (int n = 0; n < 2; ++n) *(f32x4*)(rowp + bj * HALF + n * 16) = acc[ai][bj][m][n]; }
        return false;
    }
};
__device__ __forceinline__ void rope4(f32x4& v0, f32x4& v1, const LAS float* tab) {
    const f32x4 t0 = *(const LAS f32x4*)tab, t1 = *(const LAS f32x4*)(tab + 4);
    const float c[4] = {t0[0], t0[2], t1[0], t1[2]}, s[4] = {t0[1], t0[3], t1[1], t1[3]};
#pragma unroll
    for (int i = 0; i < 4; ++i) { const float a = v0[i], b = v1[i]; v0[i] = a * c[i] - b * s[i]; v1[i] = b * c[i] + a * s[i]; }
}
struct EpiQ { static constexpr bool PERM = true; bf16_t* O; const float* ssp; const LAS float* tab;
    __device__ __forceinline__ bool operator()(f32x4 (&acc)[2][2][4][2], const Unit& u, int wr, int wc, int fr, int fq) const {
        const int row0 = u.pm * BM + wr * 64 + fr, col0 = u.pn * BM + wc * 32 + 8 * fq;
        const float qs = 0.07216878364870322f * LOG2E;
#pragma unroll
        for (int ai = 0; ai < 2; ++ai) {
        f32x4 pr0[4], pr1[4];
#pragma unroll
        for (int m = 0; m < 4; ++m) { const size_t ro = (size_t)(row0 + ai * HALF + m * 16) * 12; pr0[m] = *(const f32x4*)(ssp + ro); pr1[m] = *(const f32x4*)(ssp + ro + 4); }
        __builtin_amdgcn_sched_barrier(0);
#pragma unroll
            for (int m = 0; m < 4; ++m) { const int row = row0 + ai * HALF + m * 16; bf16_t* rowp = O + (size_t)row * 768 + col0;
                const f32x4 p0 = pr0[m], p1 = pr1[m];
                const float sc = __builtin_amdgcn_rsqf((((p0[0] + p0[1]) + (p0[2] + p0[3])) + ((p1[0] + p1[1]) + (p1[2] + p1[3]))) * (1.f / 512.f) + EPS) * qs;
                const int t = row & (SEQ - 1); const bool lat = row < ML;
#pragma unroll
                for (int bj = 0; bj < 2; ++bj) { const int grp = (u.pn * 8 + bj * 4 + wc) % 6;
                    f32x4 v0 = acc[ai][bj][m][0] * sc, v1 = acc[ai][bj][m][1] * sc;
                    if (grp >= 4 && lat) { const int pos = (grp == 4) ? (t >> 6) : (t & 63); rope4(v0, v1, tab + (pos * 16 + 4 * fq) * 2); }
                    u32x4 w; w.x = cvt_pk_bf16(v0[0], v0[1]); w.y = cvt_pk_bf16(v0[2], v0[3]); w.z = cvt_pk_bf16(v1[0], v1[1]); w.w = cvt_pk_bf16(v1[2], v1[3]);
                    *(u32x4*)(rowp + bj * HALF) = w; } }
        __builtin_amdgcn_sched_barrier(0); }
        return false;
    }
};
struct EpiZ { static constexpr bool PERM = true; bf16_t* Z; bf16_t* HB; float* ssp; const float* bias; const LAS float* tab; int pn_off, row_base;
    __device__ __forceinline__ bool operator()(f32x4 (&acc)[2][2][4][2], const Unit& u, int wr, int wc, int fr, int fq) const {
        const int pn = u.pn + pn_off;
        const int row0 = row_base + u.pm * BM + wr * 64 + fr, col0 = pn * BM + wc * 32 + 8 * fq;
        f32x4 bv[2][2];
#pragma unroll
        for (int bj = 0; bj < 2; ++bj)
#pragma unroll
            for (int n = 0; n < 2; ++n) bv[bj][n] = *(const f32x4*)(bias + col0 + bj * HALF + 4 * n);
        if (pn >= 4 && pn < 8) {
#pragma unroll
            for (int ai = 0; ai < 2; ++ai)
#pragma unroll
                for (int m = 0; m < 4; ++m) { bf16_t* rowp = HB + (size_t)(row0 + ai * HALF + m * 16) * 512 + (pn - 4) * HALF + wc * 32 + 8 * fq; float h[8];
#pragma unroll
                    for (int n = 0; n < 2; ++n) { const f32x4 a = acc[ai][0][m][n] + bv[0][n], gt = acc[ai][1][m][n] + bv[1][n];
                        const f32x4 hv = a * sigmoid4(gt); h[4 * n] = hv[0]; h[4 * n + 1] = hv[1]; h[4 * n + 2] = hv[2]; h[4 * n + 3] = hv[3]; }
                    u32x4 w; w.x = cvt_pk_bf16(h[0], h[1]); w.y = cvt_pk_bf16(h[2], h[3]); w.z = cvt_pk_bf16(h[4], h[5]); w.w = cvt_pk_bf16(h[6], h[7]); *(u32x4*)rowp = w; }
        } else {
#pragma unroll
        for (int ai = 0; ai < 2; ++ai)
#pragma unroll
            for (int m = 0; m < 4; ++m) { const int row = row0 + ai * HALF + m * 16; bf16_t* rowp = Z + (size_t)row * NZ + col0; float ss = 0.f;
                const int t = row & (SEQ - 1); const bool lat = row < ML;
#pragma unroll
                for (int bj = 0; bj < 2; ++bj) { f32x4 v0 = acc[ai][bj][m][0] + bv[bj][0], v1 = acc[ai][bj][m][1] + bv[bj][1];
                    if (pn < 4) {
#pragma unroll
                        for (int i = 0; i < 4; ++i) { v0[i] = gelu1(v0[i]); v1[i] = gelu1(v1[i]); }
                    } else if (pn < 11) {
#pragma unroll
                        for (int i = 0; i < 4; ++i) ss += v0[i] * v0[i] + v1[i] * v1[i];
                    } else if (pn < 14) { const int grp = pn * 8 + bj * 4 + wc;
                        if (grp >= 88 && grp < 110 && lat) { const int pos = (grp & 1) ? (t & 63) : (t >> 6); rope4(v0, v1, tab + (pos * 16 + 4 * fq) * 2); }
                        if (grp >= 90 && grp < 106) { v0 = v0 * (0.125f * LOG2E); v1 = v1 * (0.125f * LOG2E); }
                    } else {
                        v0 = sigmoid4(v0); v1 = sigmoid4(v1);
                    }
                    u32x4 w; w.x = cvt_pk_bf16(v0[0], v0[1]); w.y = cvt_pk_bf16(v0[2], v0[3]); w.z = cvt_pk_bf16(v1[0], v1[1]); w.w = cvt_pk_bf16(v1[2], v1[3]);
                    *(u32x4*)(rowp + bj * HALF) = w; }
                if (pn >= 8 && pn < 11) { ss += __shfl_xor(ss, 16); ss += __shfl_xor(ss, 32); ssp[(size_t)row * 12 + (pn - 8) * 4 + wc] = ss; } }
        }
        asm volatile("" :: "v"(bv[0][0]), "v"(bv[0][1]), "v"(bv[1][0]), "v"(bv[1][1]));
        return false;
    }
};
template <bool COLSCALE> struct EpiVt { static constexpr bool PERM = true; bf16_t* O; int ldc; const float* rbias; const float* ssp;
    __device__ __forceinline__ bool operator()(f32x4 (&acc)[2][2][4][2], const Unit& u, int wr, int wc, int fr, int fq) const {
        const int row0 = u.pm * BM + wr * 64 + fr, col0 = u.pn * BM + wc * 32 + 8 * fq;
        float sc[2][8];
        if (COLSCALE) {
#pragma unroll
            for (int bj = 0; bj < 2; ++bj) { f32x4 pc[8];
#pragma unroll
                for (int e = 0; e < 8; ++e) pc[e] = *(const f32x4*)(ssp + (size_t)(col0 + bj * HALF + e) * 12 + 8);
                __builtin_amdgcn_sched_barrier(0);
#pragma unroll
                for (int e = 0; e < 8; ++e) { const f32x4 p = pc[e]; sc[bj][e] = __builtin_amdgcn_rsqf(((p[0] + p[1]) + (p[2] + p[3])) * (1.f / 256.f) + EPS); }
                __builtin_amdgcn_sched_barrier(0); }
        } else {
#pragma unroll
            for (int bj = 0; bj < 2; ++bj)
#pragma unroll
                for (int e = 0; e < 8; ++e) sc[bj][e] = 1.f;
        }
        float rbv[2][4];
#pragma unroll
        for (int ai = 0; ai < 2; ++ai)
#pragma unroll
            for (int m = 0; m < 4; ++m) rbv[ai][m] = COLSCALE ? 0.f : rbias[row0 + ai * HALF + m * 16];
        __builtin_amdgcn_sched_barrier(0);
#pragma unroll
        for (int ai = 0; ai < 2; ++ai)
#pragma unroll
            for (int m = 0; m < 4; ++m) { const int row = row0 + ai * HALF + m * 16; bf16_t* rowp = O + (size_t)row * ldc + col0; const float rb = rbv[ai][m];
#pragma unroll
                for (int bj = 0; bj < 2; ++bj) { const f32x4 a0 = acc[ai][bj][m][0] + rb, a1 = acc[ai][bj][m][1] + rb;
                    u32x4 w; w.x = cvt_pk_bf16(a0[0] * sc[bj][0], a0[1] * sc[bj][1]); w.y = cvt_pk_bf16(a0[2] * sc[bj][2], a0[3] * sc[bj][3]); w.z = cvt_pk_bf16(a1[0] * sc[bj][4], a1[1] * sc[bj][5]); w.w = cvt_pk_bf16(a1[2] * sc[bj][6], a1[3] * sc[bj][7]);
                    *(u32x4*)(rowp + bj * HALF) = w; } }
        return false;
    }
};
struct EpiM1 { static constexpr bool PERM = true; const bf16_t* Z; bf16_t* T; int nlast, map;
    __device__ __forceinline__ void loadb(const bf16_t* sp, const bf16_t* sp2, int b, u32x4 (&s)[2][2], u32x4 (&s2)[2][2]) const {
#pragma unroll
        for (int mm = 0; mm < 2; ++mm)
#pragma unroll
            for (int bj = 0; bj < 2; ++bj) { const size_t ro = (size_t)((b >> 1) * HALF + (2 * (b & 1) + mm) * 16) * NZ + bj * HALF; s[mm][bj] = *(const u32x4*)(sp + ro); s2[mm][bj] = *(const u32x4*)(sp2 + ro); }
    }
    __device__ __forceinline__ bool operator()(f32x4 (&acc)[2][2][4][2], const Unit& u, int wr, int wc, int fr, int fq) const {
        const int row0 = u.pm * BM + wr * 64 + fr, col0 = u.pn * BM + wc * 32 + 8 * fq; const int sub = u.sub;
        const int br = (map >> (4 * sub)) & 15, br2 = (map >> (4 * sub + 4)) & 15; const bool mid = sub < nlast;
        const bf16_t* sp = Z + (size_t)row0 * NZ + ZC_G + br * D + col0; const bf16_t* sp2 = Z + (size_t)row0 * NZ + ZC_G + (mid ? br2 : br) * D + col0;
        u32x4 sA[2][2], s2A[2][2], sB[2][2], s2B[2][2];
        loadb(sp, sp2, 0, sA, s2A);
#pragma unroll
        for (int b = 0; b < 4; ++b) {
            if (b + 1 < 4) { if (b & 1) loadb(sp, sp2, b + 1, sA, s2A); else loadb(sp, sp2, b + 1, sB, s2B); }
            __builtin_amdgcn_sched_barrier(0);
            const int ai = b >> 1, mp = b & 1;
#pragma unroll
            for (int mm = 0; mm < 2; ++mm)
#pragma unroll
                for (int bj = 0; bj < 2; ++bj) { const int m = 2 * mp + mm; const u32x4 a = (b & 1) ? sB[mm][bj] : sA[mm][bj], c = (b & 1) ? s2B[mm][bj] : s2A[mm][bj];
                    float g[8] = {bflo(a.x), bfhi(a.x), bflo(a.y), bfhi(a.y), bflo(a.z), bfhi(a.z), bflo(a.w), bfhi(a.w)};
                    if (mid) { const float g2[8] = {bflo(c.x), bfhi(c.x), bflo(c.y), bfhi(c.y), bflo(c.z), bfhi(c.z), bflo(c.w), bfhi(c.w)};
#pragma unroll
                        for (int i = 0; i < 8; ++i) g[i] = g[i] * fast_rcp(__builtin_fmaxf(g2[i], 1e-30f));
#pragma unroll
                        for (int i = 0; i < 4; ++i) { acc[ai][bj][m][0][i] *= g[i]; acc[ai][bj][m][1][i] *= g[4 + i]; }
                    } else { f32x4 v0, v1; asm volatile("" :: "v"(c));
#pragma unroll
                        for (int i = 0; i < 4; ++i) { v0[i] = acc[ai][bj][m][0][i] * g[i]; v1[i] = acc[ai][bj][m][1][i] * g[4 + i]; }
                        u32x4 w; w.x = cvt_pk_bf16(v0[0], v0[1]); w.y = cvt_pk_bf16(v0[2], v0[3]); w.z = cvt_pk_bf16(v1[0], v1[1]); w.w = cvt_pk_bf16(v1[2], v1[3]);
                        *(u32x4*)(T + (size_t)(row0 + ai * HALF + m * 16) * D + col0 + bj * HALF) = w; } }
            __builtin_amdgcn_sched_barrier(0);
        }
        return mid;
    }
};
struct EpiM1H { static constexpr bool PERM = true; const bf16_t* Z; bf16_t* T; int nlast, map;
    __device__ __forceinline__ bool operator()(f32x4 (&acc)[2][2][4][2], const Unit& u, int wr, int wc, int fr, int fq) const {
        const int row0 = u.pm * BM + wr * 64 + fr, col0 = u.pn * HALF + wc * 32 + 8 * fq; const int sub = u.sub; const int br = (map >> (4 * sub)) & 15;
        const bf16_t* sp = Z + (size_t)row0 * NZ + ZC_G + br * D + col0;
        u32x4 s[2][4];
#pragma unroll
        for (int ai = 0; ai < 2; ++ai)
#pragma unroll
            for (int m = 0; m < 4; ++m) s[ai][m] = *(const u32x4*)(sp + (size_t)(ai * HALF + m * 16) * NZ);
        __builtin_amdgcn_sched_barrier(0);
#pragma unroll
        for (int ai = 0; ai < 2; ++ai)
#pragma unroll
            for (int m = 0; m < 4; ++m) { const u32x4 a = s[ai][m];
                const f32x4 g0 = (f32x4){bflo(a.x), bfhi(a.x), bflo(a.y), bfhi(a.y)}, g1 = (f32x4){bflo(a.z), bfhi(a.z), bflo(a.w), bfhi(a.w)};
                acc[ai][1][m][0] += g0 * acc[ai][0][m][0]; acc[ai][1][m][1] += g1 * acc[ai][0][m][1];
                acc[ai][0][m][0] = (f32x4){0.f, 0.f, 0.f, 0.f}; acc[ai][0][m][1] = (f32x4){0.f, 0.f, 0.f, 0.f};
                if (sub == nlast) { const f32x4 v0 = acc[ai][1][m][0], v1 = acc[ai][1][m][1];
                    u32x4 w; w.x = cvt_pk_bf16(v0[0], v0[1]); w.y = cvt_pk_bf16(v0[2], v0[3]); w.z = cvt_pk_bf16(v1[0], v1[1]); w.w = cvt_pk_bf16(v1[2], v1[3]);
                    *(u32x4*)(T + (size_t)(row0 + ai * HALF + m * 16) * D + col0) = w;
                    acc[ai][1][m][0] = (f32x4){0.f, 0.f, 0.f, 0.f}; acc[ai][1][m][1] = (f32x4){0.f, 0.f, 0.f, 0.f}; } }
        return true;
    }
};
}

#define LDS_WAIT() asm volatile("s_waitcnt lgkmcnt(0)" ::: "memory")
__device__ __forceinline__ void cvt_item(const float* W, int ldw, int srccol0, bf16_t* dst, int K, int k0, const float* kscale, LAS float* scr, int lane, bool perm) {
    const int sc8 = perm ? (((lane & 7) >> 1) + 4 * (lane & 1)) : (lane & 7);
    f32x4 v[8];
    float ksv[8];
#pragma unroll
    for (int i = 0; i < 8; ++i) ksv[i] = 1.f;
    if (kscale) {
#pragma unroll
        for (int i = 0; i < 8; ++i) ksv[i] = kscale[k0 + 8 * i + (lane >> 3)];
    }
    const int scc = srccol0 >= 0 ? srccol0 : 0; const float zf = srccol0 >= 0 ? 1.f : 0.f;
#pragma unroll
    for (int i = 0; i < 8; ++i) { const int kk = 8 * i + (lane >> 3);
        v[i] = __builtin_nontemporal_load((const f32x4*)(W + (size_t)(k0 + kk) * ldw + scc + sc8 * 4)); }
#pragma unroll
    for (int i = 0; i < 8; ++i) { const int kk = 8 * i + (lane >> 3); f32x4 x = v[i] * (zf * ksv[i]);
        LAS float* d = scr + kk * 33 + (lane & 7) * 4; d[0] = x[0]; d[1] = x[1]; d[2] = x[2]; d[3] = x[3]; }
    LDS_WAIT(); asm volatile("" ::: "memory");
    const int c = lane & 7;
#pragma unroll
    for (int j = 0; j < 4; ++j) { const int n = (lane >> 3) + 8 * j; const LAS float* s = scr + (8 * c) * 33 + n;
        u32x4 o; o.x = pk2(s[0 * 33], s[1 * 33]); o.y = pk2(s[2 * 33], s[3 * 33]); o.z = pk2(s[4 * 33], s[5 * 33]); o.w = pk2(s[6 * 33], s[7 * 33]);
        __builtin_nontemporal_store(o, (u32x4*)(dst + (size_t)n * K + k0 + 8 * c)); }
    LDS_WAIT(); asm volatile("" ::: "memory");
}
__device__ __forceinline__ int zsrc_col(int n) {
    if (n < 1024) return n;
    if (n < 2048) { const int t = (n - 1024) >> 8, j = (n - 1024) & 255; return j < 128 ? 1024 + 128 * t + j : 1536 + 128 * t + (j - 128); }
    if (n < 3520) return n;
    if (n < 3584) return -1;
    if (n < NZ) return n + 64;
    if (n < NZ + 128) return 3520 + (n - NZ);
    return -1;
}
constexpr int CV_GU = 2 * (NGU / 32) * (D / 64), CV_D = 2 * (D / 32) * (DFF / 64), CV_IN = (NZW / 32) * (D / 64), CV_UQ = (768 / 32) * (512 / 64), CV_KV = (1024 / 32) * (256 / 64),
              CV_BR = 4 * (D / 32) * (512 / 64), CV_OUT = (D / 32) * (D / 64), CV_LAYER = CV_GU + CV_D + CV_IN + CV_UQ + CV_KV + CV_BR + CV_OUT;
constexpr int CV_E0 = CV_GU / 2, CV_E1 = CV_E0 + CV_D / 2, CV_E2 = CV_E1 + CV_IN, CV_E3 = CV_E2 + CV_UQ, CV_E4 = CV_E3 + CV_KV, CV_E5 = CV_E4 + CV_BR, CV_E6 = CV_E5 + CV_OUT, CV_E7 = CV_E6 + CV_GU / 2, CV_E8 = CV_E7 + CV_D / 2;
static_assert(CV_E8 == CV_LAYER, "conversion item count");
constexpr int CW_QHEAD = 2048, CW_DONE = 2112;
__device__ __forceinline__ void cvt_item_idx(const Ctx& C, unsigned char* ws, int it, LAS float* scr, int lane) {
    const int l = it / CV_LAYER; int r = it - l * CV_LAYER;
    const float* W; int ldw, sc0, K, k0; bf16_t* dst; const float* ks = nullptr; bool perm = false;
    if (r < CV_E0 || (r >= CV_E6 && r < CV_E7)) { const int f = r >= CV_E6; if (f) r -= CV_E6; const int kb = r / (NGU / 32), nb = r - kb * (NGU / 32); const int n = nb * 32, tile = n >> 8, j = n & 255;
        W = (j < 128 ? C.in(I_WG) : C.in(I_WU)) + (size_t)(l * 2 + f) * D * DFF; ldw = DFF; sc0 = 128 * tile + (j & 127); dst = WLP(bf16_t, l, WL_GU) + ((size_t)f * NGU + n) * D; K = D; k0 = kb * 64; }
    else if (r < CV_E1 || r >= CV_E7) { const int f = r >= CV_E7; r -= f ? CV_E7 : CV_E0; const int kb = r / (D / 32), nb = r - kb * (D / 32);
        W = C.in(I_WD) + (size_t)(l * 2 + f) * DFF * D; ldw = D; sc0 = nb * 32; dst = WLP(bf16_t, l, WL_D) + ((size_t)f * D + nb * 32) * DFF; K = DFF; k0 = kb * 64; }
    else if (r < CV_E2) { r -= CV_E1; const int kb = r / (NZW / 32), nb = r - kb * (NZW / 32);
        W = C.in(I_WIN) + (size_t)l * D * NIN; ldw = NIN; sc0 = zsrc_col(nb * 32); perm = (nb >= ZC_KR / 32 && nb < 3520 / 32); dst = WLP(bf16_t, l, WL_IN) + (size_t)nb * 32 * D; K = D; k0 = kb * 64; }
    else if (r < CV_E3) { r -= CV_E2; const int kb = r / 24, nb = r - kb * 24;
        W = C.in(I_WUQ) + (size_t)l * 512 * 768; ldw = 768; sc0 = nb * 32; perm = (nb % 6) >= 4; dst = WLP(bf16_t, l, WL_UQ) + (size_t)nb * 32 * 512; K = 512; k0 = kb * 64; ks = C.in(I_QNORM) + l * 512; }
    else if (r < CV_E4) { r -= CV_E3; const int kb = r / 32, nb = r - kb * 32;
        W = C.in(I_WUKV) + (size_t)l * 256 * 1024; ldw = 1024; sc0 = (((nb * 32) & 511) >> 7) * 256 + ((nb * 32) >> 9) * 128 + ((nb * 32) & 127); dst = WLP(bf16_t, l, WL_KV) + (size_t)nb * 32 * 256; K = 256; k0 = kb * 64; ks = C.in(I_KVNORM) + l * 256; }
    else if (r < CV_E5) { r -= CV_E4; const int b = r / (CV_BR / 4); r -= b * (CV_BR / 4); const int kb = r / 64, nb = r - kb * 64;
        W = C.in(I_WBR) + (size_t)(l * 4 + b) * 512 * D; ldw = D; sc0 = nb * 32; dst = WLP(bf16_t, l, WL_BR) + ((size_t)b * D + nb * 32) * 512; K = 512; k0 = kb * 64; }
    else { r -= CV_E5; const int kb = r / 64, nb = r - kb * 64;
        W = C.in(I_WOUT) + (size_t)l * D * D; ldw = D; sc0 = nb * 32; dst = WLP(bf16_t, l, WL_OUT) + (size_t)nb * 32 * D; K = D; k0 = kb * 64; }
    cvt_item(W, ldw, sc0, dst, K, k0, ks, scr, lane, perm);
}
__device__ __forceinline__ void cvt_pull(const Ctx& C, LAS unsigned char* lds, int mand_end, int done_word  , int G) {
    const int tid = fresh_tid(), lane = tid & 63, wid = tid >> 6;
    volatile LAS unsigned* sh = (volatile LAS unsigned*)(lds + 8 * 8448);
    if (done_word && tid == 0) (void)__hip_atomic_fetch_add((unsigned*)(C.ws() + WS_CTL) + done_word, 1u, __ATOMIC_RELAXED, __HIP_MEMORY_SCOPE_AGENT);
    for (;;) {
        __syncthreads();
        if (tid == 0) { unsigned* const ctl = (unsigned*)(C.ws() + WS_CTL); const unsigned h = __hip_atomic_load(ctl + CW_QHEAD, __ATOMIC_RELAXED, __HIP_MEMORY_SCOPE_AGENT); bool go = false;
            if (h < (unsigned)(DEPTH * CV_LAYER)) { if (h < (unsigned)mand_end) go = true; else if (done_word && __hip_atomic_load(ctl + done_word, __ATOMIC_RELAXED, __HIP_MEMORY_SCOPE_AGENT) < (unsigned)G) go = true; }
            sh[0] = go ? __hip_atomic_fetch_add(ctl + CW_QHEAD, 16u, __ATOMIC_RELAXED, __HIP_MEMORY_SCOPE_AGENT) : 0xffffffffu; }
        __syncthreads();
        const unsigned base = sh[0];
        if (base == 0xffffffffu) break;
#pragma unroll 1
        for (int i = 0; i < 2; ++i) { const int it = (int)base + wid * 2 + i; if (it < DEPTH * CV_LAYER) cvt_item_idx(C, C.ws(), it, (LAS float*)(lds + wid * 8448), lane); }
    }
}
__device__ __forceinline__ void prologue_phase(const Ctx& C, LAS unsigned char* lds, int G, int bid) {
    unsigned char* const ws = C.ws();
    const int tid = fresh_tid(), lane = tid & 63, wid = tid >> 6;
    if (bid == 0) { float* tab = WSP(float, WS_TAB);
        for (int i = tid; i < 64 * 16; i += 512) { const int pos = i >> 4, f = i & 15; const float ang = (float)pos * exp2f(-(float)f * (13.287712379549449f / 16.f)); float s, c; sincosf(ang, &s, &c); tab[2 * i] = c; tab[2 * i + 1] = s; } }
    {
        LAS float* SC = (LAS float*)lds; LAS float* PART = (LAS float*)(lds + 40960);
        { const float* const cp = C.in(I_C); const float* const cc = C.in(I_CCTX); float xs[20];
#pragma unroll
          for (int j = 0; j < 20; ++j) { const int i = tid + 512 * j; xs[j] = j < 16 ? cp[i] : cc[i - 4 * D]; }
#pragma unroll
          for (int j = 0; j < 20; ++j) { const float x = xs[j]; SC[tid + 512 * j] = x / (1.f + expf(-x)); } }
        __syncthreads();
        const int kg = tid >> 3, ct = tid & 7;
        for (int it = bid; it < DEPTH * (NMOD / 32); it += G) { const int l = it / (NMOD / 32), ng = it - l * (NMOD / 32);
            const float* wp = C.in(I_WMOD) + ((size_t)l * D + kg * 32) * NMOD + ng * 32 + ct * 4;
            f32x4 a[5];
#pragma unroll
            for (int s = 0; s < 5; ++s) a[s] = (f32x4){0.f, 0.f, 0.f, 0.f};
#pragma unroll 1
            for (int k0 = 0; k0 < 32; k0 += 16) { f32x4 w[16];
#pragma unroll
                for (int kk = 0; kk < 16; ++kk) w[kk] = __builtin_nontemporal_load((const f32x4*)(wp + (size_t)(k0 + kk) * NMOD));
                __builtin_amdgcn_sched_barrier(0);
#pragma unroll
                for (int kk = 0; kk < 16; ++kk)
#pragma unroll
                    for (int s = 0; s < 5; ++s) a[s] += w[kk] * SC[s * D + kg * 32 + k0 + kk]; }
#pragma unroll
            for (int s = 0; s < 5; ++s) *(LAS f32x4*)(PART + (kg * 5 + s) * 32 + ct * 4) = a[s];
            __syncthreads();
            if (tid < 160) { const int s = tid >> 5, cc = tid & 31; float v = C.in(I_BMOD)[(size_t)l * NMOD + ng * 32 + cc];
                for (int k2 = 0; k2 < 64; ++k2) v += PART[(k2 * 5 + s) * 32 + cc];
                WSP(float, WS_MOD)[((size_t)l * 5 + s) * NMOD + ng * 32 + cc] = v; }
            __syncthreads();
        }
    }
    { const int gt = bid * 512 + tid, GT = G * 512;
        for (int i = gt; i < DEPTH * 65536; i += GT) { const int l = i >> 16; WLP(bf16_t, l, WL_GMW)[i & 65535] = (bf16_t)f2bf(C.in(I_GMWS)[i]); }
        for (int i = gt; i < DEPTH * NZW; i += GT) { const int l = i / NZW, n = i - l * NZW; int nn = n; if (n >= ZC_KR && n < 3520) { const int pp = n & 31; nn = (n & ~31) + 4 * (pp >> 3) + (pp & 3) + 16 * ((pp >> 2) & 1); }
            const int sc = zsrc_col(nn); WLP(float, l, WL_BZ)[n] = sc >= 0 ? C.in(I_BIN)[(size_t)l * NIN + sc] : 0.f; } }
    __syncthreads();
    cvt_pull(C, lds, CV_E0, 0, G);
}

struct NormArgs { const float* xin_lat; const float* xin_ctx; bf16_t* XB; float* outf; const bf16_t* Y; const float* part; bf16_t* H; bool store; };
#define NCOL(r, j) (col[j])
template <bool XF32> __device__ __forceinline__ void norm_row_load(const NormArgs& A, int r, const int (&col)[8], f32x4 (&x)[8], u32x2 (&xr)[8], u32x2 (&yr)[8]) {
    if (XF32) { const float* xi = r < ML ? A.xin_lat + (size_t)r * D : A.xin_ctx + (size_t)(r - ML) * D;
#pragma unroll
        for (int j = 0; j < 8; ++j) x[j] = __builtin_nontemporal_load((const f32x4*)(xi + NCOL(r, j)));
    } else {
#pragma unroll
        for (int j = 0; j < 8; ++j) xr[j] = __builtin_nontemporal_load((const u32x2*)(A.XB + (size_t)r * D + NCOL(r, j)));
    }
    if (A.Y && !(A.part && r >= ML)) {
#pragma unroll
        for (int j = 0; j < 8; ++j) yr[j] = __builtin_nontemporal_load((const u32x2*)(A.Y + (size_t)r * D + NCOL(r, j)));
    }
}
template <bool XF32> __device__ __forceinline__ void norm_row_compute(const NormArgs& A, const LAS float* V, int r, const int (&col)[8], const f32x4 (&xf)[8], const u32x2 (&xr)[8], u32x2 (&yr)[8]) {
    float rs = 0.f;
    if (A.Y) {
        if (A.part && r >= ML) {
#pragma unroll
            for (int j = 0; j < 8; ++j) { const float* pp = A.part + (size_t)(r - ML) * D + NCOL(r, j); f32x4 pq[8];
#pragma unroll
                for (int q = 0; q < 8; ++q) pq[q] = __builtin_nontemporal_load((const f32x4*)(pp + (size_t)q * MC * D));
                __builtin_amdgcn_sched_barrier(0);
                const f32x4 a = ((pq[0] + pq[1]) + (pq[2] + pq[3])) + ((pq[4] + pq[5]) + (pq[6] + pq[7]));
                yr[j].x = cvt_pk_bf16(a[0], a[1]); yr[j].y = cvt_pk_bf16(a[2], a[3]); }
        }
        float ss = 0.f;
#pragma unroll
        for (int j = 0; j < 8; ++j) { const float y0 = bflo(yr[j].x), y1 = bfhi(yr[j].x), y2 = bflo(yr[j].y), y3 = bfhi(yr[j].y); ss += (y0 * y0 + y1 * y1) + (y2 * y2 + y3 * y3); }
        rs = __builtin_amdgcn_rsqf(wave_sum(ss) * (1.f / D) + EPS);
    }
#define NORM_X(j) ((XF32 ? xf[j] : (f32x4){bflo(xr[j].x), bfhi(xr[j].x), bflo(xr[j].y), bfhi(xr[j].y)}) + (A.Y ? *(const LAS f32x4*)(V + NCOL(r, j)) * ((f32x4){bflo(yr[j].x), bfhi(yr[j].x), bflo(yr[j].y), bfhi(yr[j].y)} * rs) : (f32x4){0.f, 0.f, 0.f, 0.f}))
    float rx = 0.f;
    if (A.H) { float ss = 0.f;
#pragma unroll
        for (int j = 0; j < 8; ++j) { const f32x4 x = NORM_X(j); ss += (x[0] * x[0] + x[1] * x[1]) + (x[2] * x[2] + x[3] * x[3]); if (j & 1) __builtin_amdgcn_sched_barrier(0); }
        rx = __builtin_amdgcn_rsqf(wave_sum(ss) * (1.f / D) + EPS); }
#pragma unroll
    for (int j = 0; j < 8; ++j) { const f32x4 x = NORM_X(j);
        if (A.outf) __builtin_nontemporal_store(x, (f32x4*)(A.outf + (size_t)r * D + NCOL(r, j)));
        else if (A.store) { u32x2 w; w.x = cvt_pk_bf16(x[0], x[1]); w.y = cvt_pk_bf16(x[2], x[3]); __builtin_nontemporal_store(w, (u32x2*)(A.XB + (size_t)r * D + NCOL(r, j))); }
        if (A.H) { const f32x4 h = (x * rx) * *(const LAS f32x4*)(V + D + NCOL(r, j)) + *(const LAS f32x4*)(V + 2 * D + NCOL(r, j)); u32x2 w; w.x = cvt_pk_bf16(h[0], h[1]); w.y = cvt_pk_bf16(h[2], h[3]);
            *(u32x2*)(A.H + (size_t)r * D + NCOL(r, j)) = w; }
        if (j & 1) __builtin_amdgcn_sched_barrier(0); }
#undef NORM_X
}
template <bool XF32> __device__ __forceinline__ void norm_phase(LAS unsigned char* lds, int G, int bid, int rows, const float* xin_lat, const float* xin_ctx, bf16_t* XB, float* outf, bool store,
                                           const bf16_t* Y, const float* part  , const float* modg  , int kgate, float coef, const float* gpost,
                                           bf16_t* H, const float* modh  , int kshift, const float* gpre) {
    constexpr int NR = XF32 ? 2 : NORM_NR;
    const int tid = fresh_tid(), lane = tid & 63, wid = __builtin_amdgcn_readfirstlane(tid >> 6);
    asm volatile("" : "+s"(bid));
    float zf = 0.f; asm volatile("" : "+v"(zf));
    const NormArgs A{xin_lat, xin_ctx, XB, outf, Y, part, H, store};
    LAS float* V = (LAS float*)lds;
    int s_have = -1;
    for (int r0 = bid * 8 * NR; r0 < rows + (rows > ML ? 0 : 0); r0 += G * 8 * NR) {
        if (r0 >= ML) break;
        const int s = r0 >> 12;
        if (s != s_have) { __syncthreads();
            { const int c = 4 * fresh_tid(); f32x4 gg = (f32x4){zf, zf, zf, zf}, a = gg, b = gg;
              if (Y) gg = *(const f32x4*)(modg + (size_t)s * NMOD + kgate * D + c) * *(const f32x4*)(gpost + c) * coef;
              if (H) { a = *(const f32x4*)(gpre + c) * (*(const f32x4*)(modh + (size_t)s * NMOD + (kshift + 1) * D + c) + 1.f); b = *(const f32x4*)(modh + (size_t)s * NMOD + kshift * D + c); }
              *(LAS f32x4*)(V + c) = gg; *(LAS f32x4*)(V + D + c) = a; *(LAS f32x4*)(V + 2 * D + c) = b; }
            __syncthreads(); s_have = s; }
        int ln = lane; asm volatile("" : "+v"(ln)); int col[8];
_Pragma("unroll")
        for (int j = 0; j < 8; ++j) col[j] = 4 * ln + 256 * ((j + wid) & 7);
        f32x4 xf[XF32 ? NR : 1][8]; u32x2 xr[XF32 ? 1 : NR][8], yr[NR][8];
#pragma unroll
        for (int k = 0; k < NR; ++k)
#pragma unroll
            for (int j = 0; j < 8; ++j) { yr[k][j] = (u32x2){0u, 0u}; if (XF32) xf[k][j] = (f32x4){0.f, 0.f, 0.f, 0.f}; else xr[k][j] = (u32x2){0u, 0u}; }
#pragma unroll
        for (int k = 0; k < NR; ++k) norm_row_load<XF32>(A, r0 + wid + 8 * k, col, xf[XF32 ? k : 0], xr[XF32 ? 0 : k], yr[k]);
        __builtin_amdgcn_sched_barrier(0);
#pragma unroll
        for (int k = 0; k < NR; ++k) { norm_row_compute<XF32>(A, V, r0 + wid + 8 * k, col, xf[XF32 ? k : 0], xr[XF32 ? 0 : k], yr[k]); __builtin_amdgcn_sched_barrier(0); }
    }
    if (rows > ML) {
        for (int r0 = ML + bid * 8; r0 < rows; r0 += G * 8) {
            if (s_have != 4) { __syncthreads();
                { const int c = 4 * fresh_tid(); f32x4 gg = (f32x4){zf, zf, zf, zf}, a = gg, b = gg;
                  if (Y) gg = *(const f32x4*)(modg + (size_t)4 * NMOD + kgate * D + c) * *(const f32x4*)(gpost + c) * coef;
                  if (H) { a = *(const f32x4*)(gpre + c) * (*(const f32x4*)(modh + (size_t)4 * NMOD + (kshift + 1) * D + c) + 1.f); b = *(const f32x4*)(modh + (size_t)4 * NMOD + kshift * D + c); }
                  *(LAS f32x4*)(V + c) = gg; *(LAS f32x4*)(V + D + c) = a; *(LAS f32x4*)(V + 2 * D + c) = b; }
                __syncthreads(); s_have = 4; }
            int ln = lane; asm volatile("" : "+v"(ln)); int col[8];
_Pragma("unroll")
        for (int j = 0; j < 8; ++j) col[j] = 4 * ln + 256 * ((j + wid) & 7);
            f32x4 x[8]; u32x2 xr[8], yr[8];
#pragma unroll
            for (int j = 0; j < 8; ++j) { yr[j] = (u32x2){0u, 0u}; xr[j] = (u32x2){0u, 0u}; x[j] = (f32x4){0.f, 0.f, 0.f, 0.f}; }
            norm_row_load<XF32>(A, r0 + wid, col, x, xr, yr);
            norm_row_compute<XF32>(A, V, r0 + wid, col, x, xr, yr);
        }
    }
    __syncthreads();
}
#undef NCOL

__device__ __forceinline__ f32x4 mfma16(bf16x8 a, bf16x8 b, f32x4 c) { return __builtin_amdgcn_mfma_f32_16x16x32_bf16(a, b, c, 0, 0, 0); }
__device__ __forceinline__ void gmlp_chunk(const Ctx& C, int l, LAS unsigned char* lds, int R0, int g_lo) {
    unsigned char* const ws = C.ws();
    const bf16_t* Z = WSP(const bf16_t, WS_Z); bf16_t* YA = WSP(bf16_t, WS_YBR);
    const float* lng = C.in(I_GMLNG) + l * 512; const float* lnb = C.in(I_GMLNB) + l * 512; const float* bs = C.in(I_GMBS) + l * 512; const bf16_t* WS = WLP(const bf16_t, l, WL_GMW);
    LAS float* stats = (LAS float*)lds; LAS bf16_t* vnT = (LAS bf16_t*)(lds + 1024);
    const int tid = fresh_tid(), lane = tid & 63, wid = tid >> 6, i16 = lane & 15, g4 = lane >> 4;
    for (int rr = 0; rr < 16; ++rr) { const int q = 16 * wid + rr; const u32x4 w = *(const u32x4*)(Z + (size_t)(R0 + q) * NZ + 512 + 8 * lane);
        const float v[8] = {bflo(w.x), bfhi(w.x), bflo(w.y), bfhi(w.y), bflo(w.z), bfhi(w.z), bflo(w.w), bfhi(w.w)};
        float s = 0.f;
#pragma unroll
        for (int e = 0; e < 8; ++e) s += v[e];
        const float mean = wave_sum(s) * (1.f / 512.f); float q2 = 0.f;
#pragma unroll
        for (int e = 0; e < 8; ++e) { const float d = v[e] - mean; q2 += d * d; }
        const float rstd = __builtin_amdgcn_rsqf(wave_sum(q2) * (1.f / 512.f) + EPS);
        if (lane == 0) { stats[2 * q] = mean; stats[2 * q + 1] = rstd; } }
    __syncthreads();
    for (int g = g_lo; g < g_lo + 2; ++g) {
        u32x4 wj[4];
#pragma unroll
        for (int j = 0; j < 4; ++j) { const int id = tid + 512 * j, q = id >> 4, cc = id & 15; wj[j] = *(const u32x4*)(Z + (size_t)(R0 + q) * NZ + 512 + g * 128 + 8 * cc); }
        __builtin_amdgcn_sched_barrier(0);
#pragma unroll
        for (int j = 0; j < 4; ++j) { const int id = tid + 512 * j, q = id >> 4, cc = id & 15; const u32x4 w = wj[j];
            const float v[8] = {bflo(w.x), bfhi(w.x), bflo(w.y), bfhi(w.y), bflo(w.z), bfhi(w.z), bflo(w.w), bfhi(w.w)};
            const float mean = stats[2 * q], rstd = stats[2 * q + 1];
            const f32x4 g0 = *(const f32x4*)(lng + g * 128 + 8 * cc), g1 = *(const f32x4*)(lng + g * 128 + 8 * cc + 4), b0 = *(const f32x4*)(lnb + g * 128 + 8 * cc), b1 = *(const f32x4*)(lnb + g * 128 + 8 * cc + 4);
            const float gg[8] = {g0[0], g0[1], g0[2], g0[3], g1[0], g1[1], g1[2], g1[3]}, bb[8] = {b0[0], b0[1], b0[2], b0[3], b1[0], b1[1], b1[2], b1[3]};
#pragma unroll
            for (int e = 0; e < 8; ++e) vnT[(8 * cc + e) * 136 + q] = (bf16_t)f2bf((v[e] - mean) * rstd * gg[e] + bb[e]); }
        __syncthreads();
        bf16x8 bw[4];
#pragma unroll
        for (int ks = 0; ks < 4; ++ks) bw[ks] = *(const bf16x8*)(WS + (size_t)(g * 128 + 16 * wid + i16) * 128 + 32 * ks + 8 * g4);
        f32x4 acc[8];
#pragma unroll
        for (int ct = 0; ct < 8; ++ct) { acc[ct] = (f32x4){0.f, 0.f, 0.f, 0.f};
#pragma unroll
            for (int ks = 0; ks < 4; ++ks) { const bf16x8 a = *(const LAS bf16x8*)(vnT + (16 * ct + i16) * 136 + 32 * ks + 8 * g4); acc[ct] = mfma16(a, bw[ks], acc[ct]); } }
        const int prow = R0 + 16 * wid + i16; const float bsv = bs[g * 128 + 16 * wid + i16];
        u32x2 uwv[8];
#pragma unroll
        for (int ct = 0; ct < 8; ++ct) uwv[ct] = *(const u32x2*)(Z + (size_t)prow * NZ + g * 128 + 16 * ct + 4 * g4);
        __builtin_amdgcn_sched_barrier(0);
#pragma unroll
        for (int ct = 0; ct < 8; ++ct) { const int c4 = g * 128 + 16 * ct + 4 * g4; const u32x2 uw = uwv[ct];
            u32x2 o; o.x = cvt_pk_bf16(bflo(uw.x) * (acc[ct][0] + bsv), bfhi(uw.x) * (acc[ct][1] + bsv)); o.y = cvt_pk_bf16(bflo(uw.y) * (acc[ct][2] + bsv), bfhi(uw.y) * (acc[ct][3] + bsv));
            *(u32x2*)(YA + (size_t)prow * 512 + c4) = o; }
        __syncthreads();
    }
}
__device__ __forceinline__ void conv_block(const Ctx& C, int l, LAS unsigned char* lds, int SR0, int SL, int p0) {
    unsigned char* const ws = C.ws();
    const bf16_t* HB = WSP(const bf16_t, WS_HB); bf16_t* YB = WSP(bf16_t, WS_YBR) + (size_t)MT * 512;
    const float* lng = C.in(I_CVLNG) + l * 512; const float* lnb = C.in(I_CVLNB) + l * 512;
    LAS float* tile = (LAS float*)lds;
    const int tid = fresh_tid(), lane = tid & 63, wid = tid >> 6;
    float dw[31]; const float db = C.in(I_CVDB)[l * 512 + tid]; const float* const dwp = C.in(I_CVDW) + (size_t)l * 31 * 512 + tid;
#pragma unroll
    for (int j = 0; j < 31; ++j) dw[j] = dwp[j * 512];
    __builtin_amdgcn_sched_barrier(0);
    float hv[62]; unsigned raw[62];
#pragma unroll
    for (int j = 0; j < 62; ++j) { const int p = p0 - 15 + j; const int pc = p < 0 ? 0 : (p >= SL ? SL - 1 : p);
        raw[j] = HB[(size_t)(SR0 + pc) * 512 + tid]; }
    __builtin_amdgcn_sched_barrier(0);
#pragma unroll
    for (int j = 0; j < 62; ++j) { const int p = p0 - 15 + j; hv[j] = (p >= 0 && p < SL) ? __builtin_bit_cast(float, raw[j] << 16) : 0.f; }
#pragma unroll
    for (int o = 0; o < 32; ++o) { float s = db;
#pragma unroll
        for (int j = 0; j < 31; ++j) s += dw[j] * hv[o + j];
        tile[o * 512 + tid] = s; }
    __syncthreads();
    const f32x4 lga = *(const f32x4*)(lng + 4 * lane), lgb = *(const f32x4*)(lng + 256 + 4 * lane), lba = *(const f32x4*)(lnb + 4 * lane), lbb = *(const f32x4*)(lnb + 256 + 4 * lane);
#pragma unroll
    for (int rr = 0; rr < 4; ++rr) { const int o = 4 * wid + rr; f32x4 a = *(const LAS f32x4*)(tile + o * 512 + 4 * lane), b = *(const LAS f32x4*)(tile + o * 512 + 256 + 4 * lane);
        const float mean = wave_sum((a[0] + a[1]) + (a[2] + a[3]) + (b[0] + b[1]) + (b[2] + b[3])) * (1.f / 512.f);
        a = a - mean; b = b - mean;
        const float rstd = __builtin_amdgcn_rsqf(wave_sum((a[0] * a[0] + a[1] * a[1]) + (a[2] * a[2] + a[3] * a[3]) + (b[0] * b[0] + b[1] * b[1]) + (b[2] * b[2] + b[3] * b[3])) * (1.f / 512.f) + EPS);
        const f32x4 ya = a * rstd * lga + lba, yb = b * rstd * lgb + lbb;
        u32x2 wa, wb; wa.x = cvt_pk_bf16(ya[0] * sigmoidf_(ya[0]), ya[1] * sigmoidf_(ya[1])); wa.y = cvt_pk_bf16(ya[2] * sigmoidf_(ya[2]), ya[3] * sigmoidf_(ya[3]));
        wb.x = cvt_pk_bf16(yb[0] * sigmoidf_(yb[0]), yb[1] * sigmoidf_(yb[1])); wb.y = cvt_pk_bf16(yb[2] * sigmoidf_(yb[2]), yb[3] * sigmoidf_(yb[3]));
        bf16_t* op = YB + (size_t)(SR0 + p0 + o) * 512; *(u32x2*)(op + 4 * lane) = wa; *(u32x2*)(op + 256 + 4 * lane) = wb; }
    __syncthreads();
}

struct AttnSrc { const bf16_t* k1; int k1ld; const bf16_t* k2; int k2ld; const bf16_t* vt; };
template <int DK1, int DK2, int DV> struct AttnGeo {
    static constexpr int DK = DK1 + DK2, KS = DK / 32, DT = DV / 16, KROW = DK + 8, VROW = 72, KC = DK / 8, NKC = 64 * KC / 512, NVC = DV * 8 / 512, KBYTES = 64 * KROW * 2, VBYTES = DV * VROW * 2, VBASE = 2 * KBYTES  ;
    static_assert((64 * KC) % 512 == 0 && (DV * 8) % 512 == 0, "staging geometry");
};
template <int DK1, int DK2, int DV>
__device__ __forceinline__ void attn_load(const AttnSrc& S, int row0, int tid, u32x4 (&kr)[AttnGeo<DK1, DK2, DV>::NKC], u32x4 (&vr)[AttnGeo<DK1, DK2, DV>::NVC]) {
    typedef AttnGeo<DK1, DK2, DV> Gm;
#pragma unroll
    for (int i = 0; i < Gm::NKC; ++i) { const int c = tid + 512 * i, key = c / Gm::KC, part = c - key * Gm::KC;
        const bf16_t* src = (part < DK1 / 8) ? S.k1 + (size_t)(row0 + key) * S.k1ld + part * 8 : S.k2 + (size_t)(row0 + key) * S.k2ld + (part - DK1 / 8) * 8; kr[i] = *(const u32x4*)src; }
#pragma unroll
    for (int i = 0; i < Gm::NVC; ++i) { const int c = tid + 512 * i, d = c >> 3, c8 = c & 7; vr[i] = *(const u32x4*)(S.vt + (size_t)d * MT + row0 + 8 * c8); }
}
template <int DK1, int DK2, int DV>
__device__ __forceinline__ void attn_store(LAS unsigned char* kbuf, LAS unsigned char* vbuf, int tid, const u32x4 (&kr)[AttnGeo<DK1, DK2, DV>::NKC], const u32x4 (&vr)[AttnGeo<DK1, DK2, DV>::NVC]) {
    typedef AttnGeo<DK1, DK2, DV> Gm; LAS bf16_t* Ks = (LAS bf16_t*)kbuf; LAS bf16_t* Vt = (LAS bf16_t*)vbuf;
#pragma unroll
    for (int i = 0; i < Gm::NKC; ++i) { const int c = tid + 512 * i, key = c / Gm::KC, part = c - key * Gm::KC;
        const int rho = (key & 32) + 16 * ((key >> 2) & 1) + 4 * ((key >> 3) & 3) + (key & 3);
        *(LAS u32x4*)(Ks + rho * Gm::KROW + part * 8) = kr[i]; }
#pragma unroll
    for (int i = 0; i < Gm::NVC; ++i) { const int c = tid + 512 * i, d = c >> 3, c8 = c & 7; *(LAS u32x4*)(Vt + d * Gm::VROW + 8 * c8) = vr[i]; }
}
template <int DT, bool MASK>
__device__ __forceinline__ void attn_softmax(f32x4 (&st)[2], float& nbase, float& rel, float& l, f32x4 (&ot)[DT], bf16x8& pf, int kp0  , bool masked) {
    if (MASK && masked) {
#pragma unroll
        for (int t2 = 0; t2 < 2; ++t2)
#pragma unroll
            for (int r = 0; r < 4; ++r) if ((unsigned)(kp0 + 4 * t2 + r) > 256u) st[t2][r] = -1e30f;
    }
    const float lm = __builtin_fmaxf(__builtin_fmaxf(__builtin_fmaxf(__builtin_fmaxf(st[0][0], st[0][1]), st[0][2]), __builtin_fmaxf(__builtin_fmaxf(st[0][3], st[1][0]), st[1][1])), __builtin_fmaxf(st[1][2], st[1][3]));
    if (__any(lm > rel + 8.f)) { float mx = lm;
        { auto r16 = __builtin_amdgcn_permlane16_swap(__builtin_bit_cast(unsigned, mx), __builtin_bit_cast(unsigned, mx), false, false);
          mx = vmax(__builtin_bit_cast(float, r16[0]), __builtin_bit_cast(float, r16[1]));
          auto r32 = __builtin_amdgcn_permlane32_swap(__builtin_bit_cast(unsigned, mx), __builtin_bit_cast(unsigned, mx), false, false);
          mx = vmax(__builtin_bit_cast(float, r32[0]), __builtin_bit_cast(float, r32[1])); }
        const float mt = vmax(rel, mx);
        const float alpha = fast_exp2(rel - mt); l *= alpha; nbase -= mt; rel = 0.f;
        st[0] = st[0] - mt; st[1] = st[1] - mt;
#pragma unroll
        for (int dt = 0; dt < DT; ++dt) ot[dt] = ot[dt] * alpha; }
    { st[0] = (f32x4){fast_exp2(st[0][0]), fast_exp2(st[0][1]), fast_exp2(st[0][2]), fast_exp2(st[0][3])}; st[1] = (f32x4){fast_exp2(st[1][0]), fast_exp2(st[1][1]), fast_exp2(st[1][2]), fast_exp2(st[1][3])};
      const f32x4 es = st[0] + st[1]; const f32x2 e2 = (f32x2){es[0], es[1]} + (f32x2){es[2], es[3]};
      l += e2[0] + e2[1]; }
    union { u32x4 u; bf16x8 b; } q; q.u.x = cvt_pk_bf16(st[0][0], st[0][1]); q.u.y = cvt_pk_bf16(st[0][2], st[0][3]); q.u.z = cvt_pk_bf16(st[1][0], st[1][1]); q.u.w = cvt_pk_bf16(st[1][2], st[1][3]);
    pf = q.b;
}
template <int DK1, int DK2, int DV, bool MASK>
__device__ __forceinline__ void attn_unit(LAS unsigned char* lds, const AttnSrc& S, const bf16_t* q0p, const bf16_t* q1p, bf16_t* o0p, bf16_t* o1p,
                                          int ctx_row0, int nctx, int loc_row0, int loc_pos0, int nloc, int qpos0, int qpos1, float m0, float l0, int role) {
    typedef AttnGeo<DK1, DK2, DV> Gm; constexpr int KS = Gm::KS, DT = Gm::DT, KROW = Gm::KROW, VROW = Gm::VROW;
    const int tid = fresh_tid(), lane = tid & 63, i16 = lane & 15, g4 = lane >> 4;
    bf16x8 qf0[KS], qf1[KS];
#pragma unroll
    for (int ks = 0; ks < KS; ++ks) { qf0[ks] = *(const bf16x8*)(q0p + 32 * ks + 8 * g4); qf1[ks] = *(const bf16x8*)(q1p + 32 * ks + 8 * g4); }
    f32x4 ot0[DT], ot1[DT];
#pragma unroll
    for (int dt = 0; dt < DT; ++dt) { ot0[dt] = (f32x4){0.f, 0.f, 0.f, 0.f}; ot1[dt] = (f32x4){0.f, 0.f, 0.f, 0.f}; }
    const float base0 = m0 < -1e29f ? 0.f : m0;
    float nba = -base0, nbb = -base0, ra = m0 - base0, rb = ra, la = (g4 == 0) ? l0 : 0.f, lb = la;
    const int NT = nctx + nloc;
    u32x4 kr[Gm::NKC], vr[Gm::NVC];
#define TROW(t) ((t) < nctx ? ctx_row0 + 64 * (t) : loc_row0 + 64 * ((t) - nctx))
    attn_load<DK1, DK2, DV>(S, TROW(0), tid, kr, vr);
    __syncthreads();
    attn_store<DK1, DK2, DV>(lds, lds + Gm::VBASE, tid, kr, vr);
    __syncthreads();
    if (NT > 1) attn_load<DK1, DK2, DV>(S, TROW(1), tid, kr, vr);
    int vs = 0;
    for (int tt = 0; tt < NT; ++tt) {
        const LAS bf16_t* Ks = (const LAS bf16_t*)(lds + (tt & 1) * Gm::KBYTES); const LAS bf16_t* Vt = (const LAS bf16_t*)(lds + Gm::VBASE + vs * Gm::VBYTES);
        const bool masked = MASK && tt >= nctx; const int kpb = loc_pos0 + 64 * (tt - nctx) + 8 * g4 + 128;
        unsigned klo = (unsigned)(size_t)Ks + (unsigned)(i16 * KROW + 8 * g4) * 2u, vlo = (unsigned)(size_t)Vt + (unsigned)(i16 * VROW + 8 * g4) * 2u;
        asm volatile("" : "+v"(klo), "+v"(vlo));
        const LAS bf16_t* const Kl = (const LAS bf16_t*)klo; const LAS bf16_t* const Vl = (const LAS bf16_t*)vlo;
        f32x4 sa[2], sb[2];
#define AT_X(hh) do { _Pragma("unroll") for (int t2 = 0; t2 < 2; ++t2) { sa[t2] = (f32x4){nba, nba, nba, nba}; sb[t2] = (f32x4){nbb, nbb, nbb, nbb}; bf16x8 kf[KS]; \
            _Pragma("unroll") for (int ks = 0; ks < KS; ++ks) kf[ks] = *(const LAS bf16x8*)(Kl + (32 * (hh) + 16 * t2) * KROW + 32 * ks); \
            __builtin_amdgcn_sched_barrier(0); \
            _Pragma("unroll") for (int ks = 0; ks < KS; ++ks) { sa[t2] = mfma16(kf[ks], qf0[ks], sa[t2]); sb[t2] = mfma16(kf[ks], qf1[ks], sb[t2]); } \
            __builtin_amdgcn_sched_barrier(0); } } while (0)
#define AT_Y(hh) do { bf16x8 pa, pb, vf[4], vg[4]; \
            _Pragma("unroll") for (int dd = 0; dd < 4; ++dd) vf[dd] = *(const LAS bf16x8*)(Vl + (16 * dd) * VROW + 32 * (hh));     \
            __builtin_amdgcn_sched_barrier(0); \
            attn_softmax<DT, MASK>(sa, nba, ra, la, ot0, pa, kpb + 32 * (hh) - qpos0, masked); \
            attn_softmax<DT, MASK>(sb, nbb, rb, lb, ot1, pb, kpb + 32 * (hh) - qpos1, masked); \
            __builtin_amdgcn_sched_barrier(0); \
            if constexpr (DT > 4) { _Pragma("unroll") for (int dd = 0; dd < 4; ++dd) vg[dd] = *(const LAS bf16x8*)(Vl + (16 * (4 + dd)) * VROW + 32 * (hh)); \
                __builtin_amdgcn_sched_barrier(0); } \
            _Pragma("unroll") for (int dd = 0; dd < 4; ++dd) { ot0[dd] = mfma16(vf[dd], pa, ot0[dd]); ot1[dd] = mfma16(vf[dd], pb, ot1[dd]); } \
            __builtin_amdgcn_sched_barrier(0); \
            if constexpr (DT > 4) { _Pragma("unroll") for (int dd = 0; dd < 4; ++dd) { ot0[4 + dd] = mfma16(vg[dd], pa, ot0[4 + dd]); ot1[4 + dd] = mfma16(vg[dd], pb, ot1[4 + dd]); } \
                __builtin_amdgcn_sched_barrier(0); } } while (0)
        AT_X(0); AT_Y(0); AT_X(1);
        if (role == 0) AT_Y(1);
        const int vn = vs == 2 ? 0 : vs + 1;
        if (tt + 1 < NT) attn_store<DK1, DK2, DV>(lds + ((tt + 1) & 1) * Gm::KBYTES, lds + Gm::VBASE + vn * Gm::VBYTES, tid, kr, vr);
        __syncthreads();
        if (tt + 2 < NT) attn_load<DK1, DK2, DV>(S, TROW(tt + 2), tid, kr, vr);
        if (role != 0) AT_Y(1);
        vs = vn;
#undef AT_X
#undef AT_Y
    }
#undef TROW
    float lt = la + __shfl_xor(la, 16); lt += __shfl_xor(lt, 32); const float ia = 1.f / lt;
    lt = lb + __shfl_xor(lb, 16); lt += __shfl_xor(lt, 32); const float ib = 1.f / lt;
#pragma unroll
    for (int dt = 0; dt < DT; ++dt) { u32x2 w; w.x = cvt_pk_bf16(ot0[dt][0] * ia, ot0[dt][1] * ia); w.y = cvt_pk_bf16(ot0[dt][2] * ia, ot0[dt][3] * ia); *(u32x2*)(o0p + 16 * dt + 4 * g4) = w;
        w.x = cvt_pk_bf16(ot1[dt][0] * ib, ot1[dt][1] * ib); w.y = cvt_pk_bf16(ot1[dt][2] * ib, ot1[dt][3] * ib); *(u32x2*)(o1p + 16 * dt + 4 * g4) = w; }
}

constexpr int NPHASE = 2 + 12 * DEPTH;
__global__ void __launch_bounds__(512, 2) mk_fwd(Params P) {
    extern __shared__ __attribute__((aligned(16))) unsigned char lds_raw[];
    LAS unsigned char* lds = (LAS unsigned char*)lds_raw;
    const int tid = fresh_tid();
    volatile LAS unsigned* MISC = (volatile LAS unsigned*)(lds + MISC_OFF);
    for (int u = tid; u < (LDS_BYTES - RING_BYTES) / 4; u += 512) ((LAS unsigned*)(lds + RING_BYTES))[u] = 0u;
    __syncthreads();
    Ctx C; C.tab = (volatile LAS unsigned*)(lds + PTAB_OFF);
    if (tid == 0) {
#pragma unroll
        for (int i = 0; i < 28; ++i) { const unsigned long long v = (unsigned long long)P.in[i]; C.tab[2 * i] = (unsigned)v; C.tab[2 * i + 1] = (unsigned)(v >> 32); }
        { const unsigned long long v = (unsigned long long)P.out; C.tab[56] = (unsigned)v; C.tab[57] = (unsigned)(v >> 32); }
        { const unsigned long long v = (unsigned long long)P.ws; C.tab[58] = (unsigned)v; C.tab[59] = (unsigned)(v >> 32); }
        C.tab[60] = (unsigned)P.ph_lo; C.tab[61] = (unsigned)P.ph_hi;
    }
    __syncthreads();
    if (!MK_MULTI) (void)xcd_barrier_post((unsigned*)(C.ws() + WS_CTL) + CW_BAR, MISC + 8);
    auto tabw = [&](unsigned off) -> int { asm volatile("" : "+s"(off)); return (int)__builtin_amdgcn_readfirstlane(*(volatile LAS unsigned*)(lds + off)); };
#define LO tabw(PTAB_OFF + 240)
#define HI tabw(PTAB_OFF + 244)
#define IN(k) (LO <= (k) && (k) < HI)
#define MKBAR XcdBarrier bar; bar.bar = (unsigned*)(C.ws() + WS_CTL) + CW_BAR; bar.x = xb_xcc_id(); bar.st = (volatile LAS unsigned*)(lds + MISC_OFF) + 8
#define SEAM(k) do { if (!MK_MULTI && IN(k) && IN((k) + 1)) { MKBAR; xcd_barrier(bar); } } while (0)
#define GRID const int G = gridDim.x, bid = blockIdx.x

    if (IN(0) && EN(12)) for (int _rep = 0; _rep < (((PROBE_MASK >> 12) & 1) ? 2 : 1); ++_rep) { if (_rep) { MKBAR; xcd_barrier(bar); } GRID; prologue_phase(C, lds, G, bid); }
    SEAM(0);

    for (int l = 0; l < DEPTH; ++l) {
        const int pb = 1 + 12 * l; const bool last = (l == DEPTH - 1);
        if (IN(pb + 0) && EN(0)) for (int _rep = 0; _rep < (((PROBE_MASK >> 0) & 1) ? 2 : 1); ++_rep) { if (_rep) { MKBAR; xcd_barrier(bar); } GRID; unsigned char* const ws = C.ws(); float* const out = C.out(); float* const XC = WSP(float, WS_XC);
            const float* modl = WSP(const float, WS_MOD) + (size_t)l * 5 * NMOD; const float* npre = C.in(I_NPRE) + (size_t)l * 3 * D; const float* npost = C.in(I_NPOST) + (size_t)l * 3 * D;
            if (l == 0) norm_phase<true>(lds, G, bid, MT, C.in(I_X), C.in(I_CTX), WSP(bf16_t, WS_XB), nullptr, false  , nullptr, nullptr, modl, 0, 0.f, nullptr, WSP(bf16_t, WS_H), modl, 0, npre);
            else norm_phase<false>(lds, G, bid, MT, nullptr, nullptr, WSP(bf16_t, WS_XB), nullptr, true, WSP(const bf16_t, WS_Y), (G >= 256 ? (const float*)C.out() : nullptr), modl - (size_t)5 * NMOD, 8, 0.5f, npost - D, WSP(bf16_t, WS_H), modl, 0, npre);
        }
        SEAM(pb + 0);
        if (IN(pb + 1) && EN(1)) for (int _rep = 0; _rep < (((PROBE_MASK >> 1) & 1) ? 2 : 1); ++_rep) { if (_rep) { MKBAR; xcd_barrier(bar); } GRID; unsigned char* const ws = C.ws();
            pg8::RectOrder S; S.init(MT / 256, NGU / 256, G, bid, 0, WSP(bf16_t, WS_H), 256 * D * 2, WLP(bf16_t, l, WL_GU), 256 * D * 2);
            pg8::EpiSwiglu E{WSP(bf16_t, WS_Z)}; pg8::gemm_phase<pg8::EpiSwiglu, pg8::RectOrder, true>(lds, D, D, D, S, E); }
        if (IN(pb + 1) && EN(1)) { GRID; cvt_pull(C, lds, l * CV_LAYER + CV_E2, CW_DONE + 64 * (pb + 1), G); }
        SEAM(pb + 1);
        if (IN(pb + 2) && EN(2)) for (int _rep = 0; _rep < (((PROBE_MASK >> 2) & 1) ? 2 : 1); ++_rep) { if (_rep) { MKBAR; xcd_barrier(bar); } GRID; unsigned char* const ws = C.ws();
            const bool split = (G >= 256);
            { pg8::RectOrder S; S.init((split ? ML : MT) / 256, D / 256, G, bid, 0, WSP(bf16_t, WS_Z), 256 * DFF * 2, WLP(bf16_t, l, WL_D), 256 * DFF * 2);
              pg8::EpiPlain<false> E{WSP(bf16_t, WS_Y), D, nullptr}; pg8::gemm_phase<pg8::EpiPlain<false>, pg8::RectOrder, true>(lds, DFF, DFF, DFF, S, E); }
            if (split) { const int tile = bid >> 3, part = bid & 7, ks = part < 5 ? 10 * part : 50 + 12 * (part - 5), kn = part < 5 ? 10 : 12;
              pg8::SplitOrder S; S.pm = ML / 256 + (tile >> 3); S.pn = tile & 7; S.part = part; S.have = bid < 256;
              S.A = (const char*)(WSP(bf16_t, WS_Z) + (size_t)S.pm * 256 * DFF + ks * 64); S.B = (const char*)(WLP(bf16_t, l, WL_D) + (size_t)S.pn * 256 * DFF + ks * 64);
              pg8::EpiPartial E{C.out(), ML, (size_t)MC * D}; pg8::gemm_phase<pg8::EpiPartial, pg8::SplitOrder, true>(lds, kn * 64, DFF, DFF, S, E); } }
        SEAM(pb + 2);
        if (IN(pb + 3) && EN(3)) for (int _rep = 0; _rep < (((PROBE_MASK >> 3) & 1) ? 2 : 1); ++_rep) { if (_rep) { MKBAR; xcd_barrier(bar); } GRID; unsigned char* const ws = C.ws(); float* const out = C.out(); float* const XC = WSP(float, WS_XC);
            const float* const modl = WSP(const float, WS_MOD) + (size_t)l * 5 * NMOD;
            if (l == 0) norm_phase<true>(lds, G, bid, MT, C.in(I_X), C.in(I_CTX), WSP(bf16_t, WS_XB), nullptr, true, WSP(const bf16_t, WS_Y), (G >= 256 ? (const float*)C.out() : nullptr), modl, 2, 0.5f, C.in(I_NPOST) + (size_t)l * 3 * D, WSP(bf16_t, WS_H), modl, 3, C.in(I_NPRE) + ((size_t)l * 3 + 1) * D);
            else norm_phase<false>(lds, G, bid, MT, nullptr, nullptr, WSP(bf16_t, WS_XB), nullptr, true, WSP(const bf16_t, WS_Y), (G >= 256 ? (const float*)C.out() : nullptr), modl, 2, 0.5f, C.in(I_NPOST) + (size_t)l * 3 * D, WSP(bf16_t, WS_H), modl, 3, C.in(I_NPRE) + ((size_t)l * 3 + 1) * D); }
        SEAM(pb + 3);
        if (IN(pb + 4) && EN(4)) for (int _rep = 0; _rep < (((PROBE_MASK >> 4) & 1) ? 2 : 1); ++_rep) { if (_rep) { MKBAR; xcd_barrier(bar); } GRID; unsigned char* const ws = C.ws();
            bf16_t* const Z = WSP(bf16_t, WS_Z); bf16_t* const H = WSP(bf16_t, WS_H);
            LAS float* const LTAB = (LAS float*)(lds + LTAB_OFF);
            { const int t_ = fresh_tid(); for (int i = t_; i < 2048; i += 512) LTAB[i] = WSP(const float, WS_TAB)[i]; __syncthreads(); }
            pg8::EpiZ E{Z, WSP(bf16_t, WS_HB), WSP(float, WS_SSP), WLP(const float, l, WL_BZ), LTAB, 0, 0};
            { pg8::RectOrder S; S.init(ML / 256, NZ / 256, G, bid, 0, H, 256 * D * 2, WLP(bf16_t, l, WL_IN), 256 * D * 2);
              pg8::gemm_phase<pg8::EpiZ, pg8::RectOrder, true>(lds, D, D, D, S, E); }
            int used = (ML / 256) * (NZ / 256);
            {
                const int ct0 = last ? 10 : 0, nct = last ? 4 : 14;
                pg8::EpiZ E2{Z, WSP(bf16_t, WS_HB), WSP(float, WS_SSP), WLP(const float, l, WL_BZ), LTAB, ct0, ML};
                pg8::RectOrder S; S.init(MC / 256, nct, G, bid, used, H + (size_t)ML * D, 256 * D * 2, WLP(bf16_t, l, WL_IN) + (size_t)ct0 * 256 * D, 256 * D * 2);
                pg8::gemm_phase<pg8::EpiZ, pg8::RectOrder, true>(lds, D, D, D, S, E2); used += (MC / 256) * nct; }
            {
                pg8::EpiVt<false> E3{WSP(bf16_t, WS_VTD), MT, WLP(const float, l, WL_BZ) + NZ, nullptr};
                pg8::RectOrder S; S.init(1, MT / 256, G, bid, used, WLP(bf16_t, l, WL_IN) + (size_t)NZ * D, 0, H, 256 * D * 2);
                pg8::gemm_phase<pg8::EpiVt<false>, pg8::RectOrder, true>(lds, D, D, D, S, E3); }
        }
        if (IN(pb + 4) && EN(4)) { GRID; cvt_pull(C, lds, l * CV_LAYER + CV_E7, CW_DONE + 64 * (pb + 4), G); }
        SEAM(pb + 4);
        if (IN(pb + 5) && EN(5)) for (int _rep = 0; _rep < (((PROBE_MASK >> 5) & 1) ? 2 : 1); ++_rep) { if (_rep) { MKBAR; xcd_barrier(bar); } GRID;
            const int lm_ = _rep ? PROBE_LOCMASK : LOCMASK;
            const int nch = 2 * ((last ? ML : MT) / 128), ncb = (last ? ML : MT) / 32;
            for (int it = bid; it < nch + ncb; it += G) {
                if (it < nch) { if (lm_ & 1) gmlp_chunk(C, l, lds, (it >> 1) * 128, 2 * (it & 1)); }
                else { const int cb = it - nch; int SR0, SL, p0; if (cb < ML / 32) { SR0 = (cb >> 7) * SEQ; SL = SEQ; p0 = (cb & 127) * 32; } else { const int c2 = cb - ML / 32; SR0 = ML + (c2 >> 3) * CTXL; SL = CTXL; p0 = (c2 & 7) * 32; }
                    if (lm_ & 2) conv_block(C, l, lds, SR0, SL, p0); }
            }
            __syncthreads();
            const int pan_q = (last ? ML : MT) / 256;
            if (!last) { unsigned char* const ws = C.ws();
              LAS float* const LTAB = (LAS float*)(lds + LTAB_OFF);
              pg8::EpiZ E2{WSP(bf16_t, WS_Z), WSP(bf16_t, WS_HB), WSP(float, WS_SSP), WLP(const float, l, WL_BZ), LTAB, 14, ML};
              pg8::RectOrder S; S.init(MC / 256, NZ / 256 - 14, G, bid, G / 2, WSP(bf16_t, WS_H) + (size_t)ML * D, 256 * D * 2, WLP(bf16_t, l, WL_IN) + (size_t)14 * 256 * D, 256 * D * 2);
              pg8::gemm_phase<pg8::EpiZ, pg8::RectOrder, true>(lds, D, D, D, S, E2); }
            if (lm_ & 4) { unsigned char* const ws = C.ws();
              pg8::RectOrder S; S.init(pan_q, 3, G, bid, 0, WSP(bf16_t, WS_Z) + ZC_CQ, 256 * NZ * 2, WLP(bf16_t, l, WL_UQ), 256 * 512 * 2);
              LAS float* const LTAB = (LAS float*)(lds + LTAB_OFF); { const int t_ = fresh_tid(); for (int i = t_; i < 2048; i += 512) LTAB[i] = WSP(const float, WS_TAB)[i]; __syncthreads(); }
              pg8::EpiQ E{WSP(bf16_t, WS_QM), WSP(const float, WS_SSP), LTAB}; pg8::gemm_phase<pg8::EpiQ, pg8::RectOrder, true>(lds, 512, NZ, 512, S, E); }
            if (lm_ & 8) { unsigned char* const ws = C.ws();
              { pg8::RectOrder S; S.init(MT / 256, 2, G, bid, last ? pan_q * 3 : 0, WSP(bf16_t, WS_Z) + ZC_CKV, 256 * NZ * 2, WLP(bf16_t, l, WL_KV), 256 * 256 * 2);
                pg8::EpiPlain<true> E{WSP(bf16_t, WS_KN), 512, WSP(const float, WS_SSP)}; pg8::gemm_phase<pg8::EpiPlain<true>, pg8::RectOrder, true>(lds, 256, NZ, 256, S, E); }
              { pg8::RectOrder S; S.init(2, MT / 256, G, bid, last ? pan_q * 3 + (MT / 256) * 2 : 0, WLP(bf16_t, l, WL_KV) + 512 * 256, 256 * 256 * 2, WSP(bf16_t, WS_Z) + ZC_CKV, 256 * NZ * 2);
                pg8::EpiVt<true> E{WSP(bf16_t, WS_VTM), MT, nullptr, WSP(const float, WS_SSP)}; pg8::gemm_phase<pg8::EpiVt<true>, pg8::RectOrder, true>(lds, 256, 256, NZ, S, E); } }
        }
        SEAM(pb + 5);
        if (IN(pb + 6) && EN(6)) for (int _rep = 0; _rep < (((PROBE_MASK >> 6) & 1) ? 2 : 1); ++_rep) { if (_rep) { MKBAR; xcd_barrier(bar); } GRID; unsigned char* const ws = C.ws();
            bf16_t* const YC = WSP(bf16_t, WS_YBR) + (size_t)2 * MT * 512; bf16_t* const YD = WSP(bf16_t, WS_YBR) + (size_t)3 * MT * 512;
            const bf16_t* const QM = WSP(const bf16_t, WS_QM); const bf16_t* const KN = WSP(const bf16_t, WS_KN); const bf16_t* const Z = WSP(const bf16_t, WS_Z);
            const bf16_t* const VTM = WSP(const bf16_t, WS_VTM); const bf16_t* const VTD = WSP(const bf16_t, WS_VTD);
            const float* const sink = C.in(I_SINK) + l * 8;
            const int tid2 = fresh_tid(), wid = __builtin_amdgcn_readfirstlane(tid2 >> 6);
            int role; { const unsigned simd = (unsigned)__builtin_amdgcn_s_getreg((1 << 11) | (4 << 6) | 4) & 3u; volatile LAS unsigned* sw = (volatile LAS unsigned*)(lds + 122880);
              __syncthreads(); if ((tid2 & 63) == 0) sw[wid] = simd; __syncthreads();
              int cnt = 0;
#pragma unroll
              for (int w = 0; w < 8; ++w) cnt += (w < wid && sw[w] == simd) ? 1 : 0;
              role = __builtin_amdgcn_readfirstlane(cnt & 1); }
#ifdef ROLE_WID
            role = (ROLE_WID == 4) ? (wid >> 2) & 1 : (ROLE_WID == 0 ? 0 : wid & 1);
#endif
#define i16 (fresh_tid() & 15)
            for (int u = bid; u < 256; u += G) { const int bh = (u & 7) + 8 * ((u >> 7) & 1), qb = (u >> 3) & 15, b = bh >> 2, h = bh & 3;
                const int row = b * SEQ + 256 * qb + 32 * wid + i16;
                AttnSrc S{KN + h * 128, 512, Z + ZC_KR, NZ, VTM + (size_t)h * 128 * MT};
                attn_unit<128, 64, 128, false>(lds, S, QM + (size_t)row * 768 + h * 192, QM + (size_t)(row + 16) * 768 + h * 192, YC + (size_t)row * 512 + h * 128, YC + (size_t)(row + 16) * 512 + h * 128,
                                               ML + b * CTXL, 4, b * SEQ, 0, 64, 0, 0, -1e30f, 0.f, role); }
            for (int u = bid; u < 512; u += G) { const int b = u >> 7, kvh = (u >> 6) & 1, qb = u & 63, q0 = 64 * qb, head = 4 * kvh + (wid >> 1);
                const int q = q0 + 32 * (wid & 1) + i16, row = b * SEQ + q;
                int tlo = (128 - q0) / 64; if (tlo < 0) tlo = 0; int thi = (SEQ + 128 - q0) / 64; if (thi > 5) thi = 5;
                const int lp0 = q0 - 128 + 64 * tlo;
                AttnSrc S{Z + ZC_KD + 64 * kvh, NZ, Z, NZ, VTD + (size_t)kvh * 64 * MT};
                attn_unit<64, 0, 64, true>(lds, S, Z + (size_t)row * NZ + ZC_QD + 64 * head, Z + (size_t)(row + 16) * NZ + ZC_QD + 64 * head, YD + (size_t)row * 512 + 64 * head, YD + (size_t)(row + 16) * 512 + 64 * head,
                                           ML + b * CTXL, 4, b * SEQ + lp0, lp0, thi - tlo, q, q + 16, sink[head] * LOG2E, 1.f, role); }
            if (!last) {
                for (int u = bid; u < 16; u += G) { const int b = u >> 2, h = u & 3; const int row = ML + b * CTXL + 32 * wid + i16;
                    AttnSrc S{KN + h * 128, 512, Z + ZC_KR, NZ, VTM + (size_t)h * 128 * MT};
                    attn_unit<128, 64, 128, false>(lds, S, QM + (size_t)row * 768 + h * 192, QM + (size_t)(row + 16) * 768 + h * 192, YC + (size_t)row * 512 + h * 128, YC + (size_t)(row + 16) * 512 + h * 128,
                                                   ML + b * CTXL, 4, 0, 0, 0, 0, 0, -1e30f, 0.f, role); }
                for (int u = bid - 16; u >= 0 && u < 32; u += G) { const int b = u >> 3, kvh = (u >> 2) & 1, qb = u & 3, head = 4 * kvh + (wid >> 1);
                    const int q = 64 * qb + 32 * (wid & 1) + i16, row = ML + b * CTXL + q;
                    AttnSrc S{Z + ZC_KD + 64 * kvh, NZ, Z, NZ, VTD + (size_t)kvh * 64 * MT};
                    attn_unit<64, 0, 64, false>(lds, S, Z + (size_t)row * NZ + ZC_QD + 64 * head, Z + (size_t)(row + 16) * NZ + ZC_QD + 64 * head, YD + (size_t)row * 512 + 64 * head, YD + (size_t)(row + 16) * 512 + 64 * head,
                                                ML + b * CTXL, 4, 0, 0, 0, 0, 0, sink[head] * LOG2E, 1.f, role); }
            }
            __syncthreads();
        }
        SEAM(pb + 6);
#undef i16
        if (IN(pb + 7) && EN(7)) for (int _rep = 0; _rep < (((PROBE_MASK >> 7) & 1) ? 2 : 1); ++_rep) { if (_rep) { MKBAR; xcd_barrier(bar); } GRID; unsigned char* const ws = C.ws();
            pg8::ChainOrder S; S.init((last ? ML : MT) / 256, D / 128, G, bid, 0, WSP(bf16_t, WS_YBR), 256 * 512 * 2, WLP(bf16_t, l, WL_BR), 128 * 512 * 2); S.nsub = MERGE_N; S.map = MERGE_MAP; S.sA = (size_t)MT * 512 * 2; S.sB = (size_t)D * 512 * 2;
            pg8::EpiM1H E{WSP(const bf16_t, WS_Z), WSP(bf16_t, WS_H), S.nsub - 1, S.map}; pg8::gemm_phase<pg8::EpiM1H, pg8::ChainOrder, true, true>(lds, 512, 512, 512, S, E); }
        SEAM(pb + 7);
        if (IN(pb + 8) && EN(8)) for (int _rep = 0; _rep < (((PROBE_MASK >> 8) & 1) ? 2 : 1); ++_rep) { if (_rep) { MKBAR; xcd_barrier(bar); } GRID; unsigned char* const ws = C.ws();
            const bool split = (G >= 256) && !last;
            { pg8::RectOrder S; S.init((last || split ? ML : MT) / 256, D / 256, G, bid, 0, WSP(bf16_t, WS_H), 256 * D * 2, WLP(bf16_t, l, WL_OUT), 256 * D * 2);
              pg8::EpiPlain<false> E{WSP(bf16_t, WS_Y), D, nullptr}; pg8::gemm_phase<pg8::EpiPlain<false>, pg8::RectOrder, true>(lds, D, D, D, S, E); }
            if (split) { const int tile = bid >> 3, part = bid & 7;
              pg8::SplitOrder S; S.pm = ML / 256 + (tile >> 3); S.pn = tile & 7; S.part = part; S.have = bid < 256;
              S.A = (const char*)(WSP(bf16_t, WS_H) + (size_t)S.pm * 256 * D + part * 256); S.B = (const char*)(WLP(bf16_t, l, WL_OUT) + (size_t)S.pn * 256 * D + part * 256);
              pg8::EpiPartial E{C.out(), ML, (size_t)MC * D}; pg8::gemm_phase<pg8::EpiPartial, pg8::SplitOrder, true>(lds, 256, D, D, S, E); } }
        SEAM(pb + 8);
        if (IN(pb + 9) && EN(9)) for (int _rep = 0; _rep < (((PROBE_MASK >> 9) & 1) ? 2 : 1); ++_rep) { if (_rep) { MKBAR; xcd_barrier(bar); } GRID; unsigned char* const ws = C.ws(); float* const out = C.out(); float* const XC = WSP(float, WS_XC);
            norm_phase<false>(lds, G, bid, last ? ML : MT, nullptr, nullptr, WSP(bf16_t, WS_XB), nullptr, true, WSP(const bf16_t, WS_Y), (G >= 256 && !last) ? (const float*)C.out() : nullptr, WSP(const float, WS_MOD) + (size_t)l * 5 * NMOD, 5, 1.0f, C.in(I_NPOST) + ((size_t)l * 3 + 1) * D, WSP(bf16_t, WS_H), WSP(const float, WS_MOD) + (size_t)l * 5 * NMOD, 6, C.in(I_NPRE) + ((size_t)l * 3 + 2) * D); }
        SEAM(pb + 9);
        if (IN(pb + 10) && EN(10)) for (int _rep = 0; _rep < (((PROBE_MASK >> 10) & 1) ? 2 : 1); ++_rep) { if (_rep) { MKBAR; xcd_barrier(bar); } GRID; unsigned char* const ws = C.ws();
            pg8::RectOrder S; S.init((last ? ML : MT) / 256, NGU / 256, G, bid, 0, WSP(bf16_t, WS_H), 256 * D * 2, WLP(bf16_t, l, WL_GU) + (size_t)NGU * D, 256 * D * 2);
            pg8::EpiSwiglu E{WSP(bf16_t, WS_Z)}; pg8::gemm_phase<pg8::EpiSwiglu, pg8::RectOrder, true>(lds, D, D, D, S, E); }
        if (IN(pb + 10) && EN(10)) { GRID; cvt_pull(C, lds, l * CV_LAYER + CV_LAYER + CV_E0, CW_DONE + 64 * (pb + 10), G); }
        SEAM(pb + 10);
        if (IN(pb + 11) && EN(11)) for (int _rep = 0; _rep < (((PROBE_MASK >> 11) & 1) ? 2 : 1); ++_rep) { if (_rep) { MKBAR; xcd_barrier(bar); } GRID; unsigned char* const ws = C.ws();
            const bool split = (G >= 256) && !last;
            { pg8::RectOrder S; S.init((last || split ? ML : MT) / 256, D / 256, G, bid, 0, WSP(bf16_t, WS_Z), 256 * DFF * 2, WLP(bf16_t, l, WL_D) + (size_t)D * DFF, 256 * DFF * 2);
              pg8::EpiPlain<false> E{WSP(bf16_t, WS_Y), D, nullptr}; pg8::gemm_phase<pg8::EpiPlain<false>, pg8::RectOrder, true>(lds, DFF, DFF, DFF, S, E); }
            if (split) { const int tile = bid >> 3, part = bid & 7, ks = part < 5 ? 10 * part : 50 + 12 * (part - 5), kn = part < 5 ? 10 : 12;
              pg8::SplitOrder S; S.pm = ML / 256 + (tile >> 3); S.pn = tile & 7; S.part = part; S.have = bid < 256;
              S.A = (const char*)(WSP(bf16_t, WS_Z) + (size_t)S.pm * 256 * DFF + ks * 64); S.B = (const char*)(WLP(bf16_t, l, WL_D) + (size_t)D * DFF + (size_t)S.pn * 256 * DFF + ks * 64);
              pg8::EpiPartial E{C.out(), ML, (size_t)MC * D}; pg8::gemm_phase<pg8::EpiPartial, pg8::SplitOrder, true>(lds, kn * 64, DFF, DFF, S, E); } }
        SEAM(pb + 11);
    }
    if (IN(NPHASE - 1) && EN(13)) { GRID; unsigned char* const ws = C.ws(); float* const out = C.out(); float* const XC = WSP(float, WS_XC);
        const int l = DEPTH - 1;
        norm_phase<false>(lds, G, bid, ML, nullptr, nullptr, WSP(bf16_t, WS_XB), out, false, WSP(const bf16_t, WS_Y), nullptr, WSP(const float, WS_MOD) + (size_t)l * 5 * NMOD, 8, 0.5f, C.in(I_NPOST) + ((size_t)l * 3 + 2) * D, nullptr, nullptr, 0, nullptr);
    }
#undef IN
#undef SEAM
}


extern "C" void kernel_launch(void* const* d_in, const int* in_sizes, int n_in, void* d_out, int out_size, void* d_ws, size_t ws_size, hipStream_t stream) {
    static int grid = 0;
    if (grid == 0) {
        if (n_in != 28 || out_size != ML * D || ws_size < WS_END) { fprintf(stderr, "kernel_launch: unexpected shapes (n_in %d, out %d, ws %zu < %zu)\n", n_in, out_size, ws_size, (size_t)WS_END); grid = -1; return; }
        int dev = 0, cus = 0, per_cu = 0;
        if (hipGetDevice(&dev) != hipSuccess || hipDeviceGetAttribute(&cus, hipDeviceAttributeMultiprocessorCount, dev) != hipSuccess) { grid = -1; return; }
        if (hipFuncSetAttribute((const void*)mk_fwd, hipFuncAttributeMaxDynamicSharedMemorySize, LDS_BYTES) != hipSuccess) { fprintf(stderr, "kernel_launch: hipFuncSetAttribute failed\n"); grid = -1; return; }
        if (hipOccupancyMaxActiveBlocksPerMultiprocessor(&per_cu, (const void*)mk_fwd, 512, LDS_BYTES) != hipSuccess || per_cu < 1) fprintf(stderr, "kernel_launch: occupancy query says %d\n", per_cu);
        (void)hipGetLastError();
        grid = cus;
    }
    if (grid < 0) return;
    (void)hipMemsetAsync((char*)d_ws + WS_CTL, 0, CTL_ZERO_BYTES, stream);
    Params p{};
    for (int i = 0; i < 28; ++i) p.in[i] = (const float*)d_in[i];
    p.out = (float*)d_out; p.ws = (unsigned char*)d_ws;
#if MK_MULTI
    for (int k = 0; k < NPHASE; ++k) { p.ph_lo = k; p.ph_hi = k + 1; hipLaunchKernelGGL(mk_fwd, dim3(grid), dim3(512), LDS_BYTES, stream, p);
    }
#else
    p.ph_lo = 0; p.ph_hi = NPHASE; hipLaunchKernelGGL(mk_fwd, dim3(grid), dim3(512), LDS_BYTES, stream, p);
#endif
}
```
